# Optimizing an MI355X kernel written in HIP

```python
import math
import jax, jax.numpy as jnp
from jax import lax
import numpy as np

D_MODEL = 1024
BATCH = 4
SEQ = 4096
DEPTH = 2

HEAD_DIM = 64
N_ATTN_HEADS = 8
ATTN_WIDTH = N_ATTN_HEADS * HEAD_DIM
DILATED_BRANCHES = ((128, 1), (512, 4), (2048, 16))
N_SSD_HEADS = 4
SSD_HEAD_DIM = 64
SSD_WIDTH = N_SSD_HEADS * SSD_HEAD_DIM
SSD_GROUPS = 2
SSD_STATE = 128
CONV_WIDTH = 4
SSD_CHUNK = 128
CONV_CH = SSD_WIDTH + 2 * SSD_GROUPS * SSD_STATE
N_MEM_HEADS = 4
MEM_WIDTH = N_MEM_HEADS * HEAD_DIM
N_MEM = 256
MIX_WIDTH = ATTN_WIDTH + SSD_WIDTH + MEM_WIDTH
N_IN_COLS = 3 * ATTN_WIDTH + SSD_WIDTH + CONV_CH + N_SSD_HEADS + MEM_WIDTH
N_BUCKETS = 32
MAX_DISTANCE = 2048
N_EXPERTS = 16
N_EXPERT_GROUPS = 4
EXPERTS_PER_GROUP = N_EXPERTS // N_EXPERT_GROUPS
TOP_K = 2
D_EXPERT = 1024
ALPHA = (2 * DEPTH) ** 0.25
BETA = (8 * DEPTH) ** -0.25
LN_EPS = 1e-5
RMS_EPS = 1e-5

kernel_name = 'hybrid_dilated_ssd_memory_moe'


def _layer_norm(x, g, b):
    xf = x.astype(jnp.float32)
    mu = xf.mean(-1, keepdims=True)
    var = jnp.square(xf - mu).mean(-1, keepdims=True)
    return ((xf - mu) * lax.rsqrt(var + LN_EPS) * g + b).astype(x.dtype)


def _t5_bucket(dist):
    n = jnp.maximum(dist, 0)
    max_exact = N_BUCKETS // 2
    nf = jnp.maximum(n, max_exact).astype(jnp.float32)
    large = max_exact + (jnp.log(nf / max_exact) / math.log(MAX_DISTANCE / max_exact)
                         * (N_BUCKETS - max_exact)).astype(jnp.int32)
    large = jnp.minimum(large, N_BUCKETS - 1)
    return jnp.where(n < max_exact, n, large)


def _dilated_branch(q, k, v, rel_bias, window, dilation):
    b, s, h, e = q.shape
    steps_max = window // dilation
    blk = steps_max
    L = s // dilation
    nb = -(-L // blk)
    Lp = nb * blk

    def to_blocks(t):
        t = t.reshape(b, L, dilation, h, e).transpose(0, 2, 1, 3, 4)
        t = jnp.pad(t, ((0, 0), (0, 0), (0, Lp - L), (0, 0), (0, 0)))
        return t.reshape(b, dilation, nb, blk, h, e)

    def with_prev(t):
        prev = jnp.pad(t[:, :, :-1], ((0, 0), (0, 0), (1, 0), (0, 0), (0, 0), (0, 0)))
        return jnp.concatenate([prev, t], axis=3)

    qb = to_blocks(q)
    kk = with_prev(to_blocks(k))
    vv = with_prev(to_blocks(v))

    steps = jnp.arange(blk)[:, None] + blk - jnp.arange(2 * blk)[None, :]
    in_band = (steps >= 0) & (steps <= steps_max)
    has_prev = (jnp.arange(nb)[:, None, None] > 0) | (jnp.arange(2 * blk)[None, None, :] >= blk)
    valid = in_band[None] & has_prev
    bias = rel_bias[_t5_bucket(steps * dilation)].transpose(2, 0, 1).astype(jnp.float32)

    sc = jnp.einsum('brnqhe,brnkhe->brnhqk', qb, kk).astype(jnp.float32) + bias
    sc = jnp.where(valid[:, None], sc, -jnp.inf)
    m = sc.max(-1, keepdims=True)
    p = jnp.exp(sc - m)
    den = p.sum(-1, keepdims=True)
    o = jnp.einsum('brnhqk,brnkhe->brnqhe', p / den, vv.astype(jnp.float32))
    lse = (m + jnp.log(den))[..., 0]

    o = o.reshape(b, dilation, Lp, h, e)[:, :, :L].transpose(0, 2, 1, 3, 4).reshape(b, s, h, e)
    lse = lse.transpose(0, 1, 2, 4, 3).reshape(b, dilation, Lp, h)[:, :, :L]
    lse = lse.transpose(0, 2, 1, 3).reshape(b, s, h)
    return o, lse


def _dilated_attention(q, k, v, rel_bias):
    outs, lses = zip(*[_dilated_branch(q, k, v, rel_bias, w, d) for w, d in DILATED_BRANCHES])
    wts = jax.nn.softmax(jnp.stack(lses), axis=0)
    return jnp.einsum('ibsh,ibshe->bshe', wts, jnp.stack(outs))


def _causal_conv(u, w, bias):
    out = lax.conv_general_dilated(u, w[:, None, :], window_strides=(1,),
                                   padding=[(CONV_WIDTH - 1, 0)],
                                   dimension_numbers=('NWC', 'WIO', 'NWC'),
                                   feature_group_count=u.shape[-1])
    return out + bias


def _segsum(a):
    t = a.shape[-1]
    cs = jnp.cumsum(a, axis=-1)
    d = cs[..., :, None] - cs[..., None, :]
    return jnp.where(jnp.tril(jnp.ones((t, t), dtype=bool)), d, -jnp.inf)


def _ssd_chunked(xdt, adt, bm, cm):
    b, s, h, p = xdt.shape
    n = bm.shape[-1]
    c = s // SSD_CHUNK
    X = xdt.reshape(b, c, SSD_CHUNK, h, p)
    Bc = bm.reshape(b, c, SSD_CHUNK, h, n)
    Cc = cm.reshape(b, c, SSD_CHUNK, h, n)
    A = adt.reshape(b, c, SSD_CHUNK, h).transpose(0, 3, 1, 2)
    a_cs = jnp.cumsum(A, axis=-1)
    Lm = jnp.exp(_segsum(A))
    y_diag = jnp.einsum('bclhn,bcshn,bhcls,bcshp->bclhp', Cc, Bc, Lm, X)
    decay_states = jnp.exp(a_cs[..., -1:] - a_cs)
    states = jnp.einsum('bclhn,bhcl,bclhp->bchpn', Bc, decay_states, X)
    states = jnp.concatenate([jnp.zeros_like(states[:, :1]), states], axis=1)
    decay_chunk = jnp.exp(_segsum(jnp.pad(a_cs[..., -1], ((0, 0), (0, 0), (1, 0)))))
    states = jnp.einsum('bhzc,bchpn->bzhpn', decay_chunk, states)[:, :-1]
    y_off = jnp.einsum('bclhn,bchpn,bhcl->bclhp', Cc, states, jnp.exp(a_cs))
    return (y_diag + y_off).reshape(b, s, h, p)


def _ssd_mixer(z, xbc, dt_raw, conv_w, conv_b, dt_bias, a_log, d_skip, norm_w):
    b, s, _ = z.shape
    xbc = jax.nn.silu(_causal_conv(xbc, conv_w, conv_b)).astype(jnp.float32)
    xs, bm, cm = jnp.split(xbc, [SSD_WIDTH, SSD_WIDTH + SSD_GROUPS * SSD_STATE], axis=-1)
    xs = xs.reshape(b, s, N_SSD_HEADS, SSD_HEAD_DIM)
    rep = N_SSD_HEADS // SSD_GROUPS
    bm = jnp.repeat(bm.reshape(b, s, SSD_GROUPS, SSD_STATE), rep, axis=2)
    cm = jnp.repeat(cm.reshape(b, s, SSD_GROUPS, SSD_STATE), rep, axis=2)
    dt = jax.nn.softplus(dt_raw.astype(jnp.float32) + dt_bias.astype(jnp.float32))
    a = -jnp.exp(a_log.astype(jnp.float32))
    y = _ssd_chunked(xs * dt[..., None], a * dt, bm, cm) + d_skip.astype(jnp.float32)[:, None] * xs
    y = y.reshape(b, s, SSD_WIDTH) * jax.nn.silu(z.astype(jnp.float32))
    y = y * lax.rsqrt(jnp.mean(jnp.square(y), axis=-1, keepdims=True) + RMS_EPS) * norm_w
    return y.astype(z.dtype)


def _memory_attention(qm, mem, w_mem_kv, mem_bias):
    b, s, _ = qm.shape
    km, vm = jnp.split(mem @ w_mem_kv, 2, axis=-1)
    km = km.reshape(b, N_MEM, N_MEM_HEADS, HEAD_DIM)
    vm = vm.reshape(b, N_MEM, N_MEM_HEADS, HEAD_DIM)
    q = qm.reshape(b, s, N_MEM_HEADS, HEAD_DIM) * HEAD_DIM ** -0.5
    sc = jnp.einsum('bshe,bmhe->bhsm', q, km).astype(jnp.float32) + mem_bias.astype(jnp.float32)[None, :, None, :]
    p = jax.nn.softmax(sc, axis=-1)
    o = jnp.einsum('bhsm,bmhe->bshe', p, vm.astype(jnp.float32))
    return o.reshape(b, s, MEM_WIDTH).astype(qm.dtype)


def _moe(x, w_router, b_router, w_gate, w_up, w_down):
    logits = (x @ w_router).astype(jnp.float32) + b_router.astype(jnp.float32)
    scores = jax.nn.softmax(logits, axis=-1)
    grp = scores.reshape(*scores.shape[:-1], N_EXPERT_GROUPS, EXPERTS_PER_GROUP)
    grp_score = lax.top_k(grp, TOP_K)[0].sum(-1)
    best = jnp.argmax(grp_score, axis=-1)
    in_grp = (jnp.arange(N_EXPERTS) // EXPERTS_PER_GROUP) == best[..., None]
    top_w, top_i = lax.top_k(jnp.where(in_grp, scores, -jnp.inf), TOP_K)
    top_w = top_w / top_w.sum(-1, keepdims=True)
    gates = (jax.nn.one_hot(top_i, N_EXPERTS, dtype=jnp.float32) * top_w[..., None]).sum(-2)
    out = jnp.zeros_like(x)
    for e in range(N_EXPERTS):
        h = jax.nn.silu(x @ w_gate[e]) * (x @ w_up[e])
        out = out + gates[..., e:e + 1].astype(x.dtype) * (h @ w_down[e])
    return out


def setup_inputs(seed: int = 0) -> dict:
    key = jax.random.key(seed)
    ks = jax.random.split(key, 22)
    f32 = jnp.float32

    def nrm(k, shape, scale):
        return jax.random.normal(k, shape, f32) * scale

    x = nrm(ks[0], (BATCH, SEQ, D_MODEL), 1.0)
    mem = nrm(ks[1], (BATCH, N_MEM, D_MODEL), 1.0)
    col_scale = np.ones((N_IN_COLS,), np.float32)
    col_scale[2 * ATTN_WIDTH:3 * ATTN_WIDTH] = BETA
    w_in = nrm(ks[2], (DEPTH, D_MODEL, N_IN_COLS), D_MODEL ** -0.5) * jnp.asarray(col_scale)
    w_out = nrm(ks[3], (DEPTH, MIX_WIDTH, D_MODEL), BETA * MIX_WIDTH ** -0.5)
    rel_bias = nrm(ks[4], (N_BUCKETS, N_ATTN_HEADS), 0.1)
    conv_w = nrm(ks[5], (DEPTH, CONV_WIDTH, CONV_CH), CONV_WIDTH ** -0.5)
    conv_b = nrm(ks[6], (DEPTH, CONV_CH), 0.02)
    dt = jnp.exp(jax.random.uniform(ks[7], (DEPTH, N_SSD_HEADS), f32, math.log(1e-3), math.log(1e-1)))
    dt_bias = dt + jnp.log(-jnp.expm1(-dt))
    a_log = jnp.log(jax.random.uniform(ks[8], (DEPTH, N_SSD_HEADS), f32, 1.0, 16.0))
    d_skip = 1.0 + nrm(ks[9], (DEPTH, N_SSD_HEADS), 0.1)
    ssd_norm_w = 1.0 + nrm(ks[10], (DEPTH, SSD_WIDTH), 0.02)
    kv_scale = jnp.concatenate([jnp.ones((MEM_WIDTH,), f32), jnp.full((MEM_WIDTH,), BETA, f32)])
    w_mem_kv = nrm(ks[11], (DEPTH, D_MODEL, 2 * MEM_WIDTH), D_MODEL ** -0.5) * kv_scale
    mem_bias = nrm(ks[12], (DEPTH, N_MEM_HEADS, N_MEM), 0.1)
    ln1_g = 1.0 + nrm(ks[13], (DEPTH, D_MODEL), 0.02)
    ln1_b = nrm(ks[14], (DEPTH, D_MODEL), 0.02)
    ln2_g = 1.0 + nrm(ks[15], (DEPTH, D_MODEL), 0.02)
    ln2_b = nrm(ks[16], (DEPTH, D_MODEL), 0.02)
    w_router = nrm(ks[17], (D_MODEL, N_EXPERTS), D_MODEL ** -0.5)
    b_router = nrm(ks[18], (N_EXPERTS,), 0.01)
    w_gate = nrm(ks[19], (DEPTH, N_EXPERTS, D_MODEL, D_EXPERT), D_MODEL ** -0.5)
    w_up = nrm(ks[20], (DEPTH, N_EXPERTS, D_MODEL, D_EXPERT), BETA * D_MODEL ** -0.5)
    w_down = nrm(ks[21], (DEPTH, N_EXPERTS, D_EXPERT, D_MODEL), BETA * D_EXPERT ** -0.5)
    return {'x': x, 'mem': mem, 'w_in': w_in, 'w_out': w_out, 'rel_bias': rel_bias,
            'conv_w': conv_w, 'conv_b': conv_b, 'dt_bias': dt_bias, 'a_log': a_log,
            'd_skip': d_skip, 'ssd_norm_w': ssd_norm_w, 'w_mem_kv': w_mem_kv, 'mem_bias': mem_bias,
            'ln1_g': ln1_g, 'ln1_b': ln1_b, 'ln2_g': ln2_g, 'ln2_b': ln2_b,
            'w_router': w_router, 'b_router': b_router, 'w_gate': w_gate, 'w_up': w_up, 'w_down': w_down}


def reference(x, mem, w_in, w_out, rel_bias, conv_w, conv_b, dt_bias, a_log, d_skip, ssd_norm_w,
              w_mem_kv, mem_bias, ln1_g, ln1_b, ln2_g, ln2_b, w_router, b_router, w_gate, w_up, w_down):
    b, s, _ = x.shape
    splits = np.cumsum([ATTN_WIDTH, ATTN_WIDTH, ATTN_WIDTH, SSD_WIDTH, CONV_CH, N_SSD_HEADS]).tolist()
    for l in range(DEPTH):
        proj = x @ w_in[l]
        q, k, v, z, xbc, dt_raw, qm = jnp.split(proj, splits, axis=-1)
        heads = lambda t: t.reshape(b, s, N_ATTN_HEADS, HEAD_DIM)
        attn = _dilated_attention(heads(q) * HEAD_DIM ** -0.5, heads(k), heads(v), rel_bias)
        attn = attn.reshape(b, s, ATTN_WIDTH).astype(x.dtype)
        ssd = _ssd_mixer(z, xbc, dt_raw, conv_w[l], conv_b[l], dt_bias[l], a_log[l], d_skip[l], ssd_norm_w[l])
        memo = _memory_attention(qm, mem, w_mem_kv[l], mem_bias[l])
        y = jnp.concatenate([attn, ssd, memo], axis=-1) @ w_out[l]
        x = _layer_norm(ALPHA * x + y, ln1_g[l], ln1_b[l])
        y = _moe(x, w_router, b_router, w_gate[l], w_up[l], w_down[l])
        x = _layer_norm(ALPHA * x + y, ln2_g[l], ln2_b[l])
    return x
```

```cpp
#include <hip/hip_runtime.h>
#include <cstdio>
#include <cstdint>

#define GAS __attribute__((address_space(1)))
#define LAS __attribute__((address_space(3)))
typedef unsigned short bf16;
typedef short bf16x8 __attribute__((ext_vector_type(8)));
typedef float f32x4 __attribute__((ext_vector_type(4)));
typedef float f32x16 __attribute__((ext_vector_type(16)));
typedef unsigned u32x4 __attribute__((ext_vector_type(4)));
typedef unsigned u32x2 __attribute__((ext_vector_type(2)));

constexpr int NB = 4, SEQ = 4096, T = NB * SEQ, DM = 1024, DEPTH = 2;
constexpr int NCOLS_IN = 2820, NPROJ = 2816;
constexpr int C_Q = 0, C_K = 512, C_V = 1024, C_Z = 1536, C_XBC = 1792, C_QM = 2560;
constexpr int NE = 16, NMEM = 256;
constexpr int HROWS = 36864;
constexpr float ALPHA = 1.41421356237309515f;
constexpr float LN_EPS = 1e-5f, RMS_EPS = 1e-5f;
constexpr int NTHREADS = 512, NWAVES = 8;

constexpr size_t MiB = 1u << 20;
constexpr size_t WS_CTL = 0, CTL_ZERO_BYTES = 1 * MiB;
constexpr size_t WS_BIAST = 1 * MiB;
constexpr size_t WS_KV = 2 * MiB;
constexpr size_t WS_MEMB = 4 * MiB;
constexpr size_t WS_WT_KV = 6 * MiB;
constexpr size_t WS_WT_OUT = 8 * MiB;
constexpr size_t WS_WT_IN = 12 * MiB;
constexpr size_t WS_WT_GU = 24 * MiB;
constexpr size_t WS_WT_DN = 152 * MiB;
constexpr size_t WS_XB = 216 * MiB;
constexpr size_t WS_MIX = 248 * MiB;
constexpr size_t WS_DT = 280 * MiB;
constexpr size_t WS_TOKE = 281 * MiB;
constexpr size_t WS_TOKP = WS_TOKE + 128 * 1024;
constexpr size_t WS_TOKW = WS_TOKP + 128 * 1024;
constexpr size_t WS_LIST = 282 * MiB;
constexpr size_t WS_SST = 284 * MiB;
constexpr size_t WS_P = 300 * MiB;
constexpr size_t WS_ATTO = 388 * MiB;
constexpr size_t WS_LSE = 436 * MiB;
constexpr size_t WS_H = 300 * MiB;
constexpr size_t WS_Y = 372 * MiB;
constexpr size_t WS_XBCC = 444 * MiB;
constexpr size_t WS_YS = 492 * MiB;
constexpr size_t WS_END = 508 * MiB;
constexpr int CW_CNT = 64;

struct Params {
    const float *x, *mem, *w_in, *w_out, *rel_bias, *conv_w, *conv_b, *dt_bias, *a_log, *d_skip, *ssd_norm_w, *w_mem_kv, *mem_bias,
        *ln1_g, *ln1_b, *ln2_g, *ln2_b, *w_router, *b_router, *w_gate, *w_up, *w_down;
    float* out; unsigned char* ws;
};

__device__ __forceinline__ unsigned f2bf(float f) { unsigned u = __builtin_bit_cast(unsigned, f); return (u + 0x7fffu + ((u >> 16) & 1u)) >> 16; }
__device__ __forceinline__ unsigned pk2(float lo, float hi) { return f2bf(lo) | (f2bf(hi) << 16); }
__device__ __forceinline__ float bf2f(unsigned b) { return __builtin_bit_cast(float, b << 16); }
__device__ __forceinline__ float bflo(unsigned w) { return __builtin_bit_cast(float, w << 16); }
__device__ __forceinline__ float bfhi(unsigned w) { return __builtin_bit_cast(float, w & 0xffff0000u); }
__device__ __forceinline__ float wave_sum(float v) {
#pragma unroll
    for (int o = 1; o < 64; o <<= 1) v += __shfl_xor(v, o);
    return v;
}
__device__ __forceinline__ float wave_max(float v) {
#pragma unroll
    for (int o = 1; o < 64; o <<= 1) v = fmaxf(v, __shfl_xor(v, o));
    return v;
}
__device__ __forceinline__ float silu_f(float v) { return v / (1.f + __expf(-v)); }
__device__ __forceinline__ float softplus_f(float v) { return v > 20.f ? v : log1pf(__expf(v)); }
__device__ __forceinline__ int crow(int r, int hi) { return (r & 3) + 8 * (r >> 2) + 4 * hi; }

__device__ __forceinline__ void transpose_item(const float* W, int ldw, int src_col0, bf16* WT, int K, int dst_row0, float scale, LAS float* scr, int k0, int lane) {
#pragma unroll 8
    for (int i = 0; i < 32; ++i) { const int kk = 2 * i + (lane >> 5); scr[kk * 33 + (lane & 31)] = W[(size_t)(k0 + kk) * ldw + src_col0 + (lane & 31)]; }
    asm volatile("s_waitcnt lgkmcnt(0)" ::: "memory");
    const int c = lane & 7;
#pragma unroll
    for (int j = 0; j < 4; ++j) { const int n = (lane >> 3) + 8 * j; const LAS float* s = scr + (8 * c) * 33 + n;
        u32x4 o; o.x = pk2(s[0 * 33] * scale, s[1 * 33] * scale); o.y = pk2(s[2 * 33] * scale, s[3 * 33] * scale); o.z = pk2(s[4 * 33] * scale, s[5 * 33] * scale); o.w = pk2(s[6 * 33] * scale, s[7 * 33] * scale);
        *(u32x4*)(WT + (size_t)(dst_row0 + n) * K + k0 + 8 * c) = o; }
    asm volatile("s_waitcnt lgkmcnt(0)" ::: "memory");
}
constexpr int I_IN = 2 * 16 * 88, I_OUT = 2 * 16 * 32, I_KV = 2 * 16 * 16, I_GU = 32 * 16 * 64, I_DN = 32 * 16 * 32;
constexpr int I_TOTAL = I_IN + I_OUT + I_KV + I_GU + I_DN;

__device__ __forceinline__ void stage_prologue(const Params& p, LAS unsigned char* lds, int blk, int nblk) {
    const int tid = threadIdx.x, lane = tid & 63, wave = tid >> 6;
    const int gw = blk * NWAVES + wave, ngw = nblk * NWAVES;
    LAS float* scr = (LAS float*)(lds + wave * 16384);
    unsigned char* ws = p.ws;
    for (int it = gw; it < I_TOTAL; it += ngw) {
        int r = it;
        if (r < I_IN) { const int l = r / (16 * 88), q = r % (16 * 88), kb = q / 88, nb = q % 88, n0 = nb * 32;
            transpose_item(p.w_in + (size_t)l * DM * NCOLS_IN, NCOLS_IN, n0 < 2560 ? n0 : n0 + 4, (bf16*)(ws + WS_WT_IN) + (size_t)l * NPROJ * DM, DM, n0, (n0 < 512 || n0 >= 2560) ? 0.125f : 1.f, scr, kb * 64, lane); continue; }
        r -= I_IN;
        if (r < I_OUT) { const int l = r / (16 * 32), q = r % (16 * 32), kb = q / 32, nb = q % 32;
            transpose_item(p.w_out + (size_t)l * DM * DM, DM, nb * 32, (bf16*)(ws + WS_WT_OUT) + (size_t)l * DM * DM, DM, nb * 32, 1.f, scr, kb * 64, lane); continue; }
        r -= I_OUT;
        if (r < I_KV) { const int l = r / (16 * 16), q = r % (16 * 16), kb = q / 16, nb = q % 16;
            transpose_item(p.w_mem_kv + (size_t)l * DM * 512, 512, nb * 32, (bf16*)(ws + WS_WT_KV) + (size_t)l * 512 * DM, DM, nb * 32, 1.f, scr, kb * 64, lane); continue; }
        r -= I_KV;
        if (r < I_GU) { const int le = r / (16 * 64), q = r % (16 * 64), kb = q / 64, nb = q % 64, n0 = nb * 32, pn = n0 >> 8, bj = (n0 >> 7) & 1, j0 = n0 & 127;
            transpose_item((bj ? p.w_up : p.w_gate) + (size_t)le * DM * DM, DM, 128 * pn + j0, (bf16*)(ws + WS_WT_GU) + (size_t)le * 2048 * DM, DM, n0, 1.f, scr, kb * 64, lane); continue; }
        r -= I_GU;
        { const int le = r / (16 * 32), q = r % (16 * 32), kb = q / 32, nb = q % 32;
            transpose_item(p.w_down + (size_t)le * DM * DM, DM, nb * 32, (bf16*)(ws + WS_WT_DN) + (size_t)le * DM * DM, DM, nb * 32, 1.f, scr, kb * 64, lane); }
    }
    {
        bf16* XB = (bf16*)(ws + WS_XB); float* DT = (float*)(ws + WS_DT);
        for (int m = gw; m < T; m += ngw) {
            const f32x4* xr = (const f32x4*)(p.x + (size_t)m * DM) + lane;
            float d0 = 0.f, d1 = 0.f, d2 = 0.f, d3 = 0.f;
#pragma unroll
            for (int j = 0; j < 4; ++j) { const f32x4 v = xr[64 * j];
                u32x2 o; o.x = pk2(v.x, v.y); o.y = pk2(v.z, v.w); *((u32x2*)(XB + (size_t)m * DM) + lane + 64 * j) = o;
#pragma unroll
                for (int c = 0; c < 4; ++c) { const int k = 4 * lane + 256 * j + c; const f32x4 w = *(const f32x4*)(p.w_in + (size_t)k * NCOLS_IN + 2560); const float xv = v[c];
                    d0 += xv * w.x; d1 += xv * w.y; d2 += xv * w.z; d3 += xv * w.w; } }
            d0 = wave_sum(d0); d1 = wave_sum(d1); d2 = wave_sum(d2); d3 = wave_sum(d3);
            if (lane == 0) *(f32x4*)(DT + (size_t)m * 4) = (f32x4){d0, d1, d2, d3};
        }
    }
    {
        bf16* MB = (bf16*)(ws + WS_MEMB);
        for (int m = gw; m < NB * NMEM; m += ngw) {
            const f32x4* xr = (const f32x4*)(p.mem + (size_t)m * DM) + lane;
#pragma unroll
            for (int j = 0; j < 4; ++j) { const f32x4 v = xr[64 * j]; u32x2 o; o.x = pk2(v.x, v.y); o.y = pk2(v.z, v.w); *((u32x2*)(MB + (size_t)m * DM) + lane + 64 * j) = o; }
        }
    }
    if (blk == 0) {
        float* BT = (float*)(ws + WS_BIAST);
        for (int i = tid; i < 3 * 129; i += NTHREADS) { const int br = i / 129, st = i % 129, dil = br == 0 ? 1 : (br == 1 ? 4 : 16), n = st * dil; int bucket;
            if (n < 16) bucket = n; else { const float nf = (float)n; int lg = 16 + (int)(logf(nf / 16.f) / logf(128.f) * 16.f); bucket = lg < 31 ? lg : 31; }
#pragma unroll
            for (int h = 0; h < 8; ++h) BT[(br * 8 + h) * 132 + st] = p.rel_bias[bucket * 8 + h]; }
    }
}

template <class RowPtr, class Epi>
__device__ __forceinline__ void wave_gemm_tile(RowPtr arow  , const bf16* brow  , int K, int lane, Epi epi) {
    const int hi = lane >> 5;
    const bf16* ap = arow + 8 * hi; const bf16* bp = brow + 8 * hi;
    f32x16 acc = {};
    for (int k0 = 0; k0 < K; k0 += 16) { const bf16x8 a = *(const bf16x8*)(ap + k0); const bf16x8 b = *(const bf16x8*)(bp + k0); acc = __builtin_amdgcn_mfma_f32_32x32x16_bf16(b, a, acc, 0, 0, 0); }
#pragma unroll
    for (int g = 0; g < 4; ++g) epi(8 * g + 4 * hi, acc[4 * g], acc[4 * g + 1], acc[4 * g + 2], acc[4 * g + 3]);
}

__device__ __forceinline__ void stage_proj_ref(const Params& p, int l, int blk, int nblk) {
    const int tid = threadIdx.x, lane = tid & 63, wave = tid >> 6, gw = blk * NWAVES + wave, ngw = nblk * NWAVES;
    unsigned char* ws = p.ws;
    const bf16* XB = (const bf16*)(ws + WS_XB); const bf16* WT = (const bf16*)(ws + WS_WT_IN) + (size_t)l * NPROJ * DM; bf16* P = (bf16*)(ws + WS_P);
    constexpr int NT = NPROJ / 32, MT = T / 32;
    for (int tile = gw; tile < MT * NT; tile += ngw) { const int tm = tile / NT, tn = tile % NT; const int m = tm * 32 + (lane & 31);
        wave_gemm_tile(XB + (size_t)m * DM, WT + (size_t)(tn * 32 + (lane & 31)) * DM, DM, lane, [&](int nn, float a, float b, float c, float d) {
            u32x2 o; o.x = pk2(a, b); o.y = pk2(c, d); *(u32x2*)(P + (size_t)m * NPROJ + tn * 32 + nn) = o; }); }
    if (l == 0) {
        const bf16* MB = (const bf16*)(ws + WS_MEMB);
        constexpr int NT2 = 512 / 32, MT2 = NB * NMEM / 32;
        for (int tile = gw; tile < 2 * MT2 * NT2; tile += ngw) { const int ll = tile / (MT2 * NT2), q = tile % (MT2 * NT2), tm = q / NT2, tn = q % NT2; const int m = tm * 32 + (lane & 31);
            const bf16* WK = (const bf16*)(ws + WS_WT_KV) + (size_t)ll * 512 * DM; bf16* KV = (bf16*)(ws + WS_KV) + (size_t)ll * 1024 * 512;
            wave_gemm_tile(MB + (size_t)m * DM, WK + (size_t)(tn * 32 + (lane & 31)) * DM, DM, lane, [&](int nn, float a, float b, float c, float d) {
                u32x2 o; o.x = pk2(a, b); o.y = pk2(c, d); *(u32x2*)(KV + (size_t)m * 512 + tn * 32 + nn) = o; }); }
    }
}

__device__ __forceinline__ float dot64(const bf16* row, const unsigned (&qw)[32]) {
    float s = 0.f;
#pragma unroll
    for (int c = 0; c < 8; ++c) { const u32x4 kv = *(const u32x4*)(row + 8 * c);
        s += bflo(kv.x) * bflo(qw[4 * c]) + bfhi(kv.x) * bfhi(qw[4 * c]); s += bflo(kv.y) * bflo(qw[4 * c + 1]) + bfhi(kv.y) * bfhi(qw[4 * c + 1]);
        s += bflo(kv.z) * bflo(qw[4 * c + 2]) + bfhi(kv.z) * bfhi(qw[4 * c + 2]); s += bflo(kv.w) * bflo(qw[4 * c + 3]) + bfhi(kv.w) * bfhi(qw[4 * c + 3]); }
    return s;
}
__device__ __forceinline__ void stage_attn_ref(const Params& p, int l, int blk, int nblk) {
    const int tid = threadIdx.x, lane = tid & 63, wave = tid >> 6, gw = blk * NWAVES + wave, ngw = nblk * NWAVES;
    unsigned char* ws = p.ws; const bf16* P = (const bf16*)(ws + WS_P); const float* BT = (const float*)(ws + WS_BIAST);
    bf16* AO = (bf16*)(ws + WS_ATTO); float* LSE = (float*)(ws + WS_LSE);
    for (int task = gw; task < 3 * T * 8; task += ngw) {
        const int br = task / (T * 8), q = task % (T * 8), t = q >> 3, h = q & 7, s = t % SEQ, dil = br == 0 ? 1 : (br == 1 ? 4 : 16);
        unsigned qw[32];
        { const u32x4* qp = (const u32x4*)(P + (size_t)t * NPROJ + C_Q + h * 64);
#pragma unroll
            for (int c = 0; c < 8; ++c) { const u32x4 v = qp[c]; qw[4 * c] = v.x; qw[4 * c + 1] = v.y; qw[4 * c + 2] = v.z; qw[4 * c + 3] = v.w; } }
        float sc[3];
#pragma unroll
        for (int kk = 0; kk < 3; ++kk) { const int st = lane + 64 * kk; const bool valid = st <= 128 && s - st * dil >= 0; sc[kk] = -INFINITY;
            if (valid) sc[kk] = dot64(P + (size_t)(t - st * dil) * NPROJ + C_K + h * 64, qw) + BT[(br * 8 + h) * 132 + st]; }
        const float mx = wave_max(fmaxf(fmaxf(sc[0], sc[1]), sc[2]));
        float pr[3], ls = 0.f;
#pragma unroll
        for (int kk = 0; kk < 3; ++kk) { pr[kk] = __expf(sc[kk] - mx); ls += pr[kk]; }
        ls = wave_sum(ls);
        float o = 0.f;
        const int nst = min(128, s / dil);
        for (int st = 0; st <= nst; ++st) { const float pj = __shfl(st < 64 ? pr[0] : (st < 128 ? pr[1] : pr[2]), st & 63);
            o += pj * bf2f(P[(size_t)(t - st * dil) * NPROJ + C_V + h * 64 + lane]); }
        AO[((size_t)br * T + t) * 512 + h * 64 + lane] = (bf16)f2bf(o / ls);
        if (lane == 0) LSE[((size_t)br * T + t) * 8 + h] = mx + __logf(ls);
    }
}
__device__ __forceinline__ void stage_merge(const Params& p, int blk, int nblk) {
    const int tid = threadIdx.x, lane = tid & 63, wave = tid >> 6, gw = blk * NWAVES + wave, ngw = nblk * NWAVES;
    unsigned char* ws = p.ws; const bf16* AO = (const bf16*)(ws + WS_ATTO); const float* LSE = (const float*)(ws + WS_LSE); bf16* MIX = (bf16*)(ws + WS_MIX);
    for (int t = gw; t < T; t += ngw) {
        const int h = lane >> 3;
        const float l0 = LSE[((size_t)0 * T + t) * 8 + h], l1 = LSE[((size_t)1 * T + t) * 8 + h], l2 = LSE[((size_t)2 * T + t) * 8 + h];
        const float mx = fmaxf(fmaxf(l0, l1), l2); float w0 = __expf(l0 - mx), w1 = __expf(l1 - mx), w2 = __expf(l2 - mx); const float inv = 1.f / (w0 + w1 + w2); w0 *= inv; w1 *= inv; w2 *= inv;
        const u32x4 a = *(const u32x4*)(AO + ((size_t)0 * T + t) * 512 + lane * 8), b = *(const u32x4*)(AO + ((size_t)1 * T + t) * 512 + lane * 8), c = *(const u32x4*)(AO + ((size_t)2 * T + t) * 512 + lane * 8);
        u32x4 o;
#pragma unroll
        for (int i = 0; i < 4; ++i) o[i] = pk2(w0 * bflo(a[i]) + w1 * bflo(b[i]) + w2 * bflo(c[i]), w0 * bfhi(a[i]) + w1 * bfhi(b[i]) + w2 * bfhi(c[i]));
        *(u32x4*)(MIX + (size_t)t * DM + lane * 8) = o;
    }
}
__device__ __forceinline__ void stage_memattn_ref(const Params& p, int l, int blk, int nblk) {
    const int tid = threadIdx.x, lane = tid & 63, wave = tid >> 6, gw = blk * NWAVES + wave, ngw = nblk * NWAVES;
    unsigned char* ws = p.ws; const bf16* P = (const bf16*)(ws + WS_P); const bf16* KV = (const bf16*)(ws + WS_KV) + (size_t)l * 1024 * 512; bf16* MIX = (bf16*)(ws + WS_MIX);
    for (int task = gw; task < T * 4; task += ngw) {
        const int t = task >> 2, h = task & 3, b = t / SEQ;
        unsigned qw[32];
        { const u32x4* qp = (const u32x4*)(P + (size_t)t * NPROJ + C_QM + h * 64);
#pragma unroll
            for (int c = 0; c < 8; ++c) { const u32x4 v = qp[c]; qw[4 * c] = v.x; qw[4 * c + 1] = v.y; qw[4 * c + 2] = v.z; qw[4 * c + 3] = v.w; } }
        float sc[4];
#pragma unroll
        for (int kk = 0; kk < 4; ++kk) { const int j = lane + 64 * kk; sc[kk] = dot64(KV + (size_t)(b * NMEM + j) * 512 + h * 64, qw) + p.mem_bias[(l * 4 + h) * NMEM + j]; }
        const float mx = wave_max(fmaxf(fmaxf(sc[0], sc[1]), fmaxf(sc[2], sc[3])));
        float pr[4], ls = 0.f;
#pragma unroll
        for (int kk = 0; kk < 4; ++kk) { pr[kk] = __expf(sc[kk] - mx); ls += pr[kk]; }
        ls = wave_sum(ls);
        float o = 0.f;
        for (int j = 0; j < NMEM; ++j) { const int kk = j >> 6; const float pj = __shfl(kk == 0 ? pr[0] : (kk == 1 ? pr[1] : (kk == 2 ? pr[2] : pr[3])), j & 63);
            o += pj * bf2f(KV[(size_t)(b * NMEM + j) * 512 + 256 + h * 64 + lane]); }
        MIX[(size_t)t * DM + 768 + h * 64 + lane] = (bf16)f2bf(o / ls);
    }
}
__device__ __forceinline__ void stage_conv_ref(const Params& p, int l, int blk, int nblk) {
    unsigned char* ws = p.ws; const bf16* P = (const bf16*)(ws + WS_P); float* XC = (float*)(ws + WS_XBCC);
    const float* cw = p.conv_w + (size_t)l * 4 * 768; const float* cb = p.conv_b + (size_t)l * 768;
    for (size_t i = (size_t)blk * NTHREADS + threadIdx.x; i < (size_t)T * 768; i += (size_t)nblk * NTHREADS) {
        const int t = (int)(i / 768), c = (int)(i % 768), s = t % SEQ; float a = cb[c];
#pragma unroll
        for (int k = 0; k < 4; ++k) { const int sp = s + k - 3; if (sp >= 0) a += cw[k * 768 + c] * bf2f(P[(size_t)(t + k - 3) * NPROJ + C_XBC + c]); }
        XC[i] = silu_f(a);
    }
}
__device__ __forceinline__ void stage_ssd_ref(const Params& p, int l, int blk, int nblk) {
    unsigned char* ws = p.ws; const float* XC = (const float*)(ws + WS_XBCC); const float* DT = (const float*)(ws + WS_DT); float* YS = (float*)(ws + WS_YS);
    const int tid = threadIdx.x;
    for (int u = blk; u < NB * 4; u += nblk) {
        const int b = u >> 2, h = u & 3, g = h >> 1, pp = tid >> 3, ns = (tid & 7) * 16;
        const float a = -__expf(p.a_log[l * 4 + h]), dtb = p.dt_bias[l * 4 + h], Dh = p.d_skip[l * 4 + h];
        float hst[16];
#pragma unroll
        for (int i = 0; i < 16; ++i) hst[i] = 0.f;
        for (int s = 0; s < SEQ; ++s) { const size_t t = (size_t)b * SEQ + s;
            const float dt = softplus_f(DT[t * 4 + h] + dtb), da = __expf(a * dt);
            const float xv = XC[t * 768 + h * 64 + pp], xd = xv * dt;
            const f32x4* Bp = (const f32x4*)(XC + t * 768 + 256 + g * 128 + ns); const f32x4* Cp = (const f32x4*)(XC + t * 768 + 512 + g * 128 + ns);
            float acc = 0.f;
#pragma unroll
            for (int i4 = 0; i4 < 4; ++i4) { const f32x4 bv = Bp[i4], cv = Cp[i4];
#pragma unroll
                for (int c = 0; c < 4; ++c) { float& hh = hst[4 * i4 + c]; hh = hh * da + xd * bv[c]; acc += cv[c] * hh; } }
            acc += __shfl_xor(acc, 1); acc += __shfl_xor(acc, 2); acc += __shfl_xor(acc, 4);
            if ((tid & 7) == 0) YS[t * 256 + h * 64 + pp] = acc + Dh * xv;
        }
    }
}
__device__ __forceinline__ void stage_gate_ref(const Params& p, int l, int blk, int nblk) {
    const int tid = threadIdx.x, lane = tid & 63, wave = tid >> 6, gw = blk * NWAVES + wave, ngw = nblk * NWAVES;
    unsigned char* ws = p.ws; const bf16* P = (const bf16*)(ws + WS_P); const float* YS = (const float*)(ws + WS_YS); bf16* MIX = (bf16*)(ws + WS_MIX);
    const f32x4 nw = *(const f32x4*)(p.ssd_norm_w + l * 256 + 4 * lane);
    for (int t = gw; t < T; t += ngw) {
        f32x4 y = *(const f32x4*)(YS + (size_t)t * 256 + 4 * lane); const u32x2 zw = *(const u32x2*)(P + (size_t)t * NPROJ + C_Z + 4 * lane);
        y.x *= silu_f(bflo(zw.x)); y.y *= silu_f(bfhi(zw.x)); y.z *= silu_f(bflo(zw.y)); y.w *= silu_f(bfhi(zw.y));
        const float ms = wave_sum(y.x * y.x + y.y * y.y + y.z * y.z + y.w * y.w) * (1.f / 256.f); const float r = 1.f / sqrtf(ms + RMS_EPS);
        u32x2 o; o.x = pk2(y.x * r * nw.x, y.y * r * nw.y); o.y = pk2(y.z * r * nw.z, y.w * r * nw.w);
        *(u32x2*)(MIX + (size_t)t * DM + 512 + 4 * lane) = o;
    }
}
__device__ __forceinline__ void stage_out_ref(const Params& p, int l, int blk, int nblk) {
    const int tid = threadIdx.x, lane = tid & 63, wave = tid >> 6, gw = blk * NWAVES + wave, ngw = nblk * NWAVES;
    unsigned char* ws = p.ws; const bf16* MIX = (const bf16*)(ws + WS_MIX); const bf16* WT = (const bf16*)(ws + WS_WT_OUT) + (size_t)l * DM * DM;
    const float* xin = l == 0 ? p.x : p.out; float* out = p.out;
    constexpr int NT = DM / 32, MT = T / 32;
    for (int tile = gw; tile < MT * NT; tile += ngw) { const int tm = tile / NT, tn = tile % NT; const int m = tm * 32 + (lane & 31);
        wave_gemm_tile(MIX + (size_t)m * DM, WT + (size_t)(tn * 32 + (lane & 31)) * DM, DM, lane, [&](int nn, float a, float b, float c, float d) {
            const size_t off = (size_t)m * DM + tn * 32 + nn; const f32x4 xv = *(const f32x4*)(xin + off);
            *(f32x4*)(out + off) = (f32x4){ALPHA * xv.x + a, ALPHA * xv.y + b, ALPHA * xv.z + c, ALPHA * xv.w + d}; }); }
}

__device__ __forceinline__ void ln_row(f32x4 (&v)[4], const float* g, const float* bta, int lane) {
    float s = 0.f;
#pragma unroll
    for (int j = 0; j < 4; ++j) s += (v[j].x + v[j].y) + (v[j].z + v[j].w);
    const float mean = wave_sum(s) * (1.f / DM); float s2 = 0.f;
#pragma unroll
    for (int j = 0; j < 4; ++j) { v[j] = v[j] - mean; s2 += (v[j].x * v[j].x + v[j].y * v[j].y) + (v[j].z * v[j].z + v[j].w * v[j].w); }
    const float rstd = 1.f / sqrtf(wave_sum(s2) * (1.f / DM) + LN_EPS);
#pragma unroll
    for (int j = 0; j < 4; ++j) { const f32x4 gg = *((const f32x4*)g + lane + 64 * j), bb = *((const f32x4*)bta + lane + 64 * j); v[j] = v[j] * rstd * gg + bb; }
}
__device__ __forceinline__ void stage_ln1_router(const Params& p, int l, int blk, int nblk) {
    const int tid = threadIdx.x, lane = tid & 63, wave = tid >> 6, gw = blk * NWAVES + wave, ngw = nblk * NWAVES;
    unsigned char* ws = p.ws; bf16* XB = (bf16*)(ws + WS_XB); unsigned* cnt = (unsigned*)(ws + WS_CTL) + CW_CNT + l * 16;
    int* TOKE = (int*)(ws + WS_TOKE); int* TOKP = (int*)(ws + WS_TOKP); float* TOKW = (float*)(ws + WS_TOKW); int* LIST = (int*)(ws + WS_LIST);
    for (int t = gw; t < T; t += ngw) {
        f32x4 v[4]; f32x4* xr = (f32x4*)(p.out + (size_t)t * DM) + lane;
#pragma unroll
        for (int j = 0; j < 4; ++j) v[j] = xr[64 * j];
        ln_row(v, p.ln1_g + l * DM, p.ln1_b + l * DM, lane);
        float lg[16];
#pragma unroll
        for (int e = 0; e < 16; ++e) lg[e] = 0.f;
#pragma unroll
        for (int j = 0; j < 4; ++j) { xr[64 * j] = v[j]; u32x2 o; o.x = pk2(v[j].x, v[j].y); o.y = pk2(v[j].z, v[j].w); *((u32x2*)(XB + (size_t)t * DM) + lane + 64 * j) = o;
#pragma unroll
            for (int c = 0; c < 4; ++c) { const int k = 4 * lane + 256 * j + c; const float xv = v[j][c]; const f32x4* wr = (const f32x4*)(p.w_router + (size_t)k * 16);
#pragma unroll
                for (int q = 0; q < 4; ++q) { const f32x4 w = wr[q]; lg[4 * q] += xv * w.x; lg[4 * q + 1] += xv * w.y; lg[4 * q + 2] += xv * w.z; lg[4 * q + 3] += xv * w.w; } } }
        float mx = -INFINITY;
#pragma unroll
        for (int e = 0; e < 16; ++e) { lg[e] = wave_sum(lg[e]) + p.b_router[e]; mx = fmaxf(mx, lg[e]); }
        float sum = 0.f;
#pragma unroll
        for (int e = 0; e < 16; ++e) { lg[e] = __expf(lg[e] - mx); sum += lg[e]; }
        const float inv = 1.f / sum;
#pragma unroll
        for (int e = 0; e < 16; ++e) lg[e] *= inv;
        int best = 0; float bs = -1.f;
#pragma unroll
        for (int g = 0; g < 4; ++g) { const float a = lg[4 * g], b = lg[4 * g + 1], c = lg[4 * g + 2], d = lg[4 * g + 3];
            const float h1 = fmaxf(a, b), l1 = fminf(a, b), h2 = fmaxf(c, d), l2 = fminf(c, d); const float gs = fmaxf(h1, h2) + fmaxf(fminf(h1, h2), fmaxf(l1, l2));
            if (gs > bs) { bs = gs; best = g; } }
        const float c0 = best == 0 ? lg[0] : (best == 1 ? lg[4] : (best == 2 ? lg[8] : lg[12]));
        const float c1 = best == 0 ? lg[1] : (best == 1 ? lg[5] : (best == 2 ? lg[9] : lg[13]));
        const float c2 = best == 0 ? lg[2] : (best == 1 ? lg[6] : (best == 2 ? lg[10] : lg[14]));
        const float c3 = best == 0 ? lg[3] : (best == 1 ? lg[7] : (best == 2 ? lg[11] : lg[15]));
        int i1 = 0; float s1 = c0; if (c1 > s1) { s1 = c1; i1 = 1; } if (c2 > s1) { s1 = c2; i1 = 2; } if (c3 > s1) { s1 = c3; i1 = 3; }
        int i2 = -1; float s2 = -1.f;
        if (i1 != 0 && c0 > s2) { s2 = c0; i2 = 0; } if (i1 != 1 && c1 > s2) { s2 = c1; i2 = 1; } if (i1 != 2 && c2 > s2) { s2 = c2; i2 = 2; } if (i1 != 3 && c3 > s2) { s2 = c3; i2 = 3; }
        if (lane == 0) { const int e1 = best * 4 + i1, e2 = best * 4 + i2; const float ws_ = 1.f / (s1 + s2);
            const int p1 = (int)atomicAdd(cnt + e1, 1u), p2 = (int)atomicAdd(cnt + e2, 1u);
            LIST[e1 * T + p1] = t; LIST[e2 * T + p2] = t;
            TOKE[2 * t] = e1; TOKE[2 * t + 1] = e2; TOKP[2 * t] = p1; TOKP[2 * t + 1] = p2; TOKW[2 * t] = s1 * ws_; TOKW[2 * t + 1] = s2 * ws_; }
    }
}
__device__ __forceinline__ void stage_moe1_ref(const Params& p, int l, int blk, int nblk) {
    const int tid = threadIdx.x, lane = tid & 63, wave = tid >> 6, gw = blk * NWAVES + wave, ngw = nblk * NWAVES;
    unsigned char* ws = p.ws; const bf16* XB = (const bf16*)(ws + WS_XB); const unsigned* cnt = (const unsigned*)(ws + WS_CTL) + CW_CNT + l * 16; const int* LIST = (const int*)(ws + WS_LIST);
    bf16* H = (bf16*)(ws + WS_H);
    int total = 0;
    for (int e = 0; e < NE; ++e) total += (int)((cnt[e] + 255u) >> 8) * 256;
    const int ntask = (total / 32) * 32;
    for (int task = gw; task < ntask; task += ngw) { const int rt = task >> 5, ct = task & 31; const int row0 = rt * 32;
        int e = 0, base = 0;
        for (int q = 0; q < NE; ++q) { const int sz = (int)((cnt[q] + 255u) >> 8) * 256; if (row0 >= base + sz) { base += sz; e = q + 1; } else break; }
        const int i = row0 + (lane & 31) - base; const int tok = i < (int)cnt[e] ? LIST[e * T + i] : 0;
        const bf16* WG = (const bf16*)(ws + WS_WT_GU) + (size_t)(l * 16 + e) * 2048 * DM; const int c0 = ct * 32, pn = c0 >> 7, j0 = c0 & 127;
        const int hi = lane >> 5;
        const bf16* ap = XB + (size_t)tok * DM + 8 * hi; const bf16* gp = WG + (size_t)(256 * pn + j0 + (lane & 31)) * DM + 8 * hi; const bf16* up = gp + (size_t)128 * DM;
        f32x16 ag = {}, au = {};
        for (int k0 = 0; k0 < DM; k0 += 16) { const bf16x8 a = *(const bf16x8*)(ap + k0); ag = __builtin_amdgcn_mfma_f32_32x32x16_bf16(*(const bf16x8*)(gp + k0), a, ag, 0, 0, 0); au = __builtin_amdgcn_mfma_f32_32x32x16_bf16(*(const bf16x8*)(up + k0), a, au, 0, 0, 0); }
        const int row = row0 + (lane & 31);
#pragma unroll
        for (int g = 0; g < 4; ++g) { u32x2 o; o.x = pk2(silu_f(ag[4 * g]) * au[4 * g], silu_f(ag[4 * g + 1]) * au[4 * g + 1]); o.y = pk2(silu_f(ag[4 * g + 2]) * au[4 * g + 2], silu_f(ag[4 * g + 3]) * au[4 * g + 3]);
            *(u32x2*)(H + (size_t)row * DM + c0 + 8 * g + 4 * hi) = o; }
    }
}
__device__ __forceinline__ void stage_moe2_ref(const Params& p, int l, int blk, int nblk) {
    const int tid = threadIdx.x, lane = tid & 63, wave = tid >> 6, gw = blk * NWAVES + wave, ngw = nblk * NWAVES;
    unsigned char* ws = p.ws; const unsigned* cnt = (const unsigned*)(ws + WS_CTL) + CW_CNT + l * 16; const bf16* H = (const bf16*)(ws + WS_H); bf16* Y = (bf16*)(ws + WS_Y);
    int total = 0;
    for (int e = 0; e < NE; ++e) total += (int)((cnt[e] + 255u) >> 8) * 256;
    const int ntask = (total / 32) * 32;
    for (int task = gw; task < ntask; task += ngw) { const int rt = task >> 5, ct = task & 31; const int row0 = rt * 32;
        int e = 0, base = 0;
        for (int q = 0; q < NE; ++q) { const int sz = (int)((cnt[q] + 255u) >> 8) * 256; if (row0 >= base + sz) { base += sz; e = q + 1; } else break; }
        const bf16* WD = (const bf16*)(ws + WS_WT_DN) + (size_t)(l * 16 + e) * DM * DM; const int row = row0 + (lane & 31);
        wave_gemm_tile(H + (size_t)row * DM, WD + (size_t)(ct * 32 + (lane & 31)) * DM, DM, lane, [&](int nn, float a, float b, float c, float d) {
            u32x2 o; o.x = pk2(a, b); o.y = pk2(c, d); *(u32x2*)(Y + (size_t)row * DM + ct * 32 + nn) = o; });
    }
}
__device__ __forceinline__ void stage_ln2(const Params& p, int l, int blk, int nblk) {
    const int tid = threadIdx.x, lane = tid & 63, wave = tid >> 6, gw = blk * NWAVES + wave, ngw = nblk * NWAVES;
    unsigned char* ws = p.ws; bf16* XB = (bf16*)(ws + WS_XB); const unsigned* cnt = (const unsigned*)(ws + WS_CTL) + CW_CNT + l * 16; const bf16* Y = (const bf16*)(ws + WS_Y);
    const int* TOKE = (const int*)(ws + WS_TOKE); const int* TOKP = (const int*)(ws + WS_TOKP); const float* TOKW = (const float*)(ws + WS_TOKW); float* DT = (float*)(ws + WS_DT);
    for (int t = gw; t < T; t += ngw) {
        const int e1 = TOKE[2 * t], e2 = TOKE[2 * t + 1]; int r1 = TOKP[2 * t], r2 = TOKP[2 * t + 1]; const float w1 = TOKW[2 * t], w2 = TOKW[2 * t + 1];
        for (int e = 0; e < NE; ++e) { const int sz = (int)((cnt[e] + 255u) >> 8) * 256; if (e < e1) r1 += sz; if (e < e2) r2 += sz; }
        f32x4 v[4]; f32x4* xr = (f32x4*)(p.out + (size_t)t * DM) + lane;
#pragma unroll
        for (int j = 0; j < 4; ++j) { const f32x4 xv = xr[64 * j]; const u32x2 a = *((const u32x2*)(Y + (size_t)r1 * DM) + lane + 64 * j), b = *((const u32x2*)(Y + (size_t)r2 * DM) + lane + 64 * j);
            v[j].x = ALPHA * xv.x + (w1 * bflo(a.x) + w2 * bflo(b.x)); v[j].y = ALPHA * xv.y + (w1 * bfhi(a.x) + w2 * bfhi(b.x));
            v[j].z = ALPHA * xv.z + (w1 * bflo(a.y) + w2 * bflo(b.y)); v[j].w = ALPHA * xv.w + (w1 * bfhi(a.y) + w2 * bfhi(b.y)); }
        ln_row(v, p.ln2_g + l * DM, p.ln2_b + l * DM, lane);
        float d0 = 0.f, d1 = 0.f, d2 = 0.f, d3 = 0.f;
#pragma unroll
        for (int j = 0; j < 4; ++j) { xr[64 * j] = v[j];
            if (l + 1 < DEPTH) { u32x2 o; o.x = pk2(v[j].x, v[j].y); o.y = pk2(v[j].z, v[j].w); *((u32x2*)(XB + (size_t)t * DM) + lane + 64 * j) = o;
#pragma unroll
                for (int c = 0; c < 4; ++c) { const int k = 4 * lane + 256 * j + c; const f32x4 w = *(const f32x4*)(p.w_in + ((size_t)(l + 1) * DM + k) * NCOLS_IN + 2560); const float xv = v[j][c];
                    d0 += xv * w.x; d1 += xv * w.y; d2 += xv * w.z; d3 += xv * w.w; } } }
        if (l + 1 < DEPTH) { d0 = wave_sum(d0); d1 = wave_sum(d1); d2 = wave_sum(d2); d3 = wave_sum(d3); if (lane == 0) *(f32x4*)(DT + (size_t)t * 4) = (f32x4){d0, d1, d2, d3}; }
    }
}

template <int ST> __global__ void __launch_bounds__(NTHREADS, 2) k_stage(Params p, int l) {
    extern __shared__ __attribute__((aligned(16))) unsigned char lds[];
    const int blk = blockIdx.x, nblk = gridDim.x;
    if constexpr (ST == 0) stage_prologue(p, (LAS unsigned char*)lds, blk, nblk);
    if constexpr (ST == 1) stage_proj_ref(p, l, blk, nblk);
    if constexpr (ST == 2) { stage_attn_ref(p, l, blk, nblk); stage_memattn_ref(p, l, blk, nblk); stage_conv_ref(p, l, blk, nblk); }
    if constexpr (ST == 3) { if (blk < NB * 4) stage_ssd_ref(p, l, blk, NB * 4); else stage_merge(p, blk - NB * 4, nblk - NB * 4); }
    if constexpr (ST == 4) stage_gate_ref(p, l, blk, nblk);
    if constexpr (ST == 5) stage_out_ref(p, l, blk, nblk);
    if constexpr (ST == 6) stage_ln1_router(p, l, blk, nblk);
    if constexpr (ST == 7) stage_moe1_ref(p, l, blk, nblk);
    if constexpr (ST == 8) stage_moe2_ref(p, l, blk, nblk);
    if constexpr (ST == 9) stage_ln2(p, l, blk, nblk);
}

extern "C" void kernel_launch(void* const* d_in, const int* in_sizes, int n_in, void* d_out, int out_size, void* d_ws, size_t ws_size, hipStream_t stream) {
    if (n_in != 22 || out_size != T * DM || ws_size < WS_END) { fprintf(stderr, "kernel_launch: unexpected shapes (n_in %d out %d ws %zu)\n", n_in, out_size, ws_size); return; }
    Params p{};
    const float** pp = (const float**)&p;
    for (int i = 0; i < 22; ++i) pp[i] = (const float*)d_in[i];
    p.out = (float*)d_out; p.ws = (unsigned char*)d_ws;
    (void)hipMemsetAsync((char*)d_ws + WS_CTL, 0, CTL_ZERO_BYTES, stream);
    const int grid = 1024; const size_t LDSB = 131072;
    static bool attr = false;
    if (!attr) { (void)hipFuncSetAttribute((const void*)k_stage<0>, hipFuncAttributeMaxDynamicSharedMemorySize, (int)LDSB); attr = true; }
    hipLaunchKernelGGL(k_stage<0>, dim3(grid), dim3(NTHREADS), LDSB, stream, p, 0);
    for (int l = 0; l < DEPTH; ++l) {
        hipLaunchKernelGGL(k_stage<1>, dim3(grid), dim3(NTHREADS), 0, stream, p, l);
        hipLaunchKernelGGL(k_stage<2>, dim3(grid), dim3(NTHREADS), 0, stream, p, l);
        hipLaunchKernelGGL(k_stage<3>, dim3(grid), dim3(NTHREADS), 0, stream, p, l);
        hipLaunchKernelGGL(k_stage<4>, dim3(grid), dim3(NTHREADS), 0, stream, p, l);
        hipLaunchKernelGGL(k_stage<5>, dim3(grid), dim3(NTHREADS), 0, stream, p, l);
        hipLaunchKernelGGL(k_stage<6>, dim3(grid), dim3(NTHREADS), 0, stream, p, l);
        hipLaunchKernelGGL(k_stage<7>, dim3(grid), dim3(NTHREADS), 0, stream, p, l);
        hipLaunchKernelGGL(k_stage<8>, dim3(grid), dim3(NTHREADS), 0, stream, p, l);
        hipLaunchKernelGGL(k_stage<9>, dim3(grid), dim3(NTHREADS), 0, stream, p, l);
    }
}
```

```cpp
#include <hip/hip_runtime.h>
#include <cstdio>
#include <cstdint>

#define GAS __attribute__((address_space(1)))
#define LAS __attribute__((address_space(3)))
typedef unsigned short bf16;
typedef short bf16x8 __attribute__((ext_vector_type(8)));
typedef float f32x4 __attribute__((ext_vector_type(4)));
typedef float f32x16 __attribute__((ext_vector_type(16)));
typedef unsigned u32x4 __attribute__((ext_vector_type(4)));
typedef unsigned u32x2 __attribute__((ext_vector_type(2)));

constexpr int NB = 4, SEQ = 4096, T = NB * SEQ, DM = 1024, DEPTH = 2;
constexpr int NCOLS_IN = 2820, NPROJ = 2816;
constexpr int C_Q = 0, C_K = 512, C_V = 1024, C_Z = 1536, C_XBC = 1792, C_QM = 2560;
constexpr int NE = 16, NMEM = 256;
constexpr int HROWS = 36864;
constexpr float ALPHA = 1.41421356237309515f;
constexpr float LN_EPS = 1e-5f, RMS_EPS = 1e-5f;
constexpr int NTHREADS = 512, NWAVES = 8;

constexpr size_t MiB = 1u << 20;
constexpr size_t WS_CTL = 0, CTL_ZERO_BYTES = 1 * MiB;
constexpr size_t WS_BIAST = 1 * MiB;
constexpr size_t WS_KV = 2 * MiB;
constexpr size_t WS_MEMB = 4 * MiB;
constexpr size_t WS_WT_KV = 6 * MiB;
constexpr size_t WS_WT_OUT = 8 * MiB;
constexpr size_t WS_WT_IN = 12 * MiB;
constexpr size_t WS_WT_GU = 24 * MiB;
constexpr size_t WS_WT_DN = 152 * MiB;
constexpr size_t WS_XB = 216 * MiB;
constexpr size_t WS_MIX = 248 * MiB;
constexpr size_t WS_DT = 280 * MiB;
constexpr size_t WS_TOKE = 281 * MiB;
constexpr size_t WS_TOKP = WS_TOKE + 128 * 1024;
constexpr size_t WS_TOKW = WS_TOKP + 128 * 1024;
constexpr size_t WS_LIST = 282 * MiB;
constexpr size_t WS_SST = 284 * MiB;
constexpr size_t WS_P = 300 * MiB;
constexpr size_t WS_ATTO = 388 * MiB;
constexpr size_t WS_LSE = 436 * MiB;
constexpr size_t WS_H = 300 * MiB;
constexpr size_t WS_Y = 372 * MiB;
constexpr size_t WS_XBCC = 444 * MiB;
constexpr size_t WS_YS = 492 * MiB;
constexpr size_t WS_END = 508 * MiB;
constexpr int CW_CNT = 64;

struct Params {
    const float *x, *mem, *w_in, *w_out, *rel_bias, *conv_w, *conv_b, *dt_bias, *a_log, *d_skip, *ssd_norm_w, *w_mem_kv, *mem_bias,
        *ln1_g, *ln1_b, *ln2_g, *ln2_b, *w_router, *b_router, *w_gate, *w_up, *w_down;
    float* out; unsigned char* ws;
};

__device__ __forceinline__ unsigned f2bf(float f) { unsigned u = __builtin_bit_cast(unsigned, f); return (u + 0x7fffu + ((u >> 16) & 1u)) >> 16; }
__device__ __forceinline__ unsigned pk2(float lo, float hi) { return f2bf(lo) | (f2bf(hi) << 16); }
__device__ __forceinline__ float bf2f(unsigned b) { return __builtin_bit_cast(float, b << 16); }
__device__ __forceinline__ float bflo(unsigned w) { return __builtin_bit_cast(float, w << 16); }
__device__ __forceinline__ float bfhi(unsigned w) { return __builtin_bit_cast(float, w & 0xffff0000u); }
__device__ __forceinline__ float wave_sum(float v) {
#pragma unroll
    for (int o = 1; o < 64; o <<= 1) v += __shfl_xor(v, o);
    return v;
}
__device__ __forceinline__ float wave_max(float v) {
#pragma unroll
    for (int o = 1; o < 64; o <<= 1) v = fmaxf(v, __shfl_xor(v, o));
    return v;
}
__device__ __forceinline__ float silu_f(float v) { return v / (1.f + __expf(-v)); }
__device__ __forceinline__ float softplus_f(float v) { return v > 20.f ? v : log1pf(__expf(v)); }
__device__ __forceinline__ int crow(int r, int hi) { return (r & 3) + 8 * (r >> 2) + 4 * hi; }

__device__ __forceinline__ void transpose_item(const float* W, int ldw, int src_col0, bf16* WT, int K, int dst_row0, float scale, LAS float* scr, int k0, int lane) {
#pragma unroll 8
    for (int i = 0; i < 32; ++i) { const int kk = 2 * i + (lane >> 5); scr[kk * 33 + (lane & 31)] = W[(size_t)(k0 + kk) * ldw + src_col0 + (lane & 31)]; }
    asm volatile("s_waitcnt lgkmcnt(0)" ::: "memory");
    const int c = lane & 7;
#pragma unroll
    for (int j = 0; j < 4; ++j) { const int n = (lane >> 3) + 8 * j; const LAS float* s = scr + (8 * c) * 33 + n;
        u32x4 o; o.x = pk2(s[0 * 33] * scale, s[1 * 33] * scale); o.y = pk2(s[2 * 33] * scale, s[3 * 33] * scale); o.z = pk2(s[4 * 33] * scale, s[5 * 33] * scale); o.w = pk2(s[6 * 33] * scale, s[7 * 33] * scale);
        *(u32x4*)(WT + (size_t)(dst_row0 + n) * K + k0 + 8 * c) = o; }
    asm volatile("s_waitcnt lgkmcnt(0)" ::: "memory");
}
constexpr int I_IN = 2 * 16 * 88, I_OUT = 2 * 16 * 32, I_KV = 2 * 16 * 16, I_GU = 32 * 16 * 64, I_DN = 32 * 16 * 32;
constexpr int I_TOTAL = I_IN + I_OUT + I_KV + I_GU + I_DN;

__device__ __forceinline__ void stage_prologue(const Params& p, LAS unsigned char* lds, int blk, int nblk) {
    const int tid = threadIdx.x, lane = tid & 63, wave = tid >> 6;
    const int gw = blk * NWAVES + wave, ngw = nblk * NWAVES;
    LAS float* scr = (LAS float*)(lds + wave * 16384);
    unsigned char* ws = p.ws;
    for (int it = gw; it < I_TOTAL; it += ngw) {
        int r = it;
        if (r < I_IN) { const int l = r / (16 * 88), q = r % (16 * 88), kb = q / 88, nb = q % 88, n0 = nb * 32;
            transpose_item(p.w_in + (size_t)l * DM * NCOLS_IN, NCOLS_IN, n0 < 2560 ? n0 : n0 + 4, (bf16*)(ws + WS_WT_IN) + (size_t)l * NPROJ * DM, DM, n0, (n0 < 512 || n0 >= 2560) ? 0.125f : 1.f, scr, kb * 64, lane); continue; }
        r -= I_IN;
        if (r < I_OUT) { const int l = r / (16 * 32), q = r % (16 * 32), kb = q / 32, nb = q % 32;
            transpose_item(p.w_out + (size_t)l * DM * DM, DM, nb * 32, (bf16*)(ws + WS_WT_OUT) + (size_t)l * DM * DM, DM, nb * 32, 1.f, scr, kb * 64, lane); continue; }
        r -= I_OUT;
        if (r < I_KV) { const int l = r / (16 * 16), q = r % (16 * 16), kb = q / 16, nb = q % 16;
            transpose_item(p.w_mem_kv + (size_t)l * DM * 512, 512, nb * 32, (bf16*)(ws + WS_WT_KV) + (size_t)l * 512 * DM, DM, nb * 32, 1.f, scr, kb * 64, lane); continue; }
        r -= I_KV;
        if (r < I_GU) { const int le = r / (16 * 64), q = r % (16 * 64), kb = q / 64, nb = q % 64, n0 = nb * 32, pn = n0 >> 8, bj = (n0 >> 7) & 1, j0 = n0 & 127;
            transpose_item((bj ? p.w_up : p.w_gate) + (size_t)le * DM * DM, DM, 128 * pn + j0, (bf16*)(ws + WS_WT_GU) + (size_t)le * 2048 * DM, DM, n0, 1.f, scr, kb * 64, lane); continue; }
        r -= I_GU;
        { const int le = r / (16 * 32), q = r % (16 * 32), kb = q / 32, nb = q % 32;
            transpose_item(p.w_down + (size_t)le * DM * DM, DM, nb * 32, (bf16*)(ws + WS_WT_DN) + (size_t)le * DM * DM, DM, nb * 32, 1.f, scr, kb * 64, lane); }
    }
    {
        bf16* XB = (bf16*)(ws + WS_XB); float* DT = (float*)(ws + WS_DT);
        for (int m = gw; m < T; m += ngw) {
            const f32x4* xr = (const f32x4*)(p.x + (size_t)m * DM) + lane;
            float d0 = 0.f, d1 = 0.f, d2 = 0.f, d3 = 0.f;
#pragma unroll
            for (int j = 0; j < 4; ++j) { const f32x4 v = xr[64 * j];
                u32x2 o; o.x = pk2(v.x, v.y); o.y = pk2(v.z, v.w); *((u32x2*)(XB + (size_t)m * DM) + lane + 64 * j) = o;
#pragma unroll
                for (int c = 0; c < 4; ++c) { const int k = 4 * lane + 256 * j + c; const f32x4 w = *(const f32x4*)(p.w_in + (size_t)k * NCOLS_IN + 2560); const float xv = v[c];
                    d0 += xv * w.x; d1 += xv * w.y; d2 += xv * w.z; d3 += xv * w.w; } }
            d0 = wave_sum(d0); d1 = wave_sum(d1); d2 = wave_sum(d2); d3 = wave_sum(d3);
            if (lane == 0) *(f32x4*)(DT + (size_t)m * 4) = (f32x4){d0, d1, d2, d3};
        }
    }
    {
        bf16* MB = (bf16*)(ws + WS_MEMB);
        for (int m = gw; m < NB * NMEM; m += ngw) {
            const f32x4* xr = (const f32x4*)(p.mem + (size_t)m * DM) + lane;
#pragma unroll
            for (int j = 0; j < 4; ++j) { const f32x4 v = xr[64 * j]; u32x2 o; o.x = pk2(v.x, v.y); o.y = pk2(v.z, v.w); *((u32x2*)(MB + (size_t)m * DM) + lane + 64 * j) = o; }
        }
    }
    if (blk == 0) {
        float* BT = (float*)(ws + WS_BIAST);
        for (int i = tid; i < 3 * 129; i += NTHREADS) { const int br = i / 129, st = i % 129, dil = br == 0 ? 1 : (br == 1 ? 4 : 16), n = st * dil; int bucket;
            if (n < 16) bucket = n; else { const float nf = (float)n; int lg = 16 + (int)(logf(nf / 16.f) / logf(128.f) * 16.f); bucket = lg < 31 ? lg : 31; }
#pragma unroll
            for (int h = 0; h < 8; ++h) BT[(br * 8 + h) * 132 + st] = p.rel_bias[bucket * 8 + h]; }
    }
}

template <class RowPtr, class Epi>
__device__ __forceinline__ void wave_gemm_tile(RowPtr arow  , const bf16* brow  , int K, int lane, Epi epi) {
    const int hi = lane >> 5;
    const bf16* ap = arow + 8 * hi; const bf16* bp = brow + 8 * hi;
    f32x16 acc = {};
    for (int k0 = 0; k0 < K; k0 += 16) { const bf16x8 a = *(const bf16x8*)(ap + k0); const bf16x8 b = *(const bf16x8*)(bp + k0); acc = __builtin_amdgcn_mfma_f32_32x32x16_bf16(b, a, acc, 0, 0, 0); }
#pragma unroll
    for (int g = 0; g < 4; ++g) epi(8 * g + 4 * hi, acc[4 * g], acc[4 * g + 1], acc[4 * g + 2], acc[4 * g + 3]);
}

__device__ __forceinline__ void stage_proj_ref(const Params& p, int l, int blk, int nblk) {
    const int tid = threadIdx.x, lane = tid & 63, wave = tid >> 6, gw = blk * NWAVES + wave, ngw = nblk * NWAVES;
    unsigned char* ws = p.ws;
    const bf16* XB = (const bf16*)(ws + WS_XB); const bf16* WT = (const bf16*)(ws + WS_WT_IN) + (size_t)l * NPROJ * DM; bf16* P = (bf16*)(ws + WS_P);
    constexpr int NT = NPROJ / 32, MT = T / 32;
    for (int tile = gw; tile < MT * NT; tile += ngw) { const int tm = tile / NT, tn = tile % NT; const int m = tm * 32 + (lane & 31);
        wave_gemm_tile(XB + (size_t)m * DM, WT + (size_t)(tn * 32 + (lane & 31)) * DM, DM, lane, [&](int nn, float a, float b, float c, float d) {
            u32x2 o; o.x = pk2(a, b); o.y = pk2(c, d); *(u32x2*)(P + (size_t)m * NPROJ + tn * 32 + nn) = o; }); }
    if (l == 0) {
        const bf16* MB = (const bf16*)(ws + WS_MEMB);
        constexpr int NT2 = 512 / 32, MT2 = NB * NMEM / 32;
        for (int tile = gw; tile < 2 * MT2 * NT2; tile += ngw) { const int ll = tile / (MT2 * NT2), q = tile % (MT2 * NT2), tm = q / NT2, tn = q % NT2; const int m = tm * 32 + (lane & 31);
            const bf16* WK = (const bf16*)(ws + WS_WT_KV) + (size_t)ll * 512 * DM; bf16* KV = (bf16*)(ws + WS_KV) + (size_t)ll * 1024 * 512;
            wave_gemm_tile(MB + (size_t)m * DM, WK + (size_t)(tn * 32 + (lane & 31)) * DM, DM, lane, [&](int nn, float a, float b, float c, float d) {
                u32x2 o; o.x = pk2(a, b); o.y = pk2(c, d); *(u32x2*)(KV + (size_t)m * 512 + tn * 32 + nn) = o; }); }
    }
}

__device__ __forceinline__ float dot64(const bf16* row, const unsigned (&qw)[32]) {
    float s = 0.f;
#pragma unroll
    for (int c = 0; c < 8; ++c) { const u32x4 kv = *(const u32x4*)(row + 8 * c);
        s += bflo(kv.x) * bflo(qw[4 * c]) + bfhi(kv.x) * bfhi(qw[4 * c]); s += bflo(kv.y) * bflo(qw[4 * c + 1]) + bfhi(kv.y) * bfhi(qw[4 * c + 1]);
        s += bflo(kv.z) * bflo(qw[4 * c + 2]) + bfhi(kv.z) * bfhi(qw[4 * c + 2]); s += bflo(kv.w) * bflo(qw[4 * c + 3]) + bfhi(kv.w) * bfhi(qw[4 * c + 3]); }
    return s;
}
__device__ __forceinline__ void stage_attn_ref(const Params& p, int l, int blk, int nblk) {
    const int tid = threadIdx.x, lane = tid & 63, wave = tid >> 6, gw = blk * NWAVES + wave, ngw = nblk * NWAVES;
    unsigned char* ws = p.ws; const bf16* P = (const bf16*)(ws + WS_P); const float* BT = (const float*)(ws + WS_BIAST);
    bf16* AO = (bf16*)(ws + WS_ATTO); float* LSE = (float*)(ws + WS_LSE);
    for (int task = gw; task < 3 * T * 8; task += ngw) {
        const int br = task / (T * 8), q = task % (T * 8), t = q >> 3, h = q & 7, s = t % SEQ, dil = br == 0 ? 1 : (br == 1 ? 4 : 16);
        unsigned qw[32];
        { const u32x4* qp = (const u32x4*)(P + (size_t)t * NPROJ + C_Q + h * 64);
#pragma unroll
            for (int c = 0; c < 8; ++c) { const u32x4 v = qp[c]; qw[4 * c] = v.x; qw[4 * c + 1] = v.y; qw[4 * c + 2] = v.z; qw[4 * c + 3] = v.w; } }
        float sc[3];
#pragma unroll
        for (int kk = 0; kk < 3; ++kk) { const int st = lane + 64 * kk; const bool valid = st <= 128 && s - st * dil >= 0; sc[kk] = -INFINITY;
            if (valid) sc[kk] = dot64(P + (size_t)(t - st * dil) * NPROJ + C_K + h * 64, qw) + BT[(br * 8 + h) * 132 + st]; }
        const float mx = wave_max(fmaxf(fmaxf(sc[0], sc[1]), sc[2]));
        float pr[3], ls = 0.f;
#pragma unroll
        for (int kk = 0; kk < 3; ++kk) { pr[kk] = __expf(sc[kk] - mx); ls += pr[kk]; }
        ls = wave_sum(ls);
        float o = 0.f;
        const int nst = min(128, s / dil);
        for (int st = 0; st <= nst; ++st) { const float pj = __shfl(st < 64 ? pr[0] : (st < 128 ? pr[1] : pr[2]), st & 63);
            o += pj * bf2f(P[(size_t)(t - st * dil) * NPROJ + C_V + h * 64 + lane]); }
        AO[((size_t)br * T + t) * 512 + h * 64 + lane] = (bf16)f2bf(o / ls);
        if (lane == 0) LSE[((size_t)br * T + t) * 8 + h] = mx + __logf(ls);
    }
}
__device__ __forceinline__ void stage_merge(const Params& p, int blk, int nblk) {
    const int tid = threadIdx.x, lane = tid & 63, wave = tid >> 6, gw = blk * NWAVES + wave, ngw = nblk * NWAVES;
    unsigned char* ws = p.ws; const bf16* AO = (const bf16*)(ws + WS_ATTO); const float* LSE = (const float*)(ws + WS_LSE); bf16* MIX = (bf16*)(ws + WS_MIX);
    for (int t = gw; t < T; t += ngw) {
        const int h = lane >> 3;
        const float l0 = LSE[((size_t)0 * T + t) * 8 + h], l1 = LSE[((size_t)1 * T + t) * 8 + h], l2 = LSE[((size_t)2 * T + t) * 8 + h];
        const float mx = fmaxf(fmaxf(l0, l1), l2); float w0 = __expf(l0 - mx), w1 = __expf(l1 - mx), w2 = __expf(l2 - mx); const float inv = 1.f / (w0 + w1 + w2); w0 *= inv; w1 *= inv; w2 *= inv;
        const u32x4 a = *(const u32x4*)(AO + ((size_t)0 * T + t) * 512 + lane * 8), b = *(const u32x4*)(AO + ((size_t)1 * T + t) * 512 + lane * 8), c = *(const u32x4*)(AO + ((size_t)2 * T + t) * 512 + lane * 8);
        u32x4 o;
#pragma unroll
        for (int i = 0; i < 4; ++i) o[i] = pk2(w0 * bflo(a[i]) + w1 * bflo(b[i]) + w2 * bflo(c[i]), w0 * bfhi(a[i]) + w1 * bfhi(b[i]) + w2 * bfhi(c[i]));
        *(u32x4*)(MIX + (size_t)t * DM + lane * 8) = o;
    }
}
__device__ __forceinline__ void stage_memattn_ref(const Params& p, int l, int blk, int nblk) {
    const int tid = threadIdx.x, lane = tid & 63, wave = tid >> 6, gw = blk * NWAVES + wave, ngw = nblk * NWAVES;
    unsigned char* ws = p.ws; const bf16* P = (const bf16*)(ws + WS_P); const bf16* KV = (const bf16*)(ws + WS_KV) + (size_t)l * 1024 * 512; bf16* MIX = (bf16*)(ws + WS_MIX);
    for (int task = gw; task < T * 4; task += ngw) {
        const int t = task >> 2, h = task & 3, b = t / SEQ;
        unsigned qw[32];
        { const u32x4* qp = (const u32x4*)(P + (size_t)t * NPROJ + C_QM + h * 64);
#pragma unroll
            for (int c = 0; c < 8; ++c) { const u32x4 v = qp[c]; qw[4 * c] = v.x; qw[4 * c + 1] = v.y; qw[4 * c + 2] = v.z; qw[4 * c + 3] = v.w; } }
        float sc[4];
#pragma unroll
        for (int kk = 0; kk < 4; ++kk) { const int j = lane + 64 * kk; sc[kk] = dot64(KV + (size_t)(b * NMEM + j) * 512 + h * 64, qw) + p.mem_bias[(l * 4 + h) * NMEM + j]; }
        const float mx = wave_max(fmaxf(fmaxf(sc[0], sc[1]), fmaxf(sc[2], sc[3])));
        float pr[4], ls = 0.f;
#pragma unroll
        for (int kk = 0; kk < 4; ++kk) { pr[kk] = __expf(sc[kk] - mx); ls += pr[kk]; }
        ls = wave_sum(ls);
        float o = 0.f;
        for (int j = 0; j < NMEM; ++j) { const int kk = j >> 6; const float pj = __shfl(kk == 0 ? pr[0] : (kk == 1 ? pr[1] : (kk == 2 ? pr[2] : pr[3])), j & 63);
            o += pj * bf2f(KV[(size_t)(b * NMEM + j) * 512 + 256 + h * 64 + lane]); }
        MIX[(size_t)t * DM + 768 + h * 64 + lane] = (bf16)f2bf(o / ls);
    }
}
__device__ __forceinline__ void stage_conv_ref(const Params& p, int l, int blk, int nblk) {
    unsigned char* ws = p.ws; const bf16* P = (const bf16*)(ws + WS_P); float* XC = (float*)(ws + WS_XBCC);
    const float* cw = p.conv_w + (size_t)l * 4 * 768; const float* cb = p.conv_b + (size_t)l * 768;
    for (size_t i = (size_t)blk * NTHREADS + threadIdx.x; i < (size_t)T * 768; i += (size_t)nblk * NTHREADS) {
        const int t = (int)(i / 768), c = (int)(i % 768), s = t % SEQ; float a = cb[c];
#pragma unroll
        for (int k = 0; k < 4; ++k) { const int sp = s + k - 3; if (sp >= 0) a += cw[k * 768 + c] * bf2f(P[(size_t)(t + k - 3) * NPROJ + C_XBC + c]); }
        XC[i] = silu_f(a);
    }
}
__device__ __forceinline__ void stage_ssd_ref(const Params& p, int l, int blk, int nblk) {
    unsigned char* ws = p.ws; const float* XC = (const float*)(ws + WS_XBCC); const float* DT = (const float*)(ws + WS_DT); float* YS = (float*)(ws + WS_YS);
    const int tid = threadIdx.x;
    for (int u = blk; u < NB * 4; u += nblk) {
        const int b = u >> 2, h = u & 3, g = h >> 1, pp = tid >> 3, ns = (tid & 7) * 16;
        const float a = -__expf(p.a_log[l * 4 + h]), dtb = p.dt_bias[l * 4 + h], Dh = p.d_skip[l * 4 + h];
        float hst[16];
#pragma unroll
        for (int i = 0; i < 16; ++i) hst[i] = 0.f;
        for (int s = 0; s < SEQ; ++s) { const size_t t = (size_t)b * SEQ + s;
            const float dt = softplus_f(DT[t * 4 + h] + dtb), da = __expf(a * dt);
            const float xv = XC[t * 768 + h * 64 + pp], xd = xv * dt;
            const f32x4* Bp = (const f32x4*)(XC + t * 768 + 256 + g * 128 + ns); const f32x4* Cp = (const f32x4*)(XC + t * 768 + 512 + g * 128 + ns);
            float acc = 0.f;
#pragma unroll
            for (int i4 = 0; i4 < 4; ++i4) { const f32x4 bv = Bp[i4], cv = Cp[i4];
#pragma unroll
                for (int c = 0; c < 4; ++c) { float& hh = hst[4 * i4 + c]; hh = hh * da + xd * bv[c]; acc += cv[c] * hh; } }
            acc += __shfl_xor(acc, 1); acc += __shfl_xor(acc, 2); acc += __shfl_xor(acc, 4);
            if ((tid & 7) == 0) YS[t * 256 + h * 64 + pp] = acc + Dh * xv;
        }
    }
}
__device__ __forceinline__ void stage_gate_ref(const Params& p, int l, int blk, int nblk) {
    const int tid = threadIdx.x, lane = tid & 63, wave = tid >> 6, gw = blk * NWAVES + wave, ngw = nblk * NWAVES;
    unsigned char* ws = p.ws; const bf16* P = (const bf16*)(ws + WS_P); const float* YS = (const float*)(ws + WS_YS); bf16* MIX = (bf16*)(ws + WS_MIX);
    const f32x4 nw = *(const f32x4*)(p.ssd_norm_w + l * 256 + 4 * lane);
    for (int t = gw; t < T; t += ngw) {
        f32x4 y = *(const f32x4*)(YS + (size_t)t * 256 + 4 * lane); const u32x2 zw = *(const u32x2*)(P + (size_t)t * NPROJ + C_Z + 4 * lane);
        y.x *= silu_f(bflo(zw.x)); y.y *= silu_f(bfhi(zw.x)); y.z *= silu_f(bflo(zw.y)); y.w *= silu_f(bfhi(zw.y));
        const float ms = wave_sum(y.x * y.x + y.y * y.y + y.z * y.z + y.w * y.w) * (1.f / 256.f); const float r = 1.f / sqrtf(ms + RMS_EPS);
        u32x2 o; o.x = pk2(y.x * r * nw.x, y.y * r * nw.y); o.y = pk2(y.z * r * nw.z, y.w * r * nw.w);
        *(u32x2*)(MIX + (size_t)t * DM + 512 + 4 * lane) = o;
    }
}
__device__ __forceinline__ void stage_out_ref(const Params& p, int l, int blk, int nblk) {
    const int tid = threadIdx.x, lane = tid & 63, wave = tid >> 6, gw = blk * NWAVES + wave, ngw = nblk * NWAVES;
    unsigned char* ws = p.ws; const bf16* MIX = (const bf16*)(ws + WS_MIX); const bf16* WT = (const bf16*)(ws + WS_WT_OUT) + (size_t)l * DM * DM;
    const float* xin = l == 0 ? p.x : p.out; float* out = p.out;
    constexpr int NT = DM / 32, MT = T / 32;
    for (int tile = gw; tile < MT * NT; tile += ngw) { const int tm = tile / NT, tn = tile % NT; const int m = tm * 32 + (lane & 31);
        wave_gemm_tile(MIX + (size_t)m * DM, WT + (size_t)(tn * 32 + (lane & 31)) * DM, DM, lane, [&](int nn, float a, float b, float c, float d) {
            const size_t off = (size_t)m * DM + tn * 32 + nn; const f32x4 xv = *(const f32x4*)(xin + off);
            *(f32x4*)(out + off) = (f32x4){ALPHA * xv.x + a, ALPHA * xv.y + b, ALPHA * xv.z + c, ALPHA * xv.w + d}; }); }
}

__device__ __forceinline__ void ln_row(f32x4 (&v)[4], const float* g, const float* bta, int lane) {
    float s = 0.f;
#pragma unroll
    for (int j = 0; j < 4; ++j) s += (v[j].x + v[j].y) + (v[j].z + v[j].w);
    const float mean = wave_sum(s) * (1.f / DM); float s2 = 0.f;
#pragma unroll
    for (int j = 0; j < 4; ++j) { v[j] = v[j] - mean; s2 += (v[j].x * v[j].x + v[j].y * v[j].y) + (v[j].z * v[j].z + v[j].w * v[j].w); }
    const float rstd = 1.f / sqrtf(wave_sum(s2) * (1.f / DM) + LN_EPS);
#pragma unroll
    for (int j = 0; j < 4; ++j) { const f32x4 gg = *((const f32x4*)g + lane + 64 * j), bb = *((const f32x4*)bta + lane + 64 * j); v[j] = v[j] * rstd * gg + bb; }
}
__device__ __forceinline__ void stage_ln1_router(const Params& p, int l, int blk, int nblk) {
    const int tid = threadIdx.x, lane = tid & 63, wave = tid >> 6, gw = blk * NWAVES + wave, ngw = nblk * NWAVES;
    unsigned char* ws = p.ws; bf16* XB = (bf16*)(ws + WS_XB); unsigned* cnt = (unsigned*)(ws + WS_CTL) + CW_CNT + l * 16;
    int* TOKE = (int*)(ws + WS_TOKE); int* TOKP = (int*)(ws + WS_TOKP); float* TOKW = (float*)(ws + WS_TOKW); int* LIST = (int*)(ws + WS_LIST);
    for (int t = gw; t < T; t += ngw) {
        asm volatile("" ::: "memory");
        f32x4 v[4]; f32x4* xr = (f32x4*)(p.out + (size_t)t * DM) + lane;
#pragma unroll
        for (int j = 0; j < 4; ++j) v[j] = xr[64 * j];
        ln_row(v, p.ln1_g + l * DM, p.ln1_b + l * DM, lane);
        float lg[16];
#pragma unroll
        for (int e = 0; e < 16; ++e) lg[e] = 0.f;
#pragma unroll
        for (int j = 0; j < 4; ++j) { xr[64 * j] = v[j]; u32x2 o; o.x = pk2(v[j].x, v[j].y); o.y = pk2(v[j].z, v[j].w); *((u32x2*)(XB + (size_t)t * DM) + lane + 64 * j) = o;
#pragma unroll
            for (int c = 0; c < 4; ++c) { const int k = 4 * lane + 256 * j + c; const float xv = v[j][c]; const f32x4* wr = (const f32x4*)(p.w_router + (size_t)k * 16);
#pragma unroll
                for (int q = 0; q < 4; ++q) { const f32x4 w = wr[q]; lg[4 * q] += xv * w.x; lg[4 * q + 1] += xv * w.y; lg[4 * q + 2] += xv * w.z; lg[4 * q + 3] += xv * w.w; } } }
        float mx = -INFINITY;
#pragma unroll
        for (int e = 0; e < 16; ++e) { lg[e] = wave_sum(lg[e]) + p.b_router[e]; mx = fmaxf(mx, lg[e]); }
        float sum = 0.f;
#pragma unroll
        for (int e = 0; e < 16; ++e) { lg[e] = __expf(lg[e] - mx); sum += lg[e]; }
        const float inv = 1.f / sum;
#pragma unroll
        for (int e = 0; e < 16; ++e) lg[e] *= inv;
        int best = 0; float bs = -1.f;
#pragma unroll
        for (int g = 0; g < 4; ++g) { const float a = lg[4 * g], b = lg[4 * g + 1], c = lg[4 * g + 2], d = lg[4 * g + 3];
            const float h1 = fmaxf(a, b), l1 = fminf(a, b), h2 = fmaxf(c, d), l2 = fminf(c, d); const float gs = fmaxf(h1, h2) + fmaxf(fminf(h1, h2), fmaxf(l1, l2));
            if (gs > bs) { bs = gs; best = g; } }
        const float c0 = best == 0 ? lg[0] : (best == 1 ? lg[4] : (best == 2 ? lg[8] : lg[12]));
        const float c1 = best == 0 ? lg[1] : (best == 1 ? lg[5] : (best == 2 ? lg[9] : lg[13]));
        const float c2 = best == 0 ? lg[2] : (best == 1 ? lg[6] : (best == 2 ? lg[10] : lg[14]));
        const float c3 = best == 0 ? lg[3] : (best == 1 ? lg[7] : (best == 2 ? lg[11] : lg[15]));
        int i1 = 0; float s1 = c0; if (c1 > s1) { s1 = c1; i1 = 1; } if (c2 > s1) { s1 = c2; i1 = 2; } if (c3 > s1) { s1 = c3; i1 = 3; }
        int i2 = -1; float s2 = -1.f;
        if (i1 != 0 && c0 > s2) { s2 = c0; i2 = 0; } if (i1 != 1 && c1 > s2) { s2 = c1; i2 = 1; } if (i1 != 2 && c2 > s2) { s2 = c2; i2 = 2; } if (i1 != 3 && c3 > s2) { s2 = c3; i2 = 3; }
        if (lane == 0) { const int e1 = best * 4 + i1, e2 = best * 4 + i2; const float ws_ = 1.f / (s1 + s2);
            const int p1 = (int)atomicAdd(cnt + e1, 1u), p2 = (int)atomicAdd(cnt + e2, 1u);
            LIST[e1 * T + p1] = t; LIST[e2 * T + p2] = t;
            TOKE[2 * t] = e1; TOKE[2 * t + 1] = e2; TOKP[2 * t] = p1; TOKP[2 * t + 1] = p2; TOKW[2 * t] = s1 * ws_; TOKW[2 * t + 1] = s2 * ws_; }
    }
}
__device__ __forceinline__ void stage_moe1_ref(const Params& p, int l, int blk, int nblk) {
    const int tid = threadIdx.x, lane = tid & 63, wave = tid >> 6, gw = blk * NWAVES + wave, ngw = nblk * NWAVES;
    unsigned char* ws = p.ws; const bf16* XB = (const bf16*)(ws + WS_XB); const unsigned* cnt = (const unsigned*)(ws + WS_CTL) + CW_CNT + l * 16; const int* LIST = (const int*)(ws + WS_LIST);
    bf16* H = (bf16*)(ws + WS_H);
    int total = 0;
    for (int e = 0; e < NE; ++e) total += (int)((cnt[e] + 255u) >> 8) * 256;
    const int ntask = (total / 32) * 32;
    for (int task = gw; task < ntask; task += ngw) { const int rt = task >> 5, ct = task & 31; const int row0 = rt * 32;
        int e = 0, base = 0;
        for (int q = 0; q < NE; ++q) { const int sz = (int)((cnt[q] + 255u) >> 8) * 256; if (row0 >= base + sz) { base += sz; e = q + 1; } else break; }
        const int i = row0 + (lane & 31) - base; const int tok = i < (int)cnt[e] ? LIST[e * T + i] : 0;
        const bf16* WG = (const bf16*)(ws + WS_WT_GU) + (size_t)(l * 16 + e) * 2048 * DM; const int c0 = ct * 32, pn = c0 >> 7, j0 = c0 & 127;
        const int hi = lane >> 5;
        const bf16* ap = XB + (size_t)tok * DM + 8 * hi; const bf16* gp = WG + (size_t)(256 * pn + j0 + (lane & 31)) * DM + 8 * hi; const bf16* up = gp + (size_t)128 * DM;
        f32x16 ag = {}, au = {};
        for (int k0 = 0; k0 < DM; k0 += 16) { const bf16x8 a = *(const bf16x8*)(ap + k0); ag = __builtin_amdgcn_mfma_f32_32x32x16_bf16(*(const bf16x8*)(gp + k0), a, ag, 0, 0, 0); au = __builtin_amdgcn_mfma_f32_32x32x16_bf16(*(const bf16x8*)(up + k0), a, au, 0, 0, 0); }
        const int row = row0 + (lane & 31);
#pragma unroll
        for (int g = 0; g < 4; ++g) { u32x2 o; o.x = pk2(silu_f(ag[4 * g]) * au[4 * g], silu_f(ag[4 * g + 1]) * au[4 * g + 1]); o.y = pk2(silu_f(ag[4 * g + 2]) * au[4 * g + 2], silu_f(ag[4 * g + 3]) * au[4 * g + 3]);
            *(u32x2*)(H + (size_t)row * DM + c0 + 8 * g + 4 * hi) = o; }
    }
}
__device__ __forceinline__ void stage_moe2_ref(const Params& p, int l, int blk, int nblk) {
    const int tid = threadIdx.x, lane = tid & 63, wave = tid >> 6, gw = blk * NWAVES + wave, ngw = nblk * NWAVES;
    unsigned char* ws = p.ws; const unsigned* cnt = (const unsigned*)(ws + WS_CTL) + CW_CNT + l * 16; const bf16* H = (const bf16*)(ws + WS_H); bf16* Y = (bf16*)(ws + WS_Y);
    int total = 0;
    for (int e = 0; e < NE; ++e) total += (int)((cnt[e] + 255u) >> 8) * 256;
    const int ntask = (total / 32) * 32;
    for (int task = gw; task < ntask; task += ngw) { const int rt = task >> 5, ct = task & 31; const int row0 = rt * 32;
        int e = 0, base = 0;
        for (int q = 0; q < NE; ++q) { const int sz = (int)((cnt[q] + 255u) >> 8) * 256; if (row0 >= base + sz) { base += sz; e = q + 1; } else break; }
        const bf16* WD = (const bf16*)(ws + WS_WT_DN) + (size_t)(l * 16 + e) * DM * DM; const int row = row0 + (lane & 31);
        wave_gemm_tile(H + (size_t)row * DM, WD + (size_t)(ct * 32 + (lane & 31)) * DM, DM, lane, [&](int nn, float a, float b, float c, float d) {
            u32x2 o; o.x = pk2(a, b); o.y = pk2(c, d); *(u32x2*)(Y + (size_t)row * DM + ct * 32 + nn) = o; });
    }
}
__device__ __forceinline__ void stage_ln2(const Params& p, int l, int blk, int nblk) {
    const int tid = threadIdx.x, lane = tid & 63, wave = tid >> 6, gw = blk * NWAVES + wave, ngw = nblk * NWAVES;
    unsigned char* ws = p.ws; bf16* XB = (bf16*)(ws + WS_XB); const unsigned* cnt = (const unsigned*)(ws + WS_CTL) + CW_CNT + l * 16; const bf16* Y = (const bf16*)(ws + WS_Y);
    const int* TOKE = (const int*)(ws + WS_TOKE); const int* TOKP = (const int*)(ws + WS_TOKP); const float* TOKW = (const float*)(ws + WS_TOKW); float* DT = (float*)(ws + WS_DT);
    for (int t = gw; t < T; t += ngw) {
        asm volatile("" ::: "memory");
        const int e1 = TOKE[2 * t], e2 = TOKE[2 * t + 1]; int r1 = TOKP[2 * t], r2 = TOKP[2 * t + 1]; const float w1 = TOKW[2 * t], w2 = TOKW[2 * t + 1];
        for (int e = 0; e < NE; ++e) { const int sz = (int)((cnt[e] + 255u) >> 8) * 256; if (e < e1) r1 += sz; if (e < e2) r2 += sz; }
        f32x4 v[4]; f32x4* xr = (f32x4*)(p.out + (size_t)t * DM) + lane;
#pragma unroll
        for (int j = 0; j < 4; ++j) { const f32x4 xv = xr[64 * j]; const u32x2 a = *((const u32x2*)(Y + (size_t)r1 * DM) + lane + 64 * j), b = *((const u32x2*)(Y + (size_t)r2 * DM) + lane + 64 * j);
            v[j].x = ALPHA * xv.x + (w1 * bflo(a.x) + w2 * bflo(b.x)); v[j].y = ALPHA * xv.y + (w1 * bfhi(a.x) + w2 * bfhi(b.x));
            v[j].z = ALPHA * xv.z + (w1 * bflo(a.y) + w2 * bflo(b.y)); v[j].w = ALPHA * xv.w + (w1 * bfhi(a.y) + w2 * bfhi(b.y)); }
        ln_row(v, p.ln2_g + l * DM, p.ln2_b + l * DM, lane);
        float d0 = 0.f, d1 = 0.f, d2 = 0.f, d3 = 0.f;
#pragma unroll
        for (int j = 0; j < 4; ++j) { xr[64 * j] = v[j];
            if (l + 1 < DEPTH) { u32x2 o; o.x = pk2(v[j].x, v[j].y); o.y = pk2(v[j].z, v[j].w); *((u32x2*)(XB + (size_t)t * DM) + lane + 64 * j) = o;
#pragma unroll
                for (int c = 0; c < 4; ++c) { const int k = 4 * lane + 256 * j + c; const f32x4 w = *(const f32x4*)(p.w_in + ((size_t)(l + 1) * DM + k) * NCOLS_IN + 2560); const float xv = v[j][c];
                    d0 += xv * w.x; d1 += xv * w.y; d2 += xv * w.z; d3 += xv * w.w; } } }
        if (l + 1 < DEPTH) { d0 = wave_sum(d0); d1 = wave_sum(d1); d2 = wave_sum(d2); d3 = wave_sum(d3); if (lane == 0) *(f32x4*)(DT + (size_t)t * 4) = (f32x4){d0, d1, d2, d3}; }
    }
}


constexpr int CW_BAR = 4096;
#define XB_TMO      128
#define XB_XCNT(j)  (256  + 64 * (j))
#define XB_XSUB(j)  (1280 + 64 * (j))
#define XB_XGEN(j)  (2304 + 64 * (j))
#define XB_TOP      3328
#define XB_TOPGEN   3392
#define XCD_BAR_WORDS 3456
#define XB_SPIN_CAP (1u << 18)

__device__ __forceinline__ unsigned xb_ld(unsigned* p)              { return __hip_atomic_load(p, __ATOMIC_RELAXED, __HIP_MEMORY_SCOPE_AGENT); }
__device__ __forceinline__ unsigned xb_add(unsigned* p, unsigned v) { return __hip_atomic_fetch_add(p, v, __ATOMIC_RELAXED, __HIP_MEMORY_SCOPE_AGENT); }
__device__ __forceinline__ unsigned xb_xcc_id() { return (unsigned)__builtin_amdgcn_s_getreg((3 << 11) | 20) & 0xFu; }
#define XB_SPIN(cond, bar) do { unsigned _sp = 0; while (cond) { __builtin_amdgcn_s_sleep(1); \
    if ((++_sp & 255u) == 0u) { if (xb_ld(&(bar)[XB_TMO])) break; if (_sp > XB_SPIN_CAP) { atomicAdd(&(bar)[XB_TMO], 1u); break; } } } } while (0)

struct XcdBarrier {
    unsigned* bar; unsigned x;
    volatile LAS unsigned* st;
};

__device__ __forceinline__ XcdBarrier xcd_barrier_post(unsigned* bar, volatile LAS unsigned* st) {
    XcdBarrier b; b.bar = bar; b.x = xb_xcc_id(); b.st = st;
    if (threadIdx.x == 0) (void)xb_add(&bar[XB_XCNT(b.x)], 1u);
    return b;
}
__device__ __forceinline__ void xcd_barrier_complete(unsigned* bar, unsigned x, unsigned& nloc, unsigned& nx) {
    const unsigned G = gridDim.x * gridDim.y * gridDim.z;
    unsigned sum, cnt, mine, sp = 0u;
    for (;;) {
        sum = 0u; cnt = 0u; mine = 0u;
#pragma unroll
        for (unsigned j = 0; j < 16; ++j) { const unsigned c = xb_ld(&bar[XB_XCNT(j)]); sum += c; cnt += (c > 0u) ? 1u : 0u; mine = (j == x) ? c : mine; }
        if (sum == G) break;
        __builtin_amdgcn_s_sleep(1);
        if ((++sp & 255u) == 0u) { if (xb_ld(&bar[XB_TMO])) break; if (sp > XB_SPIN_CAP) { atomicAdd(&bar[XB_TMO], 1u); break; } }
    }
    nloc = mine > 0u ? mine : 1u; nx = cnt > 0u ? cnt : 1u;
}

__device__ __forceinline__ void xcd_barrier(const XcdBarrier& b) {
    asm volatile("s_waitcnt vmcnt(0)" ::: "memory");
    __syncthreads();
    if (threadIdx.x == 0) {
        unsigned* bar = b.bar;
        __builtin_amdgcn_s_waitcnt(0);
        unsigned nloc = b.st[0], nx = b.st[1];
        if (nloc == 0u) { xcd_barrier_complete(bar, b.x, nloc, nx); b.st[0] = nloc; b.st[1] = nx; }
        const unsigned old = xb_add(&bar[XB_XSUB(b.x)], 1u);
        const unsigned gen = old / nloc;
        if (old + 1u == (gen + 1u) * nloc) {
            __builtin_amdgcn_fence(__ATOMIC_RELEASE, "agent");
            asm volatile("s_waitcnt vmcnt(0)" ::: "memory");
            const unsigned og = xb_add(&bar[XB_TOP], 1u);
            const unsigned tg = og / nx;
            if (og + 1u == (tg + 1u) * nx) xb_add(&bar[XB_TOPGEN], 1u);
            else XB_SPIN(xb_ld(&bar[XB_TOPGEN]) == tg, bar);
            __builtin_amdgcn_fence(__ATOMIC_ACQUIRE, "agent");
            xb_add(&bar[XB_XGEN(b.x)], 1u);
            asm volatile("s_waitcnt vmcnt(0)" ::: "memory");
        } else {
            XB_SPIN(xb_ld(&bar[XB_XGEN(b.x)]) == gen, bar);
            __builtin_amdgcn_fence(__ATOMIC_ACQUIRE, "agent");
            asm volatile("s_waitcnt vmcnt(0)" ::: "memory");
        }
    }
    __syncthreads();
}

constexpr int RING_BYTES = 131072;
constexpr int MISC_OFF = RING_BYTES + 320;
constexpr int LDS_BYTES = 147456;


__device__ __forceinline__ void launder(Params& q) {
#define LND(f) asm volatile("" : "+s"(q.f))
    LND(x); LND(mem); LND(w_in); LND(w_out); LND(rel_bias); LND(conv_w); LND(conv_b); LND(dt_bias); LND(a_log); LND(d_skip); LND(ssd_norm_w); LND(w_mem_kv); LND(mem_bias);
    LND(ln1_g); LND(ln1_b); LND(ln2_g); LND(ln2_b); LND(w_router); LND(b_router); LND(w_gate); LND(w_up); LND(w_down); LND(out); LND(ws);
#undef LND
}
__global__ void __launch_bounds__(NTHREADS, 2) mega_fwd(Params p) {
    extern __shared__ __attribute__((aligned(16))) unsigned char lds_raw[];
    LAS unsigned char* lds = (LAS unsigned char*)lds_raw;
    const int tid = threadIdx.x, blk = blockIdx.x, nblk = gridDim.x;
    for (int u = tid; u < (LDS_BYTES - RING_BYTES) / 4; u += NTHREADS) ((LAS unsigned*)(lds + RING_BYTES))[u] = 0u;
    __syncthreads();
    volatile LAS unsigned* MISC = (volatile LAS unsigned*)(lds + MISC_OFF);
    XcdBarrier bar = xcd_barrier_post((unsigned*)(p.ws + WS_CTL) + CW_BAR, MISC + 8);
#define GRID_BAR() xcd_barrier(bar)
    stage_prologue(p, lds, blk, nblk);
    GRID_BAR();
#pragma unroll 1
    for (int l = 0; l < DEPTH; ++l) {
        Params q = p; launder(q);
        stage_proj_ref(q, l, blk, nblk);
        GRID_BAR();
        stage_attn_ref(q, l, blk, nblk); stage_memattn_ref(q, l, blk, nblk); stage_conv_ref(q, l, blk, nblk);
        GRID_BAR();
        if (blk < NB * 4) stage_ssd_ref(q, l, blk, NB * 4); else stage_merge(q, blk - NB * 4, nblk - NB * 4);
        GRID_BAR();
        stage_gate_ref(q, l, blk, nblk);
        GRID_BAR();
        stage_out_ref(q, l, blk, nblk);
        GRID_BAR();
        stage_ln1_router(q, l, blk, nblk);
        GRID_BAR();
        stage_moe1_ref(q, l, blk, nblk);
        GRID_BAR();
        stage_moe2_ref(q, l, blk, nblk);
        GRID_BAR();
        stage_ln2(q, l, blk, nblk);
        if (l + 1 < DEPTH) GRID_BAR();
    }
}

extern "C" void kernel_launch(void* const* d_in, const int* in_sizes, int n_in, void* d_out, int out_size, void* d_ws, size_t ws_size, hipStream_t stream) {
    if (n_in != 22 || out_size != T * DM || ws_size < WS_END) { fprintf(stderr, "kernel_launch: unexpected shapes (n_in %d out %d ws %zu)\n", n_in, out_size, ws_size); return; }
    static int grid = 0;
    if (grid == 0) {
        int dev = 0, cus = 0, per_cu = 0;
        if (hipGetDevice(&dev) != hipSuccess || hipDeviceGetAttribute(&cus, hipDeviceAttributeMultiprocessorCount, dev) != hipSuccess) { grid = -1; return; }
        if (hipFuncSetAttribute((const void*)mega_fwd, hipFuncAttributeMaxDynamicSharedMemorySize, LDS_BYTES) != hipSuccess) { fprintf(stderr, "kernel_launch: hipFuncSetAttribute failed\n"); grid = -1; return; }
        if (hipOccupancyMaxActiveBlocksPerMultiprocessor(&per_cu, (const void*)mega_fwd, NTHREADS, LDS_BYTES) != hipSuccess || per_cu < 1) fprintf(stderr, "kernel_launch: occupancy query reports %d\n", per_cu);
        (void)hipGetLastError();
        grid = cus;
    }
    if (grid < 0) return;
    Params p{};
    const float** pp = (const float**)&p;
    for (int i = 0; i < 22; ++i) pp[i] = (const float*)d_in[i];
    p.out = (float*)d_out; p.ws = (unsigned char*)d_ws;
    (void)hipMemsetAsync((char*)d_ws + WS_CTL, 0, CTL_ZERO_BYTES, stream);
    hipLaunchKernelGGL(mega_fwd, dim3(grid), dim3(NTHREADS), LDS_BYTES, stream, p);
}
```

```cpp
#include <hip/hip_runtime.h>
#include <cstdio>
#include <cstdint>

#define GAS __attribute__((address_space(1)))
#define LAS __attribute__((address_space(3)))
typedef unsigned short bf16;
typedef short bf16x8 __attribute__((ext_vector_type(8)));
typedef float f32x4 __attribute__((ext_vector_type(4)));
typedef float f32x16 __attribute__((ext_vector_type(16)));
typedef unsigned u32x4 __attribute__((ext_vector_type(4)));
typedef unsigned u32x2 __attribute__((ext_vector_type(2)));

constexpr int NB = 4, SEQ = 4096, T = NB * SEQ, DM = 1024, DEPTH = 2;
constexpr int NCOLS_IN = 2820, NPROJ = 2816;
constexpr int C_Q = 0, C_K = 512, C_V = 1024, C_Z = 1536, C_XBC = 1792, C_QM = 2560;
constexpr int NE = 16, NMEM = 256;
constexpr int HROWS = 36864;
constexpr float ALPHA = 1.41421356237309515f;
constexpr float LN_EPS = 1e-5f, RMS_EPS = 1e-5f;
constexpr int NTHREADS = 512, NWAVES = 8;

constexpr size_t MiB = 1u << 20;
constexpr size_t WS_CTL = 0, CTL_ZERO_BYTES = 1 * MiB;
constexpr size_t WS_BIAST = 1 * MiB;
constexpr size_t WS_KV = 2 * MiB;
constexpr size_t WS_MEMB = 4 * MiB;
constexpr size_t WS_WT_KV = 6 * MiB;
constexpr size_t WS_WT_OUT = 8 * MiB;
constexpr size_t WS_WT_IN = 12 * MiB;
constexpr size_t WS_WT_GU = 24 * MiB;
constexpr size_t WS_WT_DN = 152 * MiB;
constexpr size_t WS_XB = 216 * MiB;
constexpr size_t WS_MIX = 248 * MiB;
constexpr size_t WS_DT = 280 * MiB;
constexpr size_t WS_TOKE = 281 * MiB;
constexpr size_t WS_TOKP = WS_TOKE + 128 * 1024;
constexpr size_t WS_TOKW = WS_TOKP + 128 * 1024;
constexpr size_t WS_LIST = 282 * MiB;
constexpr size_t WS_SST = 284 * MiB;
constexpr size_t WS_P = 300 * MiB;
constexpr size_t WS_ATTO = 388 * MiB;
constexpr size_t WS_LSE = 436 * MiB;
constexpr size_t WS_H = 300 * MiB;
constexpr size_t WS_Y = 372 * MiB;
constexpr size_t WS_XBCC = 444 * MiB;
constexpr size_t WS_YS = 492 * MiB;
constexpr size_t WS_END = 508 * MiB;
constexpr int CW_CNT = 64;

struct Params {
    const float *x, *mem, *w_in, *w_out, *rel_bias, *conv_w, *conv_b, *dt_bias, *a_log, *d_skip, *ssd_norm_w, *w_mem_kv, *mem_bias,
        *ln1_g, *ln1_b, *ln2_g, *ln2_b, *w_router, *b_router, *w_gate, *w_up, *w_down;
    float* out; unsigned char* ws;
};

__device__ __forceinline__ int otid_w(int wv) { int t = wv * 64 + (int)__builtin_amdgcn_mbcnt_hi(~0u, __builtin_amdgcn_mbcnt_lo(~0u, 0u)); asm volatile("" : "+v"(t)); return t; }
#define otid() otid_w(wv_)
__device__ __forceinline__ unsigned f2bf(float f) { unsigned u = __builtin_bit_cast(unsigned, f); return (u + 0x7fffu + ((u >> 16) & 1u)) >> 16; }
__device__ __forceinline__ unsigned pk2(float lo, float hi) { return f2bf(lo) | (f2bf(hi) << 16); }
__device__ __forceinline__ float bf2f(unsigned b) { return __builtin_bit_cast(float, b << 16); }
__device__ __forceinline__ float bflo(unsigned w) { return __builtin_bit_cast(float, w << 16); }
__device__ __forceinline__ float bfhi(unsigned w) { return __builtin_bit_cast(float, w & 0xffff0000u); }
__device__ __forceinline__ float wave_sum(float v) {
#pragma unroll
    for (int o = 1; o < 64; o <<= 1) v += __shfl_xor(v, o);
    return v;
}
__device__ __forceinline__ float wave_max(float v) {
#pragma unroll
    for (int o = 1; o < 64; o <<= 1) v = fmaxf(v, __shfl_xor(v, o));
    return v;
}
__device__ __forceinline__ float silu_f(float v) { return v / (1.f + __expf(-v)); }
__device__ __forceinline__ float softplus_f(float v) { return v > 20.f ? v : log1pf(__expf(v)); }
__device__ __forceinline__ int crow(int r, int hi) { return (r & 3) + 8 * (r >> 2) + 4 * hi; }

__device__ __forceinline__ void transpose_item(const float* W, int ldw, int src_col0, bf16* WT, int K, int dst_row0, float scale, LAS float* scr, int k0, int lane) {
#pragma unroll 8
    for (int i = 0; i < 32; ++i) { const int kk = 2 * i + (lane >> 5); scr[kk * 33 + (lane & 31)] = W[(size_t)(k0 + kk) * ldw + src_col0 + (lane & 31)]; }
    asm volatile("s_waitcnt lgkmcnt(0)" ::: "memory");
    const int c = lane & 7;
#pragma unroll
    for (int j = 0; j < 4; ++j) { const int n = (lane >> 3) + 8 * j; const LAS float* s = scr + (8 * c) * 33 + n;
        u32x4 o; o.x = pk2(s[0 * 33] * scale, s[1 * 33] * scale); o.y = pk2(s[2 * 33] * scale, s[3 * 33] * scale); o.z = pk2(s[4 * 33] * scale, s[5 * 33] * scale); o.w = pk2(s[6 * 33] * scale, s[7 * 33] * scale);
        *(u32x4*)(WT + (size_t)(dst_row0 + n) * K + k0 + 8 * c) = o; }
    asm volatile("s_waitcnt lgkmcnt(0)" ::: "memory");
}
constexpr int I_IN = 2 * 16 * 88, I_OUT = 2 * 16 * 32, I_KV = 2 * 16 * 16, I_GU = 32 * 16 * 64, I_DN = 32 * 16 * 32;
constexpr int I_TOTAL = I_IN + I_OUT + I_KV + I_GU + I_DN;

__device__ __forceinline__ void stage_prologue(const Params& p, LAS unsigned char* lds, int blk, int nblk, int wv_) {
    const int tid = otid(), lane = tid & 63, wave = tid >> 6;
    const int gw = blk * NWAVES + wave, ngw = nblk * NWAVES;
    LAS float* scr = (LAS float*)(lds + wave * 16384);
    unsigned char* ws = p.ws;
    for (int it = gw; it < I_TOTAL; it += ngw) {
        int r = it;
        if (r < I_IN) { const int l = r / (16 * 88), q = r % (16 * 88), kb = q / 88, nb = q % 88, n0 = nb * 32;
            transpose_item(p.w_in + (size_t)l * DM * NCOLS_IN, NCOLS_IN, n0 < 2560 ? n0 : n0 + 4, (bf16*)(ws + WS_WT_IN) + (size_t)l * NPROJ * DM, DM, n0, (n0 < 512 || n0 >= 2560) ? 0.125f : 1.f, scr, kb * 64, lane); continue; }
        r -= I_IN;
        if (r < I_OUT) { const int l = r / (16 * 32), q = r % (16 * 32), kb = q / 32, nb = q % 32;
            transpose_item(p.w_out + (size_t)l * DM * DM, DM, nb * 32, (bf16*)(ws + WS_WT_OUT) + (size_t)l * DM * DM, DM, nb * 32, 1.f, scr, kb * 64, lane); continue; }
        r -= I_OUT;
        if (r < I_KV) { const int l = r / (16 * 16), q = r % (16 * 16), kb = q / 16, nb = q % 16;
            transpose_item(p.w_mem_kv + (size_t)l * DM * 512, 512, nb * 32, (bf16*)(ws + WS_WT_KV) + (size_t)l * 512 * DM, DM, nb * 32, 1.f, scr, kb * 64, lane); continue; }
        r -= I_KV;
        if (r < I_GU) { const int le = r / (16 * 64), q = r % (16 * 64), kb = q / 64, nb = q % 64, n0 = nb * 32, pn = n0 >> 8, bj = (n0 >> 7) & 1, j0 = n0 & 127;
            transpose_item((bj ? p.w_up : p.w_gate) + (size_t)le * DM * DM, DM, 128 * pn + j0, (bf16*)(ws + WS_WT_GU) + (size_t)le * 2048 * DM, DM, n0, 1.f, scr, kb * 64, lane); continue; }
        r -= I_GU;
        { const int le = r / (16 * 32), q = r % (16 * 32), kb = q / 32, nb = q % 32;
            transpose_item(p.w_down + (size_t)le * DM * DM, DM, nb * 32, (bf16*)(ws + WS_WT_DN) + (size_t)le * DM * DM, DM, nb * 32, 1.f, scr, kb * 64, lane); }
    }
    {
        bf16* XB = (bf16*)(ws + WS_XB); float* DT = (float*)(ws + WS_DT);
        for (int m = gw; m < T; m += ngw) {
            const f32x4* xr = (const f32x4*)(p.x + (size_t)m * DM) + lane;
            float d0 = 0.f, d1 = 0.f, d2 = 0.f, d3 = 0.f;
#pragma unroll
            for (int j = 0; j < 4; ++j) { const f32x4 v = xr[64 * j];
                u32x2 o; o.x = pk2(v.x, v.y); o.y = pk2(v.z, v.w); *((u32x2*)(XB + (size_t)m * DM) + lane + 64 * j) = o;
#pragma unroll
                for (int c = 0; c < 4; ++c) { const int k = 4 * lane + 256 * j + c; const f32x4 w = *(const f32x4*)(p.w_in + (size_t)k * NCOLS_IN + 2560); const float xv = v[c];
                    d0 += xv * w.x; d1 += xv * w.y; d2 += xv * w.z; d3 += xv * w.w; } }
            d0 = wave_sum(d0); d1 = wave_sum(d1); d2 = wave_sum(d2); d3 = wave_sum(d3);
            if (lane == 0) *(f32x4*)(DT + (size_t)m * 4) = (f32x4){d0, d1, d2, d3};
        }
    }
    {
        bf16* MB = (bf16*)(ws + WS_MEMB);
        for (int m = gw; m < NB * NMEM; m += ngw) {
            const f32x4* xr = (const f32x4*)(p.mem + (size_t)m * DM) + lane;
#pragma unroll
            for (int j = 0; j < 4; ++j) { const f32x4 v = xr[64 * j]; u32x2 o; o.x = pk2(v.x, v.y); o.y = pk2(v.z, v.w); *((u32x2*)(MB + (size_t)m * DM) + lane + 64 * j) = o; }
        }
    }
    if (blk == 0) {
        float* BT = (float*)(ws + WS_BIAST);
        for (int i = tid; i < 3 * 129; i += NTHREADS) { const int br = i / 129, st = i % 129, dil = br == 0 ? 1 : (br == 1 ? 4 : 16), n = st * dil; int bucket;
            if (n < 16) bucket = n; else { const float nf = (float)n; int lg = 16 + (int)(logf(nf / 16.f) / logf(128.f) * 16.f); bucket = lg < 31 ? lg : 31; }
#pragma unroll
            for (int h = 0; h < 8; ++h) BT[(br * 8 + h) * 132 + st] = p.rel_bias[bucket * 8 + h]; }
    }
}

template <class RowPtr, class Epi>
__device__ __forceinline__ void wave_gemm_tile(RowPtr arow  , const bf16* brow  , int K, int lane, Epi epi) {
    const int hi = lane >> 5;
    const bf16* ap = arow + 8 * hi; const bf16* bp = brow + 8 * hi;
    f32x16 acc = {};
    for (int k0 = 0; k0 < K; k0 += 16) { const bf16x8 a = *(const bf16x8*)(ap + k0); const bf16x8 b = *(const bf16x8*)(bp + k0); acc = __builtin_amdgcn_mfma_f32_32x32x16_bf16(b, a, acc, 0, 0, 0); }
#pragma unroll
    for (int g = 0; g < 4; ++g) epi(8 * g + 4 * hi, acc[4 * g], acc[4 * g + 1], acc[4 * g + 2], acc[4 * g + 3]);
}

__device__ __forceinline__ void stage_proj_ref(const Params& p, int l, int blk, int nblk, int wv_) {
    const int tid = otid(), lane = tid & 63, wave = tid >> 6, gw = blk * NWAVES + wave, ngw = nblk * NWAVES;
    unsigned char* ws = p.ws;
    const bf16* XB = (const bf16*)(ws + WS_XB); const bf16* WT = (const bf16*)(ws + WS_WT_IN) + (size_t)l * NPROJ * DM; bf16* P = (bf16*)(ws + WS_P);
    constexpr int NT = NPROJ / 32, MT = T / 32;
    for (int tile = gw; tile < MT * NT; tile += ngw) { const int tm = tile / NT, tn = tile % NT; const int m = tm * 32 + (lane & 31);
        wave_gemm_tile(XB + (size_t)m * DM, WT + (size_t)(tn * 32 + (lane & 31)) * DM, DM, lane, [&](int nn, float a, float b, float c, float d) {
            u32x2 o; o.x = pk2(a, b); o.y = pk2(c, d); *(u32x2*)(P + (size_t)m * NPROJ + tn * 32 + nn) = o; }); }
    if (l == 0) {
        const bf16* MB = (const bf16*)(ws + WS_MEMB);
        constexpr int NT2 = 512 / 32, MT2 = NB * NMEM / 32;
        for (int tile = gw; tile < 2 * MT2 * NT2; tile += ngw) { const int ll = tile / (MT2 * NT2), q = tile % (MT2 * NT2), tm = q / NT2, tn = q % NT2; const int m = tm * 32 + (lane & 31);
            const bf16* WK = (const bf16*)(ws + WS_WT_KV) + (size_t)ll * 512 * DM; bf16* KV = (bf16*)(ws + WS_KV) + (size_t)ll * 1024 * 512;
            wave_gemm_tile(MB + (size_t)m * DM, WK + (size_t)(tn * 32 + (lane & 31)) * DM, DM, lane, [&](int nn, float a, float b, float c, float d) {
                u32x2 o; o.x = pk2(a, b); o.y = pk2(c, d); *(u32x2*)(KV + (size_t)m * 512 + tn * 32 + nn) = o; }); }
    }
}

__device__ __forceinline__ float dot64(const bf16* row, const unsigned (&qw)[32]) {
    float s = 0.f;
#pragma unroll
    for (int c = 0; c < 8; ++c) { const u32x4 kv = *(const u32x4*)(row + 8 * c);
        s += bflo(kv.x) * bflo(qw[4 * c]) + bfhi(kv.x) * bfhi(qw[4 * c]); s += bflo(kv.y) * bflo(qw[4 * c + 1]) + bfhi(kv.y) * bfhi(qw[4 * c + 1]);
        s += bflo(kv.z) * bflo(qw[4 * c + 2]) + bfhi(kv.z) * bfhi(qw[4 * c + 2]); s += bflo(kv.w) * bflo(qw[4 * c + 3]) + bfhi(kv.w) * bfhi(qw[4 * c + 3]); }
    return s;
}
__device__ __forceinline__ void stage_attn_ref(const Params& p, int l, int blk, int nblk, int wv_) {
    const int tid = otid(), lane = tid & 63, wave = tid >> 6, gw = blk * NWAVES + wave, ngw = nblk * NWAVES;
    unsigned char* ws = p.ws; const bf16* P = (const bf16*)(ws + WS_P); const float* BT = (const float*)(ws + WS_BIAST);
    bf16* AO = (bf16*)(ws + WS_ATTO); float* LSE = (float*)(ws + WS_LSE);
    for (int task = gw; task < 3 * T * 8; task += ngw) {
        const int br = task / (T * 8), q = task % (T * 8), t = q >> 3, h = q & 7, s = t % SEQ, dil = br == 0 ? 1 : (br == 1 ? 4 : 16);
        unsigned qw[32];
        { const u32x4* qp = (const u32x4*)(P + (size_t)t * NPROJ + C_Q + h * 64);
#pragma unroll
            for (int c = 0; c < 8; ++c) { const u32x4 v = qp[c]; qw[4 * c] = v.x; qw[4 * c + 1] = v.y; qw[4 * c + 2] = v.z; qw[4 * c + 3] = v.w; } }
        float sc[3];
#pragma unroll
        for (int kk = 0; kk < 3; ++kk) { const int st = lane + 64 * kk; const bool valid = st <= 128 && s - st * dil >= 0; sc[kk] = -INFINITY;
            if (valid) sc[kk] = dot64(P + (size_t)(t - st * dil) * NPROJ + C_K + h * 64, qw) + BT[(br * 8 + h) * 132 + st]; }
        const float mx = wave_max(fmaxf(fmaxf(sc[0], sc[1]), sc[2]));
        float pr[3], ls = 0.f;
#pragma unroll
        for (int kk = 0; kk < 3; ++kk) { pr[kk] = __expf(sc[kk] - mx); ls += pr[kk]; }
        ls = wave_sum(ls);
        float o = 0.f;
        const int nst = min(128, s / dil);
        for (int st = 0; st <= nst; ++st) { const float pj = __shfl(st < 64 ? pr[0] : (st < 128 ? pr[1] : pr[2]), st & 63);
            o += pj * bf2f(P[(size_t)(t - st * dil) * NPROJ + C_V + h * 64 + lane]); }
        AO[((size_t)br * T + t) * 512 + h * 64 + lane] = (bf16)f2bf(o / ls);
        if (lane == 0) LSE[((size_t)br * T + t) * 8 + h] = mx + __logf(ls);
    }
}
__device__ __forceinline__ void stage_merge(const Params& p, int blk, int nblk, int wv_) {
    const int tid = otid(), lane = tid & 63, wave = tid >> 6, gw = blk * NWAVES + wave, ngw = nblk * NWAVES;
    unsigned char* ws = p.ws; const bf16* AO = (const bf16*)(ws + WS_ATTO); const float* LSE = (const float*)(ws + WS_LSE); bf16* MIX = (bf16*)(ws + WS_MIX);
    for (int t = gw; t < T; t += ngw) {
        const int h = lane >> 3;
        const float l0 = LSE[((size_t)0 * T + t) * 8 + h], l1 = LSE[((size_t)1 * T + t) * 8 + h], l2 = LSE[((size_t)2 * T + t) * 8 + h];
        const float mx = fmaxf(fmaxf(l0, l1), l2); float w0 = __expf(l0 - mx), w1 = __expf(l1 - mx), w2 = __expf(l2 - mx); const float inv = 1.f / (w0 + w1 + w2); w0 *= inv; w1 *= inv; w2 *= inv;
        const u32x4 a = *(const u32x4*)(AO + ((size_t)0 * T + t) * 512 + lane * 8), b = *(const u32x4*)(AO + ((size_t)1 * T + t) * 512 + lane * 8), c = *(const u32x4*)(AO + ((size_t)2 * T + t) * 512 + lane * 8);
        u32x4 o;
#pragma unroll
        for (int i = 0; i < 4; ++i) o[i] = pk2(w0 * bflo(a[i]) + w1 * bflo(b[i]) + w2 * bflo(c[i]), w0 * bfhi(a[i]) + w1 * bfhi(b[i]) + w2 * bfhi(c[i]));
        *(u32x4*)(MIX + (size_t)t * DM + lane * 8) = o;
    }
}
__device__ __forceinline__ void stage_memattn_ref(const Params& p, int l, int blk, int nblk, int wv_) {
    const int tid = otid(), lane = tid & 63, wave = tid >> 6, gw = blk * NWAVES + wave, ngw = nblk * NWAVES;
    unsigned char* ws = p.ws; const bf16* P = (const bf16*)(ws + WS_P); const bf16* KV = (const bf16*)(ws + WS_KV) + (size_t)l * 1024 * 512; bf16* MIX = (bf16*)(ws + WS_MIX);
    for (int task = gw; task < T * 4; task += ngw) {
        const int t = task >> 2, h = task & 3, b = t / SEQ;
        unsigned qw[32];
        { const u32x4* qp = (const u32x4*)(P + (size_t)t * NPROJ + C_QM + h * 64);
#pragma unroll
            for (int c = 0; c < 8; ++c) { const u32x4 v = qp[c]; qw[4 * c] = v.x; qw[4 * c + 1] = v.y; qw[4 * c + 2] = v.z; qw[4 * c + 3] = v.w; } }
        float sc[4];
#pragma unroll
        for (int kk = 0; kk < 4; ++kk) { const int j = lane + 64 * kk; sc[kk] = dot64(KV + (size_t)(b * NMEM + j) * 512 + h * 64, qw) + p.mem_bias[(l * 4 + h) * NMEM + j]; }
        const float mx = wave_max(fmaxf(fmaxf(sc[0], sc[1]), fmaxf(sc[2], sc[3])));
        float pr[4], ls = 0.f;
#pragma unroll
        for (int kk = 0; kk < 4; ++kk) { pr[kk] = __expf(sc[kk] - mx); ls += pr[kk]; }
        ls = wave_sum(ls);
        float o = 0.f;
        for (int j = 0; j < NMEM; ++j) { const int kk = j >> 6; const float pj = __shfl(kk == 0 ? pr[0] : (kk == 1 ? pr[1] : (kk == 2 ? pr[2] : pr[3])), j & 63);
            o += pj * bf2f(KV[(size_t)(b * NMEM + j) * 512 + 256 + h * 64 + lane]); }
        MIX[(size_t)t * DM + 768 + h * 64 + lane] = (bf16)f2bf(o / ls);
    }
}
__device__ __forceinline__ void stage_conv_ref(const Params& p, int l, int blk, int nblk, int wv_) {
    unsigned char* ws = p.ws; const bf16* P = (const bf16*)(ws + WS_P); float* XC = (float*)(ws + WS_XBCC);
    const float* cw = p.conv_w + (size_t)l * 4 * 768; const float* cb = p.conv_b + (size_t)l * 768;
    for (size_t i = (size_t)blk * NTHREADS + otid(); i < (size_t)T * 768; i += (size_t)nblk * NTHREADS) {
        const int t = (int)(i / 768), c = (int)(i % 768), s = t % SEQ; float a = cb[c];
#pragma unroll
        for (int k = 0; k < 4; ++k) { const int sp = s + k - 3; if (sp >= 0) a += cw[k * 768 + c] * bf2f(P[(size_t)(t + k - 3) * NPROJ + C_XBC + c]); }
        XC[i] = silu_f(a);
    }
}
__device__ __forceinline__ void stage_ssd_ref(const Params& p, int l, int blk, int nblk, int wv_) {
    unsigned char* ws = p.ws; const float* XC = (const float*)(ws + WS_XBCC); const float* DT = (const float*)(ws + WS_DT); float* YS = (float*)(ws + WS_YS);
    const int tid = otid();
    for (int u = blk; u < NB * 4; u += nblk) {
        const int b = u >> 2, h = u & 3, g = h >> 1, pp = tid >> 3, ns = (tid & 7) * 16;
        const float a = -__expf(p.a_log[l * 4 + h]), dtb = p.dt_bias[l * 4 + h], Dh = p.d_skip[l * 4 + h];
        float hst[16];
#pragma unroll
        for (int i = 0; i < 16; ++i) hst[i] = 0.f;
        for (int s = 0; s < SEQ; ++s) { const size_t t = (size_t)b * SEQ + s;
            const float dt = softplus_f(DT[t * 4 + h] + dtb), da = __expf(a * dt);
            const float xv = XC[t * 768 + h * 64 + pp], xd = xv * dt;
            const f32x4* Bp = (const f32x4*)(XC + t * 768 + 256 + g * 128 + ns); const f32x4* Cp = (const f32x4*)(XC + t * 768 + 512 + g * 128 + ns);
            float acc = 0.f;
#pragma unroll
            for (int i4 = 0; i4 < 4; ++i4) { const f32x4 bv = Bp[i4], cv = Cp[i4];
#pragma unroll
                for (int c = 0; c < 4; ++c) { float& hh = hst[4 * i4 + c]; hh = hh * da + xd * bv[c]; acc += cv[c] * hh; } }
            acc += __shfl_xor(acc, 1); acc += __shfl_xor(acc, 2); acc += __shfl_xor(acc, 4);
            if ((tid & 7) == 0) YS[t * 256 + h * 64 + pp] = acc + Dh * xv;
        }
    }
}
__device__ __forceinline__ void stage_gate_ref(const Params& p, int l, int blk, int nblk, int wv_) {
    const int tid = otid(), lane = tid & 63, wave = tid >> 6, gw = blk * NWAVES + wave, ngw = nblk * NWAVES;
    unsigned char* ws = p.ws; const bf16* P = (const bf16*)(ws + WS_P); const float* YS = (const float*)(ws + WS_YS); bf16* MIX = (bf16*)(ws + WS_MIX);
    const f32x4 nw = *(const f32x4*)(p.ssd_norm_w + l * 256 + 4 * lane);
    for (int t = gw; t < T; t += ngw) {
        f32x4 y = *(const f32x4*)(YS + (size_t)t * 256 + 4 * lane); const u32x2 zw = *(const u32x2*)(P + (size_t)t * NPROJ + C_Z + 4 * lane);
        y.x *= silu_f(bflo(zw.x)); y.y *= silu_f(bfhi(zw.x)); y.z *= silu_f(bflo(zw.y)); y.w *= silu_f(bfhi(zw.y));
        const float ms = wave_sum(y.x * y.x + y.y * y.y + y.z * y.z + y.w * y.w) * (1.f / 256.f); const float r = 1.f / sqrtf(ms + RMS_EPS);
        u32x2 o; o.x = pk2(y.x * r * nw.x, y.y * r * nw.y); o.y = pk2(y.z * r * nw.z, y.w * r * nw.w);
        *(u32x2*)(MIX + (size_t)t * DM + 512 + 4 * lane) = o;
    }
}
__device__ __forceinline__ void stage_out_ref(const Params& p, int l, int blk, int nblk, int wv_) {
    const int tid = otid(), lane = tid & 63, wave = tid >> 6, gw = blk * NWAVES + wave, ngw = nblk * NWAVES;
    unsigned char* ws = p.ws; const bf16* MIX = (const bf16*)(ws + WS_MIX); const bf16* WT = (const bf16*)(ws + WS_WT_OUT) + (size_t)l * DM * DM;
    const float* xin = l == 0 ? p.x : p.out; float* out = p.out;
    constexpr int NT = DM / 32, MT = T / 32;
    for (int tile = gw; tile < MT * NT; tile += ngw) { const int tm = tile / NT, tn = tile % NT; const int m = tm * 32 + (lane & 31);
        wave_gemm_tile(MIX + (size_t)m * DM, WT + (size_t)(tn * 32 + (lane & 31)) * DM, DM, lane, [&](int nn, float a, float b, float c, float d) {
            const size_t off = (size_t)m * DM + tn * 32 + nn; const f32x4 xv = *(const f32x4*)(xin + off);
            *(f32x4*)(out + off) = (f32x4){ALPHA * xv.x + a, ALPHA * xv.y + b, ALPHA * xv.z + c, ALPHA * xv.w + d}; }); }
}

__device__ __forceinline__ void ln_row(f32x4 (&v)[4], const float* g, const float* bta, int lane) {
    float s = 0.f;
#pragma unroll
    for (int j = 0; j < 4; ++j) s += (v[j].x + v[j].y) + (v[j].z + v[j].w);
    const float mean = wave_sum(s) * (1.f / DM); float s2 = 0.f;
#pragma unroll
    for (int j = 0; j < 4; ++j) { v[j] = v[j] - mean; s2 += (v[j].x * v[j].x + v[j].y * v[j].y) + (v[j].z * v[j].z + v[j].w * v[j].w); }
    const float rstd = 1.f / sqrtf(wave_sum(s2) * (1.f / DM) + LN_EPS);
#pragma unroll
    for (int j = 0; j < 4; ++j) { const f32x4 gg = *((const f32x4*)g + lane + 64 * j), bb = *((const f32x4*)bta + lane + 64 * j); v[j] = v[j] * rstd * gg + bb; }
}
__device__ __forceinline__ void stage_ln1_router(const Params& p, int l, int blk, int nblk, int wv_) {
    const int tid = otid(), lane = tid & 63, wave = tid >> 6, gw = blk * NWAVES + wave, ngw = nblk * NWAVES;
    unsigned char* ws = p.ws; bf16* XB = (bf16*)(ws + WS_XB); unsigned* cnt = (unsigned*)(ws + WS_CTL) + CW_CNT + l * 16;
    int* TOKE = (int*)(ws + WS_TOKE); int* TOKP = (int*)(ws + WS_TOKP); float* TOKW = (float*)(ws + WS_TOKW); int* LIST = (int*)(ws + WS_LIST);
    for (int t = gw; t < T; t += ngw) {
        asm volatile("" ::: "memory");
        f32x4 v[4]; f32x4* xr = (f32x4*)(p.out + (size_t)t * DM) + lane;
#pragma unroll
        for (int j = 0; j < 4; ++j) v[j] = xr[64 * j];
        ln_row(v, p.ln1_g + l * DM, p.ln1_b + l * DM, lane);
        float lg[16];
#pragma unroll
        for (int e = 0; e < 16; ++e) lg[e] = 0.f;
#pragma unroll
        for (int j = 0; j < 4; ++j) { xr[64 * j] = v[j]; u32x2 o; o.x = pk2(v[j].x, v[j].y); o.y = pk2(v[j].z, v[j].w); *((u32x2*)(XB + (size_t)t * DM) + lane + 64 * j) = o;
#pragma unroll
            for (int c = 0; c < 4; ++c) { const int k = 4 * lane + 256 * j + c; const float xv = v[j][c]; const f32x4* wr = (const f32x4*)(p.w_router + (size_t)k * 16);
#pragma unroll
                for (int q = 0; q < 4; ++q) { const f32x4 w = wr[q]; lg[4 * q] += xv * w.x; lg[4 * q + 1] += xv * w.y; lg[4 * q + 2] += xv * w.z; lg[4 * q + 3] += xv * w.w; } } }
        float mx = -INFINITY;
#pragma unroll
        for (int e = 0; e < 16; ++e) { lg[e] = wave_sum(lg[e]) + p.b_router[e]; mx = fmaxf(mx, lg[e]); }
        float sum = 0.f;
#pragma unroll
        for (int e = 0; e < 16; ++e) { lg[e] = __expf(lg[e] - mx); sum += lg[e]; }
        const float inv = 1.f / sum;
#pragma unroll
        for (int e = 0; e < 16; ++e) lg[e] *= inv;
        int best = 0; float bs = -1.f;
#pragma unroll
        for (int g = 0; g < 4; ++g) { const float a = lg[4 * g], b = lg[4 * g + 1], c = lg[4 * g + 2], d = lg[4 * g + 3];
            const float h1 = fmaxf(a, b), l1 = fminf(a, b), h2 = fmaxf(c, d), l2 = fminf(c, d); const float gs = fmaxf(h1, h2) + fmaxf(fminf(h1, h2), fmaxf(l1, l2));
            if (gs > bs) { bs = gs; best = g; } }
        const float c0 = best == 0 ? lg[0] : (best == 1 ? lg[4] : (best == 2 ? lg[8] : lg[12]));
        const float c1 = best == 0 ? lg[1] : (best == 1 ? lg[5] : (best == 2 ? lg[9] : lg[13]));
        const float c2 = best == 0 ? lg[2] : (best == 1 ? lg[6] : (best == 2 ? lg[10] : lg[14]));
        const float c3 = best == 0 ? lg[3] : (best == 1 ? lg[7] : (best == 2 ? lg[11] : lg[15]));
        int i1 = 0; float s1 = c0; if (c1 > s1) { s1 = c1; i1 = 1; } if (c2 > s1) { s1 = c2; i1 = 2; } if (c3 > s1) { s1 = c3; i1 = 3; }
        int i2 = -1; float s2 = -1.f;
        if (i1 != 0 && c0 > s2) { s2 = c0; i2 = 0; } if (i1 != 1 && c1 > s2) { s2 = c1; i2 = 1; } if (i1 != 2 && c2 > s2) { s2 = c2; i2 = 2; } if (i1 != 3 && c3 > s2) { s2 = c3; i2 = 3; }
        if (lane == 0) { const int e1 = best * 4 + i1, e2 = best * 4 + i2; const float ws_ = 1.f / (s1 + s2);
            const int p1 = (int)atomicAdd(cnt + e1, 1u), p2 = (int)atomicAdd(cnt + e2, 1u);
            LIST[e1 * T + p1] = t; LIST[e2 * T + p2] = t;
            TOKE[2 * t] = e1; TOKE[2 * t + 1] = e2; TOKP[2 * t] = p1; TOKP[2 * t + 1] = p2; TOKW[2 * t] = s1 * ws_; TOKW[2 * t + 1] = s2 * ws_; }
    }
}
__device__ __forceinline__ void stage_moe1_ref(const Params& p, int l, int blk, int nblk, int wv_) {
    const int tid = otid(), lane = tid & 63, wave = tid >> 6, gw = blk * NWAVES + wave, ngw = nblk * NWAVES;
    unsigned char* ws = p.ws; const bf16* XB = (const bf16*)(ws + WS_XB); const unsigned* cnt = (const unsigned*)(ws + WS_CTL) + CW_CNT + l * 16; const int* LIST = (const int*)(ws + WS_LIST);
    bf16* H = (bf16*)(ws + WS_H);
    int total = 0;
    for (int e = 0; e < NE; ++e) total += (int)((cnt[e] + 255u) >> 8) * 256;
    const int ntask = (total / 32) * 32;
    for (int task = gw; task < ntask; task += ngw) { const int rt = task >> 5, ct = task & 31; const int row0 = rt * 32;
        int e = 0, base = 0;
        for (int q = 0; q < NE; ++q) { const int sz = (int)((cnt[q] + 255u) >> 8) * 256; if (row0 >= base + sz) { base += sz; e = q + 1; } else break; }
        const int i = row0 + (lane & 31) - base; const int tok = i < (int)cnt[e] ? LIST[e * T + i] : 0;
        const bf16* WG = (const bf16*)(ws + WS_WT_GU) + (size_t)(l * 16 + e) * 2048 * DM; const int c0 = ct * 32, pn = c0 >> 7, j0 = c0 & 127;
        const int hi = lane >> 5;
        const bf16* ap = XB + (size_t)tok * DM + 8 * hi; const bf16* gp = WG + (size_t)(256 * pn + j0 + (lane & 31)) * DM + 8 * hi; const bf16* up = gp + (size_t)128 * DM;
        f32x16 ag = {}, au = {};
        for (int k0 = 0; k0 < DM; k0 += 16) { const bf16x8 a = *(const bf16x8*)(ap + k0); ag = __builtin_amdgcn_mfma_f32_32x32x16_bf16(*(const bf16x8*)(gp + k0), a, ag, 0, 0, 0); au = __builtin_amdgcn_mfma_f32_32x32x16_bf16(*(const bf16x8*)(up + k0), a, au, 0, 0, 0); }
        const int row = row0 + (lane & 31);
#pragma unroll
        for (int g = 0; g < 4; ++g) { u32x2 o; o.x = pk2(silu_f(ag[4 * g]) * au[4 * g], silu_f(ag[4 * g + 1]) * au[4 * g + 1]); o.y = pk2(silu_f(ag[4 * g + 2]) * au[4 * g + 2], silu_f(ag[4 * g + 3]) * au[4 * g + 3]);
            *(u32x2*)(H + (size_t)row * DM + c0 + 8 * g + 4 * hi) = o; }
    }
}
__device__ __forceinline__ void stage_moe2_ref(const Params& p, int l, int blk, int nblk, int wv_) {
    const int tid = otid(), lane = tid & 63, wave = tid >> 6, gw = blk * NWAVES + wave, ngw = nblk * NWAVES;
    unsigned char* ws = p.ws; const unsigned* cnt = (const unsigned*)(ws + WS_CTL) + CW_CNT + l * 16; const bf16* H = (const bf16*)(ws + WS_H); bf16* Y = (bf16*)(ws + WS_Y);
    int total = 0;
    for (int e = 0; e < NE; ++e) total += (int)((cnt[e] + 255u) >> 8) * 256;
    const int ntask = (total / 32) * 32;
    for (int task = gw; task < ntask; task += ngw) { const int rt = task >> 5, ct = task & 31; const int row0 = rt * 32;
        int e = 0, base = 0;
        for (int q = 0; q < NE; ++q) { const int sz = (int)((cnt[q] + 255u) >> 8) * 256; if (row0 >= base + sz) { base += sz; e = q + 1; } else break; }
        const bf16* WD = (const bf16*)(ws + WS_WT_DN) + (size_t)(l * 16 + e) * DM * DM; const int row = row0 + (lane & 31);
        wave_gemm_tile(H + (size_t)row * DM, WD + (size_t)(ct * 32 + (lane & 31)) * DM, DM, lane, [&](int nn, float a, float b, float c, float d) {
            u32x2 o; o.x = pk2(a, b); o.y = pk2(c, d); *(u32x2*)(Y + (size_t)row * DM + ct * 32 + nn) = o; });
    }
}
__device__ __forceinline__ void stage_ln2(const Params& p, int l, int blk, int nblk, int wv_) {
    const int tid = otid(), lane = tid & 63, wave = tid >> 6, gw = blk * NWAVES + wave, ngw = nblk * NWAVES;
    unsigned char* ws = p.ws; bf16* XB = (bf16*)(ws + WS_XB); const unsigned* cnt = (const unsigned*)(ws + WS_CTL) + CW_CNT + l * 16; const bf16* Y = (const bf16*)(ws + WS_Y);
    const int* TOKE = (const int*)(ws + WS_TOKE); const int* TOKP = (const int*)(ws + WS_TOKP); const float* TOKW = (const float*)(ws + WS_TOKW); float* DT = (float*)(ws + WS_DT);
    for (int t = gw; t < T; t += ngw) {
        asm volatile("" ::: "memory");
        const int e1 = TOKE[2 * t], e2 = TOKE[2 * t + 1]; int r1 = TOKP[2 * t], r2 = TOKP[2 * t + 1]; const float w1 = TOKW[2 * t], w2 = TOKW[2 * t + 1];
        for (int e = 0; e < NE; ++e) { const int sz = (int)((cnt[e] + 255u) >> 8) * 256; if (e < e1) r1 += sz; if (e < e2) r2 += sz; }
        f32x4 v[4]; f32x4* xr = (f32x4*)(p.out + (size_t)t * DM) + lane;
#pragma unroll
        for (int j = 0; j < 4; ++j) { const f32x4 xv = xr[64 * j]; const u32x2 a = *((const u32x2*)(Y + (size_t)r1 * DM) + lane + 64 * j), b = *((const u32x2*)(Y + (size_t)r2 * DM) + lane + 64 * j);
            v[j].x = ALPHA * xv.x + (w1 * bflo(a.x) + w2 * bflo(b.x)); v[j].y = ALPHA * xv.y + (w1 * bfhi(a.x) + w2 * bfhi(b.x));
            v[j].z = ALPHA * xv.z + (w1 * bflo(a.y) + w2 * bflo(b.y)); v[j].w = ALPHA * xv.w + (w1 * bfhi(a.y) + w2 * bfhi(b.y)); }
        ln_row(v, p.ln2_g + l * DM, p.ln2_b + l * DM, lane);
        float d0 = 0.f, d1 = 0.f, d2 = 0.f, d3 = 0.f;
#pragma unroll
        for (int j = 0; j < 4; ++j) { xr[64 * j] = v[j];
            if (l + 1 < DEPTH) { u32x2 o; o.x = pk2(v[j].x, v[j].y); o.y = pk2(v[j].z, v[j].w); *((u32x2*)(XB + (size_t)t * DM) + lane + 64 * j) = o;
#pragma unroll
                for (int c = 0; c < 4; ++c) { const int k = 4 * lane + 256 * j + c; const f32x4 w = *(const f32x4*)(p.w_in + ((size_t)(l + 1) * DM + k) * NCOLS_IN + 2560); const float xv = v[j][c];
                    d0 += xv * w.x; d1 += xv * w.y; d2 += xv * w.z; d3 += xv * w.w; } } }
        if (l + 1 < DEPTH) { d0 = wave_sum(d0); d1 = wave_sum(d1); d2 = wave_sum(d2); d3 = wave_sum(d3); if (lane == 0) *(f32x4*)(DT + (size_t)t * 4) = (f32x4){d0, d1, d2, d3}; }
    }
}


namespace pg8 {
constexpr int BM = 256, BK = 64, HALF = 128, HTB = HALF * BK * 2  , STAGE_BYTES = 8 * HTB;
__host__ __device__ __forceinline__ int lds_byte(int r, int c) { const int st = (r >> 4) * 2 + (c >> 5), rr = r & 15, cc = c & 31, ob = rr * 64 + cc * 2; return st * 1024 + (ob ^ (((ob >> 9) & 1) << 5)); }
__host__ __device__ __forceinline__ void stage_rc(int b, int& R, int& C) { const int st = b / 1024, sb = b % 1024, swz = sb ^ (((sb >> 9) & 1) << 5); R = (st >> 1) * 16 + swz / 64; C = (st & 1) * 32 + (swz % 64) / 2; }
__host__ __device__ __forceinline__ int perm32(int rho) { const int n = rho >> 4, i = rho & 15; return 8 * (i >> 2) + 4 * n + (i & 3); }
struct Unit { int pm, pn, cn; };
struct Gemm { const bf16* A; const bf16* Bt; int K; };

__device__ __forceinline__ unsigned cvt_pk_bf16(float lo, float hi) { unsigned r; asm volatile("v_cvt_pk_bf16_f32 %0, %1, %2" : "=v"(r) : "v"(lo), "v"(hi)); return r; }

struct EpiBf16 {
    static constexpr bool PERM = true;
    bf16* O; int ldc; int split_cols; size_t split_stride;
    __device__ __forceinline__ void operator()(const f32x4 (&acc)[2][2][4][2], const Unit& u, int wr, int wc, int fr, int fq) const {
        const int row0 = u.pm * BM + wr * 64 + fr; int colt = u.cn * BM; bf16* base = O;
        if (split_cols) { const int t = colt / split_cols; base += (size_t)t * split_stride; colt -= t * split_cols; }
        const int col0 = colt + wc * 32 + 8 * fq;
#pragma unroll
        for (int ai = 0; ai < 2; ++ai)
#pragma unroll
            for (int m = 0; m < 4; ++m) { bf16* rowp = base + (size_t)(row0 + ai * HALF + m * 16) * ldc + col0;
#pragma unroll
                for (int bj = 0; bj < 2; ++bj) { const f32x4 v0 = acc[ai][bj][m][0], v1 = acc[ai][bj][m][1];
                    u32x4 w; w.x = cvt_pk_bf16(v0[0], v0[1]); w.y = cvt_pk_bf16(v0[2], v0[3]); w.z = cvt_pk_bf16(v1[0], v1[1]); w.w = cvt_pk_bf16(v1[2], v1[3]);
                    *(u32x4*)(rowp + bj * HALF) = w; } }
    }
};
struct EpiSwiGLU {
    static constexpr bool PERM = true;
    bf16* O; int ldc;
    __device__ __forceinline__ void operator()(const f32x4 (&acc)[2][2][4][2], const Unit& u, int wr, int wc, int fr, int fq) const {
        const int row0 = u.pm * BM + wr * 64 + fr; const int col0 = u.cn * HALF + wc * 32 + 8 * fq;
#pragma unroll
        for (int ai = 0; ai < 2; ++ai)
#pragma unroll
            for (int m = 0; m < 4; ++m) { float h[8];
#pragma unroll
                for (int n = 0; n < 2; ++n)
#pragma unroll
                    for (int c = 0; c < 4; ++c) { const float g = acc[ai][0][m][n][c], uu = acc[ai][1][m][n][c]; h[4 * n + c] = g * __builtin_amdgcn_rcpf(1.f + __expf(-g)) * uu; }
                u32x4 w; w.x = cvt_pk_bf16(h[0], h[1]); w.y = cvt_pk_bf16(h[2], h[3]); w.z = cvt_pk_bf16(h[4], h[5]); w.w = cvt_pk_bf16(h[6], h[7]);
                *(u32x4*)(O + (size_t)(row0 + ai * HALF + m * 16) * ldc + col0) = w; }
    }
};
struct EpiResF32 {
    static constexpr bool PERM = false;
    const float* base; float* out; int ldc; float alpha;
    __device__ __forceinline__ void operator()(const f32x4 (&acc)[2][2][4][2], const Unit& u, int wr, int wc, int fr, int fq) const {
        const int row0 = u.pm * BM + wr * 64 + fr; const int col0 = u.cn * BM + wc * 32 + 4 * fq;
#pragma unroll
        for (int ai = 0; ai < 2; ++ai)
#pragma unroll
            for (int m = 0; m < 4; ++m) { const size_t off = (size_t)(row0 + ai * HALF + m * 16) * ldc + col0;
#pragma unroll
                for (int bj = 0; bj < 2; ++bj)
#pragma unroll
                    for (int n = 0; n < 2; ++n) { const f32x4 bs = *(const f32x4*)(base + off + bj * HALF + n * 16); *(f32x4*)(out + off + bj * HALF + n * 16) = bs * alpha + acc[ai][bj][m][n]; } }
    }
};

template <class Epi, class Sched, bool GATHER>
__device__ __forceinline__ void gemm_phase(LAS unsigned char* lds, const Gemm g, const Sched& S, const Epi& E, const LAS int* gtab, int wv_) {
    const int tid = otid(), wid = __builtin_amdgcn_readfirstlane(tid >> 6), lane = tid & 63, wr = wid >> 2, wc = wid & 3, fr = lane & 15, fq = lane >> 4;
    const int K = g.K, nt = K / BK;
    unsigned voffA[2], voffB[2]; int RA[2], CA[2];
#pragma unroll
    for (int i = 0; i < 2; ++i) { int R, C; stage_rc(tid * 16 + i * 8192, R, C); const int Rb = Epi::PERM ? ((R & ~31) + perm32(R & 31)) : R; RA[i] = R; CA[i] = C;
        voffA[i] = (unsigned)(R * K + C) * 2u; voffB[i] = (unsigned)(Rb * K + C) * 2u; }
    const size_t kstep = (size_t)(BK * 2);
    const size_t hstep = (size_t)HALF * K * 2;
    const size_t tstep = 2 * hstep;
    const unsigned ldsw = (unsigned)wid * 1024u;
    const int aoff = lds_byte(wr * 64 + fr, fq * 8), boff = lds_byte(wc * 32 + fr, fq * 8);
#define PG8_SA(b, h) (((b) * 2 + (h)) * HTB)
#define PG8_SB(b, h) ((4 + (b) * 2 + (h)) * HTB)
#define PG8_STAGE(bufoff, gbase, voff) do { _Pragma("unroll") for (int _i = 0; _i < 2; ++_i) \
        __builtin_amdgcn_global_load_lds((const unsigned*)((const char*)(gbase) + (voff)[_i]), (LAS unsigned*)(lds + (bufoff) + ldsw + _i * 8192), 16, 0, 0); } while (0)
#define PG8_STAGE_A(bufoff, pbase, gbase, h, vo) do { if constexpr (GATHER) { PG8_STAGE(bufoff, gbase, (vo)[h]); } else { PG8_STAGE(bufoff, (pbase) + (h) * hstep, voffA); } } while (0)
#define PG8_LDA(dst, b, h) do { _Pragma("unroll") for (int m = 0; m < 4; ++m) _Pragma("unroll") for (int k = 0; k < 2; ++k) dst[m][k] = *(const LAS bf16x8*)(lds + PG8_SA(b, h) + aoff + m * 2048 + k * 1024); } while (0)
#define PG8_LDB(dst, b, h) do { _Pragma("unroll") for (int n = 0; n < 2; ++n) _Pragma("unroll") for (int k = 0; k < 2; ++k) dst[n][k] = *(const LAS bf16x8*)(lds + PG8_SB(b, h) + boff + n * 2048 + k * 1024); } while (0)
#define PG8_MMA(ai, bj, At, Bt) do { __builtin_amdgcn_s_setprio(1); _Pragma("unroll") for (int m = 0; m < 4; ++m) _Pragma("unroll") for (int n = 0; n < 2; ++n) _Pragma("unroll") for (int k = 0; k < 2; ++k) \
        acc[ai][bj][m][n] = __builtin_amdgcn_mfma_f32_16x16x32_bf16(Bt[n][k], At[m][k], acc[ai][bj][m][n], 0, 0, 0); __builtin_amdgcn_s_setprio(0); } while (0)
#define PG8_WAIT_V(n) asm volatile("s_waitcnt vmcnt(" #n ")" ::: "memory")
#define PG8_WAIT_L(n) asm volatile("s_waitcnt lgkmcnt(" #n ")" ::: "memory")
#define PG8_BAR __builtin_amdgcn_s_barrier()
#define PG8_SCHED __builtin_amdgcn_sched_barrier(0)
#define PG8_GVO(dst, ui_) do { _Pragma("unroll") for (int _h = 0; _h < 2; ++_h) _Pragma("unroll") for (int _i = 0; _i < 2; ++_i) \
        dst[_h][_i] = (unsigned)gtab[(ui_) * 256 + _h * HALF + RA[_i]] * (unsigned)(K * 2) + (unsigned)(CA[_i] * 2); } while (0)
    Unit cur, nxt; int ui = 0;
    if (!S.next(0, cur)) return;
    f32x4 acc[2][2][4][2];
#pragma unroll
    for (int a = 0; a < 2; ++a)
#pragma unroll
        for (int b = 0; b < 2; ++b)
#pragma unroll
            for (int m = 0; m < 4; ++m)
#pragma unroll
                for (int n = 0; n < 2; ++n) acc[a][b][m][n] = (f32x4){0.f, 0.f, 0.f, 0.f};
    bf16x8 At[4][2], B0[2][2], B1[2][2];
    unsigned voC[2][2], voN[2][2];
    if constexpr (GATHER) { PG8_GVO(voC, 0); PG8_WAIT_L(0); }
    const char* gA = (const char*)g.A;
    const char* cA = GATHER ? gA : gA + (size_t)cur.pm * tstep; const char* cB = (const char*)g.Bt + (size_t)cur.pn * tstep;
    PG8_STAGE(PG8_SB(0, 0), cB, voffB); PG8_STAGE(PG8_SB(0, 1), cB + hstep, voffB); PG8_STAGE_A(PG8_SA(0, 0), cA, cA, 0, voC); PG8_STAGE_A(PG8_SA(0, 1), cA, cA, 1, voC);
    if (wr == 1) PG8_BAR;
    PG8_WAIT_V(2); PG8_BAR;
    PG8_STAGE(PG8_SB(1, 0), cB + kstep, voffB); PG8_STAGE_A(PG8_SA(1, 0), cA + kstep, cA + kstep, 0, voC); PG8_STAGE(PG8_SB(1, 1), cB + hstep + kstep, voffB);
    PG8_WAIT_V(6); PG8_BAR;
    for (;;) {
        const bool has_next = S.next(ui + 1, nxt);
        const char* nA = (has_next && !GATHER) ? gA + (size_t)nxt.pm * tstep : cA; const char* nB = has_next ? (const char*)g.Bt + (size_t)nxt.pn * tstep : cB;
        if constexpr (GATHER) { if (has_next) { PG8_GVO(voN, ui + 1); } else {
#pragma unroll
            for (int _h = 0; _h < 2; ++_h)
#pragma unroll
                for (int _i = 0; _i < 2; ++_i) voN[_h][_i] = voC[_h][_i]; } }
        for (int t = 0; t < nt; t += 2) {
            const bool last = (t == nt - 2);
            const char* a1 = cA + (size_t)(t + 1) * kstep;
            const char* a2 = last ? nA : cA + (size_t)(t + 2) * kstep; const char* b2 = last ? nB : cB + (size_t)(t + 2) * kstep;
            const char* a3 = a2 + kstep; const char* b3 = b2 + kstep;
            unsigned vs[2][2];
            if constexpr (GATHER) {
#pragma unroll
                for (int _h = 0; _h < 2; ++_h)
#pragma unroll
                    for (int _i = 0; _i < 2; ++_i) vs[_h][_i] = last ? voN[_h][_i] : voC[_h][_i]; }
            PG8_LDB(B0, 0, 0); PG8_LDB(B1, 0, 1); PG8_SCHED; PG8_LDA(At, 0, 0); PG8_STAGE_A(PG8_SA(1, 1), a1, a1, 1, voC);
            PG8_WAIT_V(8); PG8_WAIT_L(0); PG8_BAR; PG8_MMA(0, 0, At, B0); PG8_MMA(0, 1, At, B1); PG8_BAR; PG8_SCHED;
            PG8_LDA(At, 0, 1); PG8_STAGE(PG8_SB(0, 0), b2, voffB); PG8_STAGE(PG8_SB(0, 1), b2 + hstep, voffB); PG8_STAGE_A(PG8_SA(0, 0), a2, a2, 0, vs);
            PG8_WAIT_V(8); PG8_WAIT_L(0); PG8_BAR; PG8_MMA(1, 0, At, B0); PG8_MMA(1, 1, At, B1); PG8_BAR; PG8_SCHED;
            PG8_LDB(B0, 1, 0); PG8_LDB(B1, 1, 1); PG8_SCHED; PG8_LDA(At, 1, 0); PG8_STAGE_A(PG8_SA(0, 1), a2, a2, 1, vs);
            PG8_WAIT_V(8); PG8_WAIT_L(0); PG8_BAR; PG8_MMA(0, 0, At, B0); PG8_MMA(0, 1, At, B1); PG8_BAR; PG8_SCHED;
            PG8_LDA(At, 1, 1); PG8_STAGE(PG8_SB(1, 0), b3, voffB); PG8_STAGE(PG8_SB(1, 1), b3 + hstep, voffB); PG8_STAGE_A(PG8_SA(1, 0), a3, a3, 0, vs);
            PG8_WAIT_V(8); PG8_WAIT_L(0); PG8_BAR; PG8_MMA(1, 0, At, B0); PG8_MMA(1, 1, At, B1); PG8_BAR; PG8_SCHED;
        }
        if (wr == 0) PG8_BAR;
        E(acc, cur, wr, wc, fr, fq);
        if (!has_next) break;
#pragma unroll
        for (int a = 0; a < 2; ++a)
#pragma unroll
            for (int b = 0; b < 2; ++b)
#pragma unroll
                for (int m = 0; m < 4; ++m)
#pragma unroll
                    for (int n = 0; n < 2; ++n) acc[a][b][m][n] = (f32x4){0.f, 0.f, 0.f, 0.f};
        cur = nxt; cA = nA; cB = nB; ++ui;
        if constexpr (GATHER) {
#pragma unroll
            for (int _h = 0; _h < 2; ++_h)
#pragma unroll
                for (int _i = 0; _i < 2; ++_i) voC[_h][_i] = voN[_h][_i]; }
        if (wr == 1) PG8_BAR;
    }
    PG8_WAIT_V(0);
    PG8_BAR;
#undef PG8_SA
#undef PG8_SB
#undef PG8_STAGE
#undef PG8_STAGE_A
#undef PG8_LDA
#undef PG8_LDB
#undef PG8_MMA
#undef PG8_WAIT_V
#undef PG8_WAIT_L
#undef PG8_BAR
#undef PG8_SCHED
#undef PG8_GVO
}
struct GridOrder {
    int nMx, nN, x, j, W;
    __device__ __forceinline__ void init(int nM, int nN_, int G, int c) { nMx = nM / 8; nN = nN_; x = c & 7; j = c >> 3; W = (G - x + 7) >> 3; }
    __device__ __forceinline__ bool next(int i, Unit& u) const { const int L = i * W + j; if (L >= nMx * nN) return false; u.pm = x * nMx + L % nMx; u.pn = L / nMx; u.cn = u.pn; return true; }
};
struct ListOrder {
    int first, n, nN;
    __device__ __forceinline__ bool next(int i, Unit& u) const { if (i > 0 || first < 0 || first >= n) return false; u.pm = first / nN; u.pn = first % nN; u.cn = u.pn; return true; }
};
struct MoeOrder {
    int pe[16]; int nC, t0, t1, j, W;
    __device__ __forceinline__ void init(const unsigned* cnt, int nC_, int G, int c) { int a = 0;
#pragma unroll
        for (int e = 0; e < 16; ++e) { a += (int)((__builtin_amdgcn_readfirstlane(cnt[e]) + 255u) >> 8); pe[e] = a; }
        const int x = c & 7; nC = nC_; j = c >> 3; W = (G - x + 7) >> 3; t0 = (x * a) >> 3; t1 = ((x + 1) * a) >> 3; }
    __device__ __forceinline__ void expert_of(int rt, int& e, int& start) const { e = 0; start = 0;
#pragma unroll
        for (int q = 0; q < 16; ++q) if (rt >= pe[q]) { e = q + 1; start = pe[q]; } }
    __device__ __forceinline__ bool next(int i, Unit& u) const { const int L = i * W + j; const int rt = t0 + L / nC, cl = L % nC; if (rt >= t1) return false;
        int e, st; expert_of(rt, e, st); u.pm = rt; u.pn = e * nC + cl; u.cn = cl; return true; }
};
}

constexpr int GTAB_OFF = 131072 + 1024;
__device__ __forceinline__ void stage_proj(const Params& p, LAS unsigned char* lds, int l, int blk, int nblk, int wv_) {
    unsigned char* ws = p.ws;
    { pg8::Gemm g{(const bf16*)(ws + WS_XB), (const bf16*)(ws + WS_WT_IN) + (size_t)l * NPROJ * DM, DM}; pg8::GridOrder S; S.init(T / 256, NPROJ / 256, nblk, blk);
      pg8::EpiBf16 E{(bf16*)(ws + WS_P), NPROJ, 0, 0};
      pg8::gemm_phase<pg8::EpiBf16, pg8::GridOrder, false>(lds, g, S, E, nullptr, wv_); }
    if (l == 0) {
        pg8::Gemm g{(const bf16*)(ws + WS_MEMB), (const bf16*)(ws + WS_WT_KV), DM}; pg8::ListOrder S{nblk >= 208 ? blk - 192 : blk, 16, 4};
        pg8::EpiBf16 E{(bf16*)(ws + WS_KV), 512, 512, (size_t)1024 * 512};
        pg8::gemm_phase<pg8::EpiBf16, pg8::ListOrder, false>(lds, g, S, E, nullptr, wv_); }
}
__device__ __forceinline__ void stage_out(const Params& p, LAS unsigned char* lds, int l, int blk, int nblk, int wv_) {
    unsigned char* ws = p.ws;
    pg8::Gemm g{(const bf16*)(ws + WS_MIX), (const bf16*)(ws + WS_WT_OUT) + (size_t)l * DM * DM, DM}; pg8::GridOrder S; S.init(T / 256, DM / 256, nblk, blk);
    pg8::EpiResF32 E{l == 0 ? p.x : p.out, p.out, DM, ALPHA};
    pg8::gemm_phase<pg8::EpiResF32, pg8::GridOrder, false>(lds, g, S, E, nullptr, wv_);
}
__device__ __forceinline__ void stage_moe1(const Params& p, LAS unsigned char* lds, int l, int blk, int nblk, int wv_) {
    unsigned char* ws = p.ws; const unsigned* cnt = (const unsigned*)(ws + WS_CTL) + CW_CNT + l * 16; const int* LIST = (const int*)(ws + WS_LIST);
    pg8::MoeOrder S; S.init(cnt, 8, nblk, blk);
    LAS int* gtab = (LAS int*)(lds + GTAB_OFF);
    { pg8::Unit u; const int tid = otid();
      for (int i = 0; i < 12 && S.next(i, u); ++i) if (tid < 256) { int e, st; S.expert_of(u.pm, e, st); const int pos = (u.pm - st) * 256 + tid; gtab[i * 256 + tid] = pos < (int)cnt[e] ? LIST[e * T + pos] : 0; }
      __syncthreads(); }
    pg8::Gemm g{(const bf16*)(ws + WS_XB), (const bf16*)(ws + WS_WT_GU) + (size_t)l * 16 * 2048 * DM, DM};
    pg8::EpiSwiGLU E{(bf16*)(ws + WS_H), DM};
    pg8::gemm_phase<pg8::EpiSwiGLU, pg8::MoeOrder, true>(lds, g, S, E, gtab, wv_);
}
__device__ __forceinline__ void stage_moe2(const Params& p, LAS unsigned char* lds, int l, int blk, int nblk, int wv_) {
    unsigned char* ws = p.ws; const unsigned* cnt = (const unsigned*)(ws + WS_CTL) + CW_CNT + l * 16;
    pg8::MoeOrder S; S.init(cnt, 4, nblk, blk);
    pg8::Gemm g{(const bf16*)(ws + WS_H), (const bf16*)(ws + WS_WT_DN) + (size_t)l * 16 * DM * DM, DM};
    pg8::EpiBf16 E{(bf16*)(ws + WS_Y), DM, 0, 0};
    pg8::gemm_phase<pg8::EpiBf16, pg8::MoeOrder, false>(lds, g, S, E, nullptr, wv_);
}

constexpr int CW_BAR = 4096;
#define XB_TMO      128
#define XB_XCNT(j)  (256  + 64 * (j))
#define XB_XSUB(j)  (1280 + 64 * (j))
#define XB_XGEN(j)  (2304 + 64 * (j))
#define XB_TOP      3328
#define XB_TOPGEN   3392
#define XCD_BAR_WORDS 3456
#define XB_SPIN_CAP (1u << 18)

__device__ __forceinline__ unsigned xb_ld(unsigned* p)              { return __hip_atomic_load(p, __ATOMIC_RELAXED, __HIP_MEMORY_SCOPE_AGENT); }
__device__ __forceinline__ unsigned xb_add(unsigned* p, unsigned v) { return __hip_atomic_fetch_add(p, v, __ATOMIC_RELAXED, __HIP_MEMORY_SCOPE_AGENT); }
__device__ __forceinline__ unsigned xb_xcc_id() { return (unsigned)__builtin_amdgcn_s_getreg((3 << 11) | 20) & 0xFu; }
#define XB_SPIN(cond, bar) do { unsigned _sp = 0; while (cond) { __builtin_amdgcn_s_sleep(1); \
    if ((++_sp & 255u) == 0u) { if (xb_ld(&(bar)[XB_TMO])) break; if (_sp > XB_SPIN_CAP) { atomicAdd(&(bar)[XB_TMO], 1u); break; } } } } while (0)

struct XcdBarrier {
    unsigned* bar; unsigned x;
    volatile LAS unsigned* st;
    bool leader;
};

__device__ __forceinline__ XcdBarrier xcd_barrier_post(unsigned* bar, volatile LAS unsigned* st) {
    XcdBarrier b; b.bar = bar; b.x = xb_xcc_id(); b.st = st; b.leader = (threadIdx.x == 0);
    if (threadIdx.x == 0) (void)xb_add(&bar[XB_XCNT(b.x)], 1u);
    return b;
}
__device__ __forceinline__ void xcd_barrier_complete(unsigned* bar, unsigned x, unsigned& nloc, unsigned& nx) {
    const unsigned G = gridDim.x * gridDim.y * gridDim.z;
    unsigned sum, cnt, mine, sp = 0u;
    for (;;) {
        sum = 0u; cnt = 0u; mine = 0u;
#pragma unroll
        for (unsigned j = 0; j < 16; ++j) { const unsigned c = xb_ld(&bar[XB_XCNT(j)]); sum += c; cnt += (c > 0u) ? 1u : 0u; mine = (j == x) ? c : mine; }
        if (sum == G) break;
        __builtin_amdgcn_s_sleep(1);
        if ((++sp & 255u) == 0u) { if (xb_ld(&bar[XB_TMO])) break; if (sp > XB_SPIN_CAP) { atomicAdd(&bar[XB_TMO], 1u); break; } }
    }
    nloc = mine > 0u ? mine : 1u; nx = cnt > 0u ? cnt : 1u;
}

__device__ __forceinline__ void xcd_barrier(const XcdBarrier& b) {
    asm volatile("s_waitcnt vmcnt(0)" ::: "memory");
    __syncthreads();
    if (b.leader) {
        unsigned* bar = b.bar;
        __builtin_amdgcn_s_waitcnt(0);
        unsigned nloc = b.st[0], nx = b.st[1];
        if (nloc == 0u) { xcd_barrier_complete(bar, b.x, nloc, nx); b.st[0] = nloc; b.st[1] = nx; }
        const unsigned old = xb_add(&bar[XB_XSUB(b.x)], 1u);
        const unsigned gen = old / nloc;
        if (old + 1u == (gen + 1u) * nloc) {
            __builtin_amdgcn_fence(__ATOMIC_RELEASE, "agent");
            asm volatile("s_waitcnt vmcnt(0)" ::: "memory");
            const unsigned og = xb_add(&bar[XB_TOP], 1u);
            const unsigned tg = og / nx;
            if (og + 1u == (tg + 1u) * nx) xb_add(&bar[XB_TOPGEN], 1u);
            else XB_SPIN(xb_ld(&bar[XB_TOPGEN]) == tg, bar);
            __builtin_amdgcn_fence(__ATOMIC_ACQUIRE, "agent");
            xb_add(&bar[XB_XGEN(b.x)], 1u);
            asm volatile("s_waitcnt vmcnt(0)" ::: "memory");
        } else {
            XB_SPIN(xb_ld(&bar[XB_XGEN(b.x)]) == gen, bar);
            __builtin_amdgcn_fence(__ATOMIC_ACQUIRE, "agent");
            asm volatile("s_waitcnt vmcnt(0)" ::: "memory");
        }
    }
    __syncthreads();
}

constexpr int RING_BYTES = 131072;
constexpr int MISC_OFF = RING_BYTES + 320;
constexpr int LDS_BYTES = 147456;


__device__ __forceinline__ void launder(Params& q) {
#define LND(f) asm volatile("" : "+s"(q.f))
    LND(x); LND(mem); LND(w_in); LND(w_out); LND(rel_bias); LND(conv_w); LND(conv_b); LND(dt_bias); LND(a_log); LND(d_skip); LND(ssd_norm_w); LND(w_mem_kv); LND(mem_bias);
    LND(ln1_g); LND(ln1_b); LND(ln2_g); LND(ln2_b); LND(w_router); LND(b_router); LND(w_gate); LND(w_up); LND(w_down); LND(out); LND(ws);
#undef LND
}
__global__ void __launch_bounds__(NTHREADS, 2) mega_fwd(Params p) {
    extern __shared__ __attribute__((aligned(16))) unsigned char lds_raw[];
    LAS unsigned char* lds = (LAS unsigned char*)lds_raw;
    const int tid = threadIdx.x, blk = blockIdx.x, nblk = gridDim.x; const int wv_ = __builtin_amdgcn_readfirstlane(tid >> 6);
    for (int u = tid; u < (LDS_BYTES - RING_BYTES) / 4; u += NTHREADS) ((LAS unsigned*)(lds + RING_BYTES))[u] = 0u;
    __syncthreads();
    volatile LAS unsigned* MISC = (volatile LAS unsigned*)(lds + MISC_OFF);
    (void)xcd_barrier_post((unsigned*)(p.ws + WS_CTL) + CW_BAR, MISC + 8);
#define GRID_BAR() do { XcdBarrier b_; b_.bar = (unsigned*)(p.ws + WS_CTL) + CW_BAR; b_.x = xb_xcc_id(); b_.st = (volatile LAS unsigned*)(lds + MISC_OFF) + 8; b_.leader = (otid() == 0); xcd_barrier(b_); } while (0)
    stage_prologue(p, lds, blk, nblk, wv_);
    GRID_BAR();
#pragma unroll 1
    for (int l = 0; l < DEPTH; ++l) {
        Params q = p; launder(q);
        stage_proj(q, lds, l, blk, nblk, wv_);
        GRID_BAR();
        stage_attn_ref(q, l, blk, nblk, wv_); stage_memattn_ref(q, l, blk, nblk, wv_); stage_conv_ref(q, l, blk, nblk, wv_);
        GRID_BAR();
        if (blk < NB * 4) stage_ssd_ref(q, l, blk, NB * 4, wv_); else stage_merge(q, blk - NB * 4, nblk - NB * 4, wv_);
        GRID_BAR();
        stage_gate_ref(q, l, blk, nblk, wv_);
        GRID_BAR();
        stage_out(q, lds, l, blk, nblk, wv_);
        GRID_BAR();
        stage_ln1_router(q, l, blk, nblk, wv_);
        GRID_BAR();
        stage_moe1(q, lds, l, blk, nblk, wv_);
        GRID_BAR();
        stage_moe2(q, lds, l, blk, nblk, wv_);
        GRID_BAR();
        stage_ln2(q, l, blk, nblk, wv_);
        if (l + 1 < DEPTH) GRID_BAR();
    }
}

extern "C" void kernel_launch(void* const* d_in, const int* in_sizes, int n_in, void* d_out, int out_size, void* d_ws, size_t ws_size, hipStream_t stream) {
    if (n_in != 22 || out_size != T * DM || ws_size < WS_END) { fprintf(stderr, "kernel_launch: unexpected shapes (n_in %d out %d ws %zu)\n", n_in, out_size, ws_size); return; }
    static int grid = 0;
    if (grid == 0) {
        int dev = 0, cus = 0, per_cu = 0;
        if (hipGetDevice(&dev) != hipSuccess || hipDeviceGetAttribute(&cus, hipDeviceAttributeMultiprocessorCount, dev) != hipSuccess) { grid = -1; return; }
        if (hipFuncSetAttribute((const void*)mega_fwd, hipFuncAttributeMaxDynamicSharedMemorySize, LDS_BYTES) != hipSuccess) { fprintf(stderr, "kernel_launch: hipFuncSetAttribute failed\n"); grid = -1; return; }
        if (hipOccupancyMaxActiveBlocksPerMultiprocessor(&per_cu, (const void*)mega_fwd, NTHREADS, LDS_BYTES) != hipSuccess || per_cu < 1) fprintf(stderr, "kernel_launch: occupancy query reports %d\n", per_cu);
        (void)hipGetLastError();
        grid = cus;
    }
    if (grid < 0) return;
    Params p{};
    const float** pp = (const float**)&p;
    for (int i = 0; i < 22; ++i) pp[i] = (const float*)d_in[i];
    p.out = (float*)d_out; p.ws = (unsigned char*)d_ws;
    (void)hipMemsetAsync((char*)d_ws + WS_CTL, 0, CTL_ZERO_BYTES, stream);
    hipLaunchKernelGGL(mega_fwd, dim3(grid), dim3(NTHREADS), LDS_BYTES, stream, p);
}
```

```cpp
#include <hip/hip_runtime.h>
#include <cstdio>
#include <cstdint>

#define GAS __attribute__((address_space(1)))
#define LAS __attribute__((address_space(3)))
typedef unsigned short bf16;
typedef short bf16x8 __attribute__((ext_vector_type(8)));
typedef float f32x4 __attribute__((ext_vector_type(4)));
typedef float f32x16 __attribute__((ext_vector_type(16)));
typedef unsigned u32x4 __attribute__((ext_vector_type(4)));
typedef unsigned u32x2 __attribute__((ext_vector_type(2)));

constexpr int NB = 4, SEQ = 4096, T = NB * SEQ, DM = 1024, DEPTH = 2;
constexpr int NCOLS_IN = 2820, NPROJ = 2816;
constexpr int C_Q = 0, C_K = 512, C_V = 1024, C_Z = 1536, C_XBC = 1792, C_QM = 2560;
constexpr int NE = 16, NMEM = 256;
constexpr int HROWS = 36864;
constexpr float ALPHA = 1.41421356237309515f;
constexpr float LN_EPS = 1e-5f, RMS_EPS = 1e-5f;
constexpr int NTHREADS = 512, NWAVES = 8;

constexpr size_t MiB = 1u << 20;
constexpr size_t WS_CTL = 0, CTL_ZERO_BYTES = 1 * MiB;
constexpr size_t WS_BIAST = 1 * MiB;
constexpr size_t WS_KV = 2 * MiB;
constexpr size_t WS_MEMB = 4 * MiB;
constexpr size_t WS_WT_KV = 6 * MiB;
constexpr size_t WS_WT_OUT = 8 * MiB;
constexpr size_t WS_WT_IN = 12 * MiB;
constexpr size_t WS_WT_GU = 24 * MiB;
constexpr size_t WS_WT_DN = 152 * MiB;
constexpr size_t WS_XB = 216 * MiB;
constexpr size_t WS_MIX = 248 * MiB;
constexpr size_t WS_DT = 280 * MiB;
constexpr size_t WS_TOKE = 281 * MiB;
constexpr size_t WS_TOKP = WS_TOKE + 128 * 1024;
constexpr size_t WS_TOKW = WS_TOKP + 128 * 1024;
constexpr size_t WS_LIST = 282 * MiB;
constexpr size_t WS_SST = 284 * MiB;
constexpr size_t WS_P = 300 * MiB;
constexpr size_t WS_ATTO = 388 * MiB;
constexpr size_t WS_LSE = 436 * MiB;
constexpr size_t WS_H = 300 * MiB;
constexpr size_t WS_Y = 372 * MiB;
constexpr size_t WS_XBCC = 444 * MiB;
constexpr size_t WS_YS = 492 * MiB;
constexpr size_t WS_END = 508 * MiB;
constexpr int CW_CNT = 64;

struct Params {
    const float *x, *mem, *w_in, *w_out, *rel_bias, *conv_w, *conv_b, *dt_bias, *a_log, *d_skip, *ssd_norm_w, *w_mem_kv, *mem_bias,
        *ln1_g, *ln1_b, *ln2_g, *ln2_b, *w_router, *b_router, *w_gate, *w_up, *w_down;
    float* out; unsigned char* ws;
};

__device__ __forceinline__ int otid_w(int wv) { int t; asm volatile("v_mbcnt_lo_u32_b32 %0, -1, 0\n\tv_mbcnt_hi_u32_b32 %0, -1, %0\n\tv_lshl_add_u32 %0, %1, 6, %0" : "=&v"(t) : "s"(wv)); return t; }
#define otid() otid_w(wv_)
__device__ __forceinline__ unsigned f2bf(float f) { unsigned u = __builtin_bit_cast(unsigned, f); return (u + 0x7fffu + ((u >> 16) & 1u)) >> 16; }
__device__ __forceinline__ unsigned pk2(float lo, float hi) { return f2bf(lo) | (f2bf(hi) << 16); }
__device__ __forceinline__ float bf2f(unsigned b) { return __builtin_bit_cast(float, b << 16); }
__device__ __forceinline__ float bflo(unsigned w) { return __builtin_bit_cast(float, w << 16); }
__device__ __forceinline__ float bfhi(unsigned w) { return __builtin_bit_cast(float, w & 0xffff0000u); }
__device__ __forceinline__ float wave_sum(float v) {
#pragma unroll
    for (int o = 1; o < 64; o <<= 1) v += __shfl_xor(v, o);
    return v;
}
__device__ __forceinline__ float wave_max(float v) {
#pragma unroll
    for (int o = 1; o < 64; o <<= 1) v = fmaxf(v, __shfl_xor(v, o));
    return v;
}
__device__ __forceinline__ float silu_f(float v) { return v / (1.f + __expf(-v)); }
__device__ __forceinline__ float softplus_f(float v) { return v > 20.f ? v : log1pf(__expf(v)); }
__device__ __forceinline__ int crow(int r, int hi) { return (r & 3) + 8 * (r >> 2) + 4 * hi; }

__device__ __forceinline__ void transpose_item(const float* W, int ldw, int src_col0, bf16* WT, int K, int dst_row0, float scale, LAS float* scr, int k0, int lane) {
#pragma unroll 8
    for (int i = 0; i < 32; ++i) { const int kk = 2 * i + (lane >> 5); scr[kk * 33 + (lane & 31)] = W[(size_t)(k0 + kk) * ldw + src_col0 + (lane & 31)]; }
    asm volatile("s_waitcnt lgkmcnt(0)" ::: "memory");
    const int c = lane & 7;
#pragma unroll
    for (int j = 0; j < 4; ++j) { const int n = (lane >> 3) + 8 * j; const LAS float* s = scr + (8 * c) * 33 + n;
        u32x4 o; o.x = pk2(s[0 * 33] * scale, s[1 * 33] * scale); o.y = pk2(s[2 * 33] * scale, s[3 * 33] * scale); o.z = pk2(s[4 * 33] * scale, s[5 * 33] * scale); o.w = pk2(s[6 * 33] * scale, s[7 * 33] * scale);
        *(u32x4*)(WT + (size_t)(dst_row0 + n) * K + k0 + 8 * c) = o; }
    asm volatile("s_waitcnt lgkmcnt(0)" ::: "memory");
}
constexpr int I_IN = 2 * 16 * 88, I_OUT = 2 * 16 * 32, I_KV = 2 * 16 * 16, I_GU = 32 * 16 * 64, I_DN = 32 * 16 * 32;
constexpr int I_TOTAL = I_IN + I_OUT + I_KV + I_GU + I_DN;

__device__ __forceinline__ void stage_prologue(const Params& p, LAS unsigned char* lds, int blk, int nblk, int wv_) {
    const int tid = otid(), lane = tid & 63, wave = tid >> 6;
    const int gw = blk * NWAVES + wave, ngw = nblk * NWAVES;
    LAS float* scr = (LAS float*)(lds + wave * 16384);
    unsigned char* ws = p.ws;
    for (int it = gw; it < I_TOTAL; it += ngw) {
        int r = it;
        if (r < I_IN) { const int l = r / (16 * 88), q = r % (16 * 88), kb = q / 88, nb = q % 88, n0 = nb * 32;
            transpose_item(p.w_in + (size_t)l * DM * NCOLS_IN, NCOLS_IN, n0 < 2560 ? n0 : n0 + 4, (bf16*)(ws + WS_WT_IN) + (size_t)l * NPROJ * DM, DM, n0, (n0 < 512 || n0 >= 2560) ? 0.125f : 1.f, scr, kb * 64, lane); continue; }
        r -= I_IN;
        if (r < I_OUT) { const int l = r / (16 * 32), q = r % (16 * 32), kb = q / 32, nb = q % 32;
            transpose_item(p.w_out + (size_t)l * DM * DM, DM, nb * 32, (bf16*)(ws + WS_WT_OUT) + (size_t)l * DM * DM, DM, nb * 32, 1.f, scr, kb * 64, lane); continue; }
        r -= I_OUT;
        if (r < I_KV) { const int l = r / (16 * 16), q = r % (16 * 16), kb = q / 16, nb = q % 16;
            transpose_item(p.w_mem_kv + (size_t)l * DM * 512, 512, nb * 32, (bf16*)(ws + WS_WT_KV) + (size_t)l * 512 * DM, DM, nb * 32, 1.f, scr, kb * 64, lane); continue; }
        r -= I_KV;
        if (r < I_GU) { const int le = r / (16 * 64), q = r % (16 * 64), kb = q / 64, nb = q % 64, n0 = nb * 32, pn = n0 >> 8, bj = (n0 >> 7) & 1, j0 = n0 & 127;
            transpose_item((bj ? p.w_up : p.w_gate) + (size_t)le * DM * DM, DM, 128 * pn + j0, (bf16*)(ws + WS_WT_GU) + (size_t)le * 2048 * DM, DM, n0, 1.f, scr, kb * 64, lane); continue; }
        r -= I_GU;
        { const int le = r / (16 * 32), q = r % (16 * 32), kb = q / 32, nb = q % 32;
            transpose_item(p.w_down + (size_t)le * DM * DM, DM, nb * 32, (bf16*)(ws + WS_WT_DN) + (size_t)le * DM * DM, DM, nb * 32, 1.f, scr, kb * 64, lane); }
    }
    {
        bf16* XB = (bf16*)(ws + WS_XB); float* DT = (float*)(ws + WS_DT);
        for (int m = gw; m < T; m += ngw) {
            const f32x4* xr = (const f32x4*)(p.x + (size_t)m * DM) + lane;
            float d0 = 0.f, d1 = 0.f, d2 = 0.f, d3 = 0.f;
#pragma unroll
            for (int j = 0; j < 4; ++j) { const f32x4 v = xr[64 * j];
                u32x2 o; o.x = pk2(v.x, v.y); o.y = pk2(v.z, v.w); *((u32x2*)(XB + (size_t)m * DM) + lane + 64 * j) = o;
#pragma unroll
                for (int c = 0; c < 4; ++c) { const int k = 4 * lane + 256 * j + c; const f32x4 w = *(const f32x4*)(p.w_in + (size_t)k * NCOLS_IN + 2560); const float xv = v[c];
                    d0 += xv * w.x; d1 += xv * w.y; d2 += xv * w.z; d3 += xv * w.w; } }
            d0 = wave_sum(d0); d1 = wave_sum(d1); d2 = wave_sum(d2); d3 = wave_sum(d3);
            if (lane == 0) *(f32x4*)(DT + (size_t)m * 4) = (f32x4){d0, d1, d2, d3};
        }
    }
    {
        bf16* MB = (bf16*)(ws + WS_MEMB);
        for (int m = gw; m < NB * NMEM; m += ngw) {
            const f32x4* xr = (const f32x4*)(p.mem + (size_t)m * DM) + lane;
#pragma unroll
            for (int j = 0; j < 4; ++j) { const f32x4 v = xr[64 * j]; u32x2 o; o.x = pk2(v.x, v.y); o.y = pk2(v.z, v.w); *((u32x2*)(MB + (size_t)m * DM) + lane + 64 * j) = o; }
        }
    }
    if (blk == 0) {
        float* BT = (float*)(ws + WS_BIAST);
        for (int i = tid; i < 3 * 129; i += NTHREADS) { const int br = i / 129, st = i % 129, dil = br == 0 ? 1 : (br == 1 ? 4 : 16), n = st * dil; int bucket;
            if (n < 16) bucket = n; else { const float nf = (float)n; int lg = 16 + (int)(logf(nf / 16.f) / logf(128.f) * 16.f); bucket = lg < 31 ? lg : 31; }
#pragma unroll
            for (int h = 0; h < 8; ++h) BT[(br * 8 + h) * 132 + st] = p.rel_bias[bucket * 8 + h]; }
    }
}

template <class RowPtr, class Epi>
__device__ __forceinline__ void wave_gemm_tile(RowPtr arow  , const bf16* brow  , int K, int lane, Epi epi) {
    const int hi = lane >> 5;
    const bf16* ap = arow + 8 * hi; const bf16* bp = brow + 8 * hi;
    f32x16 acc = {};
    for (int k0 = 0; k0 < K; k0 += 16) { const bf16x8 a = *(const bf16x8*)(ap + k0); const bf16x8 b = *(const bf16x8*)(bp + k0); acc = __builtin_amdgcn_mfma_f32_32x32x16_bf16(b, a, acc, 0, 0, 0); }
#pragma unroll
    for (int g = 0; g < 4; ++g) epi(8 * g + 4 * hi, acc[4 * g], acc[4 * g + 1], acc[4 * g + 2], acc[4 * g + 3]);
}

__device__ __forceinline__ void stage_proj_ref(const Params& p, int l, int blk, int nblk, int wv_) {
    const int tid = otid(), lane = tid & 63, wave = tid >> 6, gw = blk * NWAVES + wave, ngw = nblk * NWAVES;
    unsigned char* ws = p.ws;
    const bf16* XB = (const bf16*)(ws + WS_XB); const bf16* WT = (const bf16*)(ws + WS_WT_IN) + (size_t)l * NPROJ * DM; bf16* P = (bf16*)(ws + WS_P);
    constexpr int NT = NPROJ / 32, MT = T / 32;
    for (int tile = gw; tile < MT * NT; tile += ngw) { const int tm = tile / NT, tn = tile % NT; const int m = tm * 32 + (lane & 31);
        wave_gemm_tile(XB + (size_t)m * DM, WT + (size_t)(tn * 32 + (lane & 31)) * DM, DM, lane, [&](int nn, float a, float b, float c, float d) {
            u32x2 o; o.x = pk2(a, b); o.y = pk2(c, d); *(u32x2*)(P + (size_t)m * NPROJ + tn * 32 + nn) = o; }); }
    if (l == 0) {
        const bf16* MB = (const bf16*)(ws + WS_MEMB);
        constexpr int NT2 = 512 / 32, MT2 = NB * NMEM / 32;
        for (int tile = gw; tile < 2 * MT2 * NT2; tile += ngw) { const int ll = tile / (MT2 * NT2), q = tile % (MT2 * NT2), tm = q / NT2, tn = q % NT2; const int m = tm * 32 + (lane & 31);
            const bf16* WK = (const bf16*)(ws + WS_WT_KV) + (size_t)ll * 512 * DM; bf16* KV = (bf16*)(ws + WS_KV) + (size_t)ll * 1024 * 512;
            wave_gemm_tile(MB + (size_t)m * DM, WK + (size_t)(tn * 32 + (lane & 31)) * DM, DM, lane, [&](int nn, float a, float b, float c, float d) {
                u32x2 o; o.x = pk2(a, b); o.y = pk2(c, d); *(u32x2*)(KV + (size_t)m * 512 + tn * 32 + nn) = o; }); }
    }
}

__device__ __forceinline__ float dot64(const bf16* row, const unsigned (&qw)[32]) {
    float s = 0.f;
#pragma unroll
    for (int c = 0; c < 8; ++c) { const u32x4 kv = *(const u32x4*)(row + 8 * c);
        s += bflo(kv.x) * bflo(qw[4 * c]) + bfhi(kv.x) * bfhi(qw[4 * c]); s += bflo(kv.y) * bflo(qw[4 * c + 1]) + bfhi(kv.y) * bfhi(qw[4 * c + 1]);
        s += bflo(kv.z) * bflo(qw[4 * c + 2]) + bfhi(kv.z) * bfhi(qw[4 * c + 2]); s += bflo(kv.w) * bflo(qw[4 * c + 3]) + bfhi(kv.w) * bfhi(qw[4 * c + 3]); }
    return s;
}
__device__ __forceinline__ void stage_attn_ref(const Params& p, int l, int blk, int nblk, int wv_) {
    const int tid = otid(), lane = tid & 63, wave = tid >> 6, gw = blk * NWAVES + wave, ngw = nblk * NWAVES;
    unsigned char* ws = p.ws; const bf16* P = (const bf16*)(ws + WS_P); const float* BT = (const float*)(ws + WS_BIAST);
    bf16* AO = (bf16*)(ws + WS_ATTO); float* LSE = (float*)(ws + WS_LSE);
    for (int task = gw; task < 3 * T * 8; task += ngw) {
        const int br = task / (T * 8), q = task % (T * 8), t = q >> 3, h = q & 7, s = t % SEQ, dil = br == 0 ? 1 : (br == 1 ? 4 : 16);
        unsigned qw[32];
        { const u32x4* qp = (const u32x4*)(P + (size_t)t * NPROJ + C_Q + h * 64);
#pragma unroll
            for (int c = 0; c < 8; ++c) { const u32x4 v = qp[c]; qw[4 * c] = v.x; qw[4 * c + 1] = v.y; qw[4 * c + 2] = v.z; qw[4 * c + 3] = v.w; } }
        float sc[3];
#pragma unroll
        for (int kk = 0; kk < 3; ++kk) { const int st = lane + 64 * kk; const bool valid = st <= 128 && s - st * dil >= 0; sc[kk] = -INFINITY;
            if (valid) sc[kk] = dot64(P + (size_t)(t - st * dil) * NPROJ + C_K + h * 64, qw) + BT[(br * 8 + h) * 132 + st]; }
        const float mx = wave_max(fmaxf(fmaxf(sc[0], sc[1]), sc[2]));
        float pr[3], ls = 0.f;
#pragma unroll
        for (int kk = 0; kk < 3; ++kk) { pr[kk] = __expf(sc[kk] - mx); ls += pr[kk]; }
        ls = wave_sum(ls);
        float o = 0.f;
        const int nst = min(128, s / dil);
        for (int st = 0; st <= nst; ++st) { const float pj = __shfl(st < 64 ? pr[0] : (st < 128 ? pr[1] : pr[2]), st & 63);
            o += pj * bf2f(P[(size_t)(t - st * dil) * NPROJ + C_V + h * 64 + lane]); }
        AO[((size_t)br * T + t) * 512 + h * 64 + lane] = (bf16)f2bf(o / ls);
        if (lane == 0) LSE[((size_t)br * T + t) * 8 + h] = mx + __logf(ls);
    }
}
__device__ __forceinline__ void stage_merge(const Params& p, int blk, int nblk, int wv_) {
    const int tid = otid(), lane = tid & 63, wave = tid >> 6, gw = blk * NWAVES + wave, ngw = nblk * NWAVES;
    unsigned char* ws = p.ws; const bf16* AO = (const bf16*)(ws + WS_ATTO); const float* LSE = (const float*)(ws + WS_LSE); bf16* MIX = (bf16*)(ws + WS_MIX);
    for (int t = gw; t < T; t += ngw) {
        const int h = lane >> 3;
        const float l0 = LSE[((size_t)0 * T + t) * 8 + h], l1 = LSE[((size_t)1 * T + t) * 8 + h], l2 = LSE[((size_t)2 * T + t) * 8 + h];
        const float mx = fmaxf(fmaxf(l0, l1), l2); float w0 = __expf(l0 - mx), w1 = __expf(l1 - mx), w2 = __expf(l2 - mx); const float inv = 1.f / (w0 + w1 + w2); w0 *= inv; w1 *= inv; w2 *= inv;
        const u32x4 a = *(const u32x4*)(AO + ((size_t)0 * T + t) * 512 + lane * 8), b = *(const u32x4*)(AO + ((size_t)1 * T + t) * 512 + lane * 8), c = *(const u32x4*)(AO + ((size_t)2 * T + t) * 512 + lane * 8);
        u32x4 o;
#pragma unroll
        for (int i = 0; i < 4; ++i) o[i] = pk2(w0 * bflo(a[i]) + w1 * bflo(b[i]) + w2 * bflo(c[i]), w0 * bfhi(a[i]) + w1 * bfhi(b[i]) + w2 * bfhi(c[i]));
        *(u32x4*)(MIX + (size_t)t * DM + lane * 8) = o;
    }
}
__device__ __forceinline__ void stage_memattn_ref(const Params& p, int l, int blk, int nblk, int wv_) {
    const int tid = otid(), lane = tid & 63, wave = tid >> 6, gw = blk * NWAVES + wave, ngw = nblk * NWAVES;
    unsigned char* ws = p.ws; const bf16* P = (const bf16*)(ws + WS_P); const bf16* KV = (const bf16*)(ws + WS_KV) + (size_t)l * 1024 * 512; bf16* MIX = (bf16*)(ws + WS_MIX);
    for (int task = gw; task < T * 4; task += ngw) {
        const int t = task >> 2, h = task & 3, b = t / SEQ;
        unsigned qw[32];
        { const u32x4* qp = (const u32x4*)(P + (size_t)t * NPROJ + C_QM + h * 64);
#pragma unroll
            for (int c = 0; c < 8; ++c) { const u32x4 v = qp[c]; qw[4 * c] = v.x; qw[4 * c + 1] = v.y; qw[4 * c + 2] = v.z; qw[4 * c + 3] = v.w; } }
        float sc[4];
#pragma unroll
        for (int kk = 0; kk < 4; ++kk) { const int j = lane + 64 * kk; sc[kk] = dot64(KV + (size_t)(b * NMEM + j) * 512 + h * 64, qw) + p.mem_bias[(l * 4 + h) * NMEM + j]; }
        const float mx = wave_max(fmaxf(fmaxf(sc[0], sc[1]), fmaxf(sc[2], sc[3])));
        float pr[4], ls = 0.f;
#pragma unroll
        for (int kk = 0; kk < 4; ++kk) { pr[kk] = __expf(sc[kk] - mx); ls += pr[kk]; }
        ls = wave_sum(ls);
        float o = 0.f;
        for (int j = 0; j < NMEM; ++j) { const int kk = j >> 6; const float pj = __shfl(kk == 0 ? pr[0] : (kk == 1 ? pr[1] : (kk == 2 ? pr[2] : pr[3])), j & 63);
            o += pj * bf2f(KV[(size_t)(b * NMEM + j) * 512 + 256 + h * 64 + lane]); }
        MIX[(size_t)t * DM + 768 + h * 64 + lane] = (bf16)f2bf(o / ls);
    }
}
__device__ __forceinline__ void stage_conv_ref(const Params& p, int l, int blk, int nblk, int wv_) {
    unsigned char* ws = p.ws; const bf16* P = (const bf16*)(ws + WS_P); float* XC = (float*)(ws + WS_XBCC);
    const float* cw = p.conv_w + (size_t)l * 4 * 768; const float* cb = p.conv_b + (size_t)l * 768;
    for (size_t i = (size_t)blk * NTHREADS + otid(); i < (size_t)T * 768; i += (size_t)nblk * NTHREADS) {
        const int t = (int)(i / 768), c = (int)(i % 768), s = t % SEQ; float a = cb[c];
#pragma unroll
        for (int k = 0; k < 4; ++k) { const int sp = s + k - 3; if (sp >= 0) a += cw[k * 768 + c] * bf2f(P[(size_t)(t + k - 3) * NPROJ + C_XBC + c]); }
        XC[i] = silu_f(a);
    }
}
__device__ __forceinline__ void stage_ssd_ref(const Params& p, int l, int blk, int nblk, int wv_) {
    unsigned char* ws = p.ws; const float* XC = (const float*)(ws + WS_XBCC); const float* DT = (const float*)(ws + WS_DT); float* YS = (float*)(ws + WS_YS);
    const int tid = otid();
    for (int u = blk; u < NB * 4; u += nblk) {
        const int b = u >> 2, h = u & 3, g = h >> 1, pp = tid >> 3, ns = (tid & 7) * 16;
        const float a = -__expf(p.a_log[l * 4 + h]), dtb = p.dt_bias[l * 4 + h], Dh = p.d_skip[l * 4 + h];
        float hst[16];
#pragma unroll
        for (int i = 0; i < 16; ++i) hst[i] = 0.f;
        for (int s = 0; s < SEQ; ++s) { const size_t t = (size_t)b * SEQ + s;
            const float dt = softplus_f(DT[t * 4 + h] + dtb), da = __expf(a * dt);
            const float xv = XC[t * 768 + h * 64 + pp], xd = xv * dt;
            const f32x4* Bp = (const f32x4*)(XC + t * 768 + 256 + g * 128 + ns); const f32x4* Cp = (const f32x4*)(XC + t * 768 + 512 + g * 128 + ns);
            float acc = 0.f;
#pragma unroll
            for (int i4 = 0; i4 < 4; ++i4) { const f32x4 bv = Bp[i4], cv = Cp[i4];
#pragma unroll
                for (int c = 0; c < 4; ++c) { float& hh = hst[4 * i4 + c]; hh = hh * da + xd * bv[c]; acc += cv[c] * hh; } }
            acc += __shfl_xor(acc, 1); acc += __shfl_xor(acc, 2); acc += __shfl_xor(acc, 4);
            if ((tid & 7) == 0) YS[t * 256 + h * 64 + pp] = acc + Dh * xv;
        }
    }
}
__device__ __forceinline__ void stage_gate_ref(const Params& p, int l, int blk, int nblk, int wv_) {
    const int tid = otid(), lane = tid & 63, wave = tid >> 6, gw = blk * NWAVES + wave, ngw = nblk * NWAVES;
    unsigned char* ws = p.ws; const bf16* P = (const bf16*)(ws + WS_P); const float* YS = (const float*)(ws + WS_YS); bf16* MIX = (bf16*)(ws + WS_MIX);
    const f32x4 nw = *(const f32x4*)(p.ssd_norm_w + l * 256 + 4 * lane);
    for (int t = gw; t < T; t += ngw) {
        f32x4 y = *(const f32x4*)(YS + (size_t)t * 256 + 4 * lane); const u32x2 zw = *(const u32x2*)(P + (size_t)t * NPROJ + C_Z + 4 * lane);
        y.x *= silu_f(bflo(zw.x)); y.y *= silu_f(bfhi(zw.x)); y.z *= silu_f(bflo(zw.y)); y.w *= silu_f(bfhi(zw.y));
        const float ms = wave_sum(y.x * y.x + y.y * y.y + y.z * y.z + y.w * y.w) * (1.f / 256.f); const float r = 1.f / sqrtf(ms + RMS_EPS);
        u32x2 o; o.x = pk2(y.x * r * nw.x, y.y * r * nw.y); o.y = pk2(y.z * r * nw.z, y.w * r * nw.w);
        *(u32x2*)(MIX + (size_t)t * DM + 512 + 4 * lane) = o;
    }
}
__device__ __forceinline__ void stage_out_ref(const Params& p, int l, int blk, int nblk, int wv_) {
    const int tid = otid(), lane = tid & 63, wave = tid >> 6, gw = blk * NWAVES + wave, ngw = nblk * NWAVES;
    unsigned char* ws = p.ws; const bf16* MIX = (const bf16*)(ws + WS_MIX); const bf16* WT = (const bf16*)(ws + WS_WT_OUT) + (size_t)l * DM * DM;
    const float* xin = l == 0 ? p.x : p.out; float* out = p.out;
    constexpr int NT = DM / 32, MT = T / 32;
    for (int tile = gw; tile < MT * NT; tile += ngw) { const int tm = tile / NT, tn = tile % NT; const int m = tm * 32 + (lane & 31);
        wave_gemm_tile(MIX + (size_t)m * DM, WT + (size_t)(tn * 32 + (lane & 31)) * DM, DM, lane, [&](int nn, float a, float b, float c, float d) {
            const size_t off = (size_t)m * DM + tn * 32 + nn; const f32x4 xv = *(const f32x4*)(xin + off);
            *(f32x4*)(out + off) = (f32x4){ALPHA * xv.x + a, ALPHA * xv.y + b, ALPHA * xv.z + c, ALPHA * xv.w + d}; }); }
}

__device__ __forceinline__ void ln_row(f32x4 (&v)[4], const float* g, const float* bta, int lane) {
    float s = 0.f;
#pragma unroll
    for (int j = 0; j < 4; ++j) s += (v[j].x + v[j].y) + (v[j].z + v[j].w);
    const float mean = wave_sum(s) * (1.f / DM); float s2 = 0.f;
#pragma unroll
    for (int j = 0; j < 4; ++j) { v[j] = v[j] - mean; s2 += (v[j].x * v[j].x + v[j].y * v[j].y) + (v[j].z * v[j].z + v[j].w * v[j].w); }
    const float rstd = 1.f / sqrtf(wave_sum(s2) * (1.f / DM) + LN_EPS);
#pragma unroll
    for (int j = 0; j < 4; ++j) { const f32x4 gg = *((const f32x4*)g + lane + 64 * j), bb = *((const f32x4*)bta + lane + 64 * j); v[j] = v[j] * rstd * gg + bb; }
}
__device__ __forceinline__ void stage_ln1_router(const Params& p, int l, int blk, int nblk, int wv_) {
    const int tid = otid(), lane = tid & 63, wave = tid >> 6, gw = blk * NWAVES + wave, ngw = nblk * NWAVES;
    unsigned char* ws = p.ws; bf16* XB = (bf16*)(ws + WS_XB); unsigned* cnt = (unsigned*)(ws + WS_CTL) + CW_CNT + l * 16;
    int* TOKE = (int*)(ws + WS_TOKE); int* TOKP = (int*)(ws + WS_TOKP); float* TOKW = (float*)(ws + WS_TOKW); int* LIST = (int*)(ws + WS_LIST);
    for (int t = gw; t < T; t += ngw) {
        asm volatile("" ::: "memory");
        f32x4 v[4]; f32x4* xr = (f32x4*)(p.out + (size_t)t * DM) + lane;
#pragma unroll
        for (int j = 0; j < 4; ++j) v[j] = xr[64 * j];
        ln_row(v, p.ln1_g + l * DM, p.ln1_b + l * DM, lane);
        float lg[16];
#pragma unroll
        for (int e = 0; e < 16; ++e) lg[e] = 0.f;
#pragma unroll
        for (int j = 0; j < 4; ++j) { xr[64 * j] = v[j]; u32x2 o; o.x = pk2(v[j].x, v[j].y); o.y = pk2(v[j].z, v[j].w); *((u32x2*)(XB + (size_t)t * DM) + lane + 64 * j) = o;
#pragma unroll
            for (int c = 0; c < 4; ++c) { const int k = 4 * lane + 256 * j + c; const float xv = v[j][c]; const f32x4* wr = (const f32x4*)(p.w_router + (size_t)k * 16);
#pragma unroll
                for (int q = 0; q < 4; ++q) { const f32x4 w = wr[q]; lg[4 * q] += xv * w.x; lg[4 * q + 1] += xv * w.y; lg[4 * q + 2] += xv * w.z; lg[4 * q + 3] += xv * w.w; } } }
        float mx = -INFINITY;
#pragma unroll
        for (int e = 0; e < 16; ++e) { lg[e] = wave_sum(lg[e]) + p.b_router[e]; mx = fmaxf(mx, lg[e]); }
        float sum = 0.f;
#pragma unroll
        for (int e = 0; e < 16; ++e) { lg[e] = __expf(lg[e] - mx); sum += lg[e]; }
        const float inv = 1.f / sum;
#pragma unroll
        for (int e = 0; e < 16; ++e) lg[e] *= inv;
        int best = 0; float bs = -1.f;
#pragma unroll
        for (int g = 0; g < 4; ++g) { const float a = lg[4 * g], b = lg[4 * g + 1], c = lg[4 * g + 2], d = lg[4 * g + 3];
            const float h1 = fmaxf(a, b), l1 = fminf(a, b), h2 = fmaxf(c, d), l2 = fminf(c, d); const float gs = fmaxf(h1, h2) + fmaxf(fminf(h1, h2), fmaxf(l1, l2));
            if (gs > bs) { bs = gs; best = g; } }
        const float c0 = best == 0 ? lg[0] : (best == 1 ? lg[4] : (best == 2 ? lg[8] : lg[12]));
        const float c1 = best == 0 ? lg[1] : (best == 1 ? lg[5] : (best == 2 ? lg[9] : lg[13]));
        const float c2 = best == 0 ? lg[2] : (best == 1 ? lg[6] : (best == 2 ? lg[10] : lg[14]));
        const float c3 = best == 0 ? lg[3] : (best == 1 ? lg[7] : (best == 2 ? lg[11] : lg[15]));
        int i1 = 0; float s1 = c0; if (c1 > s1) { s1 = c1; i1 = 1; } if (c2 > s1) { s1 = c2; i1 = 2; } if (c3 > s1) { s1 = c3; i1 = 3; }
        int i2 = -1; float s2 = -1.f;
        if (i1 != 0 && c0 > s2) { s2 = c0; i2 = 0; } if (i1 != 1 && c1 > s2) { s2 = c1; i2 = 1; } if (i1 != 2 && c2 > s2) { s2 = c2; i2 = 2; } if (i1 != 3 && c3 > s2) { s2 = c3; i2 = 3; }
        if (lane == 0) { const int e1 = best * 4 + i1, e2 = best * 4 + i2; const float ws_ = 1.f / (s1 + s2);
            const int p1 = (int)atomicAdd(cnt + e1, 1u), p2 = (int)atomicAdd(cnt + e2, 1u);
            LIST[e1 * T + p1] = t; LIST[e2 * T + p2] = t;
            TOKE[2 * t] = e1; TOKE[2 * t + 1] = e2; TOKP[2 * t] = p1; TOKP[2 * t + 1] = p2; TOKW[2 * t] = s1 * ws_; TOKW[2 * t + 1] = s2 * ws_; }
    }
}
__device__ __forceinline__ void stage_moe1_ref(const Params& p, int l, int blk, int nblk, int wv_) {
    const int tid = otid(), lane = tid & 63, wave = tid >> 6, gw = blk * NWAVES + wave, ngw = nblk * NWAVES;
    unsigned char* ws = p.ws; const bf16* XB = (const bf16*)(ws + WS_XB); const unsigned* cnt = (const unsigned*)(ws + WS_CTL) + CW_CNT + l * 16; const int* LIST = (const int*)(ws + WS_LIST);
    bf16* H = (bf16*)(ws + WS_H);
    int total = 0;
    for (int e = 0; e < NE; ++e) total += (int)((cnt[e] + 255u) >> 8) * 256;
    const int ntask = (total / 32) * 32;
    for (int task = gw; task < ntask; task += ngw) { const int rt = task >> 5, ct = task & 31; const int row0 = rt * 32;
        int e = 0, base = 0;
        for (int q = 0; q < NE; ++q) { const int sz = (int)((cnt[q] + 255u) >> 8) * 256; if (row0 >= base + sz) { base += sz; e = q + 1; } else break; }
        const int i = row0 + (lane & 31) - base; const int tok = i < (int)cnt[e] ? LIST[e * T + i] : 0;
        const bf16* WG = (const bf16*)(ws + WS_WT_GU) + (size_t)(l * 16 + e) * 2048 * DM; const int c0 = ct * 32, pn = c0 >> 7, j0 = c0 & 127;
        const int hi = lane >> 5;
        const bf16* ap = XB + (size_t)tok * DM + 8 * hi; const bf16* gp = WG + (size_t)(256 * pn + j0 + (lane & 31)) * DM + 8 * hi; const bf16* up = gp + (size_t)128 * DM;
        f32x16 ag = {}, au = {};
        for (int k0 = 0; k0 < DM; k0 += 16) { const bf16x8 a = *(const bf16x8*)(ap + k0); ag = __builtin_amdgcn_mfma_f32_32x32x16_bf16(*(const bf16x8*)(gp + k0), a, ag, 0, 0, 0); au = __builtin_amdgcn_mfma_f32_32x32x16_bf16(*(const bf16x8*)(up + k0), a, au, 0, 0, 0); }
        const int row = row0 + (lane & 31);
#pragma unroll
        for (int g = 0; g < 4; ++g) { u32x2 o; o.x = pk2(silu_f(ag[4 * g]) * au[4 * g], silu_f(ag[4 * g + 1]) * au[4 * g + 1]); o.y = pk2(silu_f(ag[4 * g + 2]) * au[4 * g + 2], silu_f(ag[4 * g + 3]) * au[4 * g + 3]);
            *(u32x2*)(H + (size_t)row * DM + c0 + 8 * g + 4 * hi) = o; }
    }
}
__device__ __forceinline__ void stage_moe2_ref(const Params& p, int l, int blk, int nblk, int wv_) {
    const int tid = otid(), lane = tid & 63, wave = tid >> 6, gw = blk * NWAVES + wave, ngw = nblk * NWAVES;
    unsigned char* ws = p.ws; const unsigned* cnt = (const unsigned*)(ws + WS_CTL) + CW_CNT + l * 16; const bf16* H = (const bf16*)(ws + WS_H); bf16* Y = (bf16*)(ws + WS_Y);
    int total = 0;
    for (int e = 0; e < NE; ++e) total += (int)((cnt[e] + 255u) >> 8) * 256;
    const int ntask = (total / 32) * 32;
    for (int task = gw; task < ntask; task += ngw) { const int rt = task >> 5, ct = task & 31; const int row0 = rt * 32;
        int e = 0, base = 0;
        for (int q = 0; q < NE; ++q) { const int sz = (int)((cnt[q] + 255u) >> 8) * 256; if (row0 >= base + sz) { base += sz; e = q + 1; } else break; }
        const bf16* WD = (const bf16*)(ws + WS_WT_DN) + (size_t)(l * 16 + e) * DM * DM; const int row = row0 + (lane & 31);
        wave_gemm_tile(H + (size_t)row * DM, WD + (size_t)(ct * 32 + (lane & 31)) * DM, DM, lane, [&](int nn, float a, float b, float c, float d) {
            u32x2 o; o.x = pk2(a, b); o.y = pk2(c, d); *(u32x2*)(Y + (size_t)row * DM + ct * 32 + nn) = o; });
    }
}
__device__ __forceinline__ void stage_ln2(const Params& p, int l, int blk, int nblk, int wv_) {
    const int tid = otid(), lane = tid & 63, wave = tid >> 6, gw = blk * NWAVES + wave, ngw = nblk * NWAVES;
    unsigned char* ws = p.ws; bf16* XB = (bf16*)(ws + WS_XB); const unsigned* cnt = (const unsigned*)(ws + WS_CTL) + CW_CNT + l * 16; const bf16* Y = (const bf16*)(ws + WS_Y);
    const int* TOKE = (const int*)(ws + WS_TOKE); const int* TOKP = (const int*)(ws + WS_TOKP); const float* TOKW = (const float*)(ws + WS_TOKW); float* DT = (float*)(ws + WS_DT);
    for (int t = gw; t < T; t += ngw) {
        asm volatile("" ::: "memory");
        const int e1 = TOKE[2 * t], e2 = TOKE[2 * t + 1]; int r1 = TOKP[2 * t], r2 = TOKP[2 * t + 1]; const float w1 = TOKW[2 * t], w2 = TOKW[2 * t + 1];
        for (int e = 0; e < NE; ++e) { const int sz = (int)((cnt[e] + 255u) >> 8) * 256; if (e < e1) r1 += sz; if (e < e2) r2 += sz; }
        f32x4 v[4]; f32x4* xr = (f32x4*)(p.out + (size_t)t * DM) + lane;
#pragma unroll
        for (int j = 0; j < 4; ++j) { const f32x4 xv = xr[64 * j]; const u32x2 a = *((const u32x2*)(Y + (size_t)r1 * DM) + lane + 64 * j), b = *((const u32x2*)(Y + (size_t)r2 * DM) + lane + 64 * j);
            v[j].x = ALPHA * xv.x + (w1 * bflo(a.x) + w2 * bflo(b.x)); v[j].y = ALPHA * xv.y + (w1 * bfhi(a.x) + w2 * bfhi(b.x));
            v[j].z = ALPHA * xv.z + (w1 * bflo(a.y) + w2 * bflo(b.y)); v[j].w = ALPHA * xv.w + (w1 * bfhi(a.y) + w2 * bfhi(b.y)); }
        ln_row(v, p.ln2_g + l * DM, p.ln2_b + l * DM, lane);
        float d0 = 0.f, d1 = 0.f, d2 = 0.f, d3 = 0.f;
#pragma unroll
        for (int j = 0; j < 4; ++j) { xr[64 * j] = v[j];
            if (l + 1 < DEPTH) { u32x2 o; o.x = pk2(v[j].x, v[j].y); o.y = pk2(v[j].z, v[j].w); *((u32x2*)(XB + (size_t)t * DM) + lane + 64 * j) = o;
#pragma unroll
                for (int c = 0; c < 4; ++c) { const int k = 4 * lane + 256 * j + c; const f32x4 w = *(const f32x4*)(p.w_in + ((size_t)(l + 1) * DM + k) * NCOLS_IN + 2560); const float xv = v[j][c];
                    d0 += xv * w.x; d1 += xv * w.y; d2 += xv * w.z; d3 += xv * w.w; } } }
        if (l + 1 < DEPTH) { d0 = wave_sum(d0); d1 = wave_sum(d1); d2 = wave_sum(d2); d3 = wave_sum(d3); if (lane == 0) *(f32x4*)(DT + (size_t)t * 4) = (f32x4){d0, d1, d2, d3}; }
    }
}


namespace pg8 {
constexpr int BM = 256, BK = 64, HALF = 128, HTB = HALF * BK * 2  , STAGE_BYTES = 8 * HTB;
__host__ __device__ __forceinline__ int lds_byte(int r, int c) { const int st = (r >> 4) * 2 + (c >> 5), rr = r & 15, cc = c & 31, ob = rr * 64 + cc * 2; return st * 1024 + (ob ^ (((ob >> 9) & 1) << 5)); }
__host__ __device__ __forceinline__ void stage_rc(int b, int& R, int& C) { const int st = b / 1024, sb = b % 1024, swz = sb ^ (((sb >> 9) & 1) << 5); R = (st >> 1) * 16 + swz / 64; C = (st & 1) * 32 + (swz % 64) / 2; }
__host__ __device__ __forceinline__ int perm32(int rho) { const int n = rho >> 4, i = rho & 15; return 8 * (i >> 2) + 4 * n + (i & 3); }
struct Unit { int pm, pn, cn; };
struct Gemm { const bf16* A; const bf16* Bt; int K; };

__device__ __forceinline__ unsigned cvt_pk_bf16(float lo, float hi) { unsigned r; asm volatile("v_cvt_pk_bf16_f32 %0, %1, %2" : "=v"(r) : "v"(lo), "v"(hi)); return r; }

struct EpiBf16 {
    static constexpr bool PERM = true;
    bf16* O; int ldc; int split_cols; size_t split_stride;
    __device__ __forceinline__ void operator()(const f32x4 (&acc)[2][2][4][2], const Unit& u, int wr, int wc, int fr, int fq) const {
        const int row0 = u.pm * BM + wr * 64 + fr; int colt = u.cn * BM; bf16* base = O;
        if (split_cols) { const int t = colt / split_cols; base += (size_t)t * split_stride; colt -= t * split_cols; }
        const int col0 = colt + wc * 32 + 8 * fq;
#pragma unroll
        for (int ai = 0; ai < 2; ++ai)
#pragma unroll
            for (int m = 0; m < 4; ++m) { bf16* rowp = base + (size_t)(row0 + ai * HALF + m * 16) * ldc + col0;
#pragma unroll
                for (int bj = 0; bj < 2; ++bj) { const f32x4 v0 = acc[ai][bj][m][0], v1 = acc[ai][bj][m][1];
                    u32x4 w; w.x = cvt_pk_bf16(v0[0], v0[1]); w.y = cvt_pk_bf16(v0[2], v0[3]); w.z = cvt_pk_bf16(v1[0], v1[1]); w.w = cvt_pk_bf16(v1[2], v1[3]);
                    *(u32x4*)(rowp + bj * HALF) = w; } }
    }
};
struct EpiSwiGLU {
    static constexpr bool PERM = true;
    bf16* O; int ldc;
    __device__ __forceinline__ void operator()(const f32x4 (&acc)[2][2][4][2], const Unit& u, int wr, int wc, int fr, int fq) const {
        const int row0 = u.pm * BM + wr * 64 + fr; const int col0 = u.cn * HALF + wc * 32 + 8 * fq;
#pragma unroll
        for (int ai = 0; ai < 2; ++ai)
#pragma unroll
            for (int m = 0; m < 4; ++m) { float h[8];
#pragma unroll
                for (int n = 0; n < 2; ++n)
#pragma unroll
                    for (int c = 0; c < 4; ++c) { const float g = acc[ai][0][m][n][c], uu = acc[ai][1][m][n][c]; h[4 * n + c] = g * __builtin_amdgcn_rcpf(1.f + __expf(-g)) * uu; }
                u32x4 w; w.x = cvt_pk_bf16(h[0], h[1]); w.y = cvt_pk_bf16(h[2], h[3]); w.z = cvt_pk_bf16(h[4], h[5]); w.w = cvt_pk_bf16(h[6], h[7]);
                *(u32x4*)(O + (size_t)(row0 + ai * HALF + m * 16) * ldc + col0) = w; }
    }
};
struct EpiResF32 {
    static constexpr bool PERM = false;
    const float* base; float* out; int ldc; float alpha;
    __device__ __forceinline__ void operator()(const f32x4 (&acc)[2][2][4][2], const Unit& u, int wr, int wc, int fr, int fq) const {
        const int row0 = u.pm * BM + wr * 64 + fr; const int col0 = u.cn * BM + wc * 32 + 4 * fq;
#pragma unroll
        for (int ai = 0; ai < 2; ++ai)
#pragma unroll
            for (int m = 0; m < 4; ++m) { const size_t off = (size_t)(row0 + ai * HALF + m * 16) * ldc + col0;
#pragma unroll
                for (int bj = 0; bj < 2; ++bj)
#pragma unroll
                    for (int n = 0; n < 2; ++n) { const f32x4 bs = *(const f32x4*)(base + off + bj * HALF + n * 16); *(f32x4*)(out + off + bj * HALF + n * 16) = bs * alpha + acc[ai][bj][m][n]; } }
    }
};

template <class Epi, class Sched, bool GATHER>
__device__ __forceinline__ void gemm_phase(LAS unsigned char* lds, const Gemm g, const Sched& S, const Epi& E, const LAS int* gtab, int wv_) {
    const int tid = otid(), wid = __builtin_amdgcn_readfirstlane(tid >> 6), lane = tid & 63, wr = wid >> 2, wc = wid & 3, fr = lane & 15, fq = lane >> 4;
    const int K = g.K, nt = K / BK;
    unsigned voffA[2], voffB[2]; int RA[2], CA[2];
#pragma unroll
    for (int i = 0; i < 2; ++i) { int R, C; stage_rc(tid * 16 + i * 8192, R, C); const int Rb = Epi::PERM ? ((R & ~31) + perm32(R & 31)) : R; RA[i] = R; CA[i] = C;
        voffA[i] = (unsigned)(R * K + C) * 2u; voffB[i] = (unsigned)(Rb * K + C) * 2u; }
    const size_t kstep = (size_t)(BK * 2);
    const size_t hstep = (size_t)HALF * K * 2;
    const size_t tstep = 2 * hstep;
    const unsigned ldsw = (unsigned)wid * 1024u;
    const int aoff = lds_byte(wr * 64 + fr, fq * 8), boff = lds_byte(wc * 32 + fr, fq * 8);
#define PG8_SA(b, h) (((b) * 2 + (h)) * HTB)
#define PG8_SB(b, h) ((4 + (b) * 2 + (h)) * HTB)
#define PG8_STAGE(bufoff, gbase, voff) do { _Pragma("unroll") for (int _i = 0; _i < 2; ++_i) \
        __builtin_amdgcn_global_load_lds((const unsigned*)((const char*)(gbase) + (voff)[_i]), (LAS unsigned*)(lds + (bufoff) + ldsw + _i * 8192), 16, 0, 0); } while (0)
#define PG8_STAGE_A(bufoff, pbase, gbase, h, vo) do { if constexpr (GATHER) { PG8_STAGE(bufoff, gbase, (vo)[h]); } else { PG8_STAGE(bufoff, (pbase) + (h) * hstep, voffA); } } while (0)
#define PG8_LDA(dst, b, h) do { _Pragma("unroll") for (int m = 0; m < 4; ++m) _Pragma("unroll") for (int k = 0; k < 2; ++k) dst[m][k] = *(const LAS bf16x8*)(lds + PG8_SA(b, h) + aoff + m * 2048 + k * 1024); } while (0)
#define PG8_LDB(dst, b, h) do { _Pragma("unroll") for (int n = 0; n < 2; ++n) _Pragma("unroll") for (int k = 0; k < 2; ++k) dst[n][k] = *(const LAS bf16x8*)(lds + PG8_SB(b, h) + boff + n * 2048 + k * 1024); } while (0)
#define PG8_MMA(ai, bj, At, Bt) do { __builtin_amdgcn_s_setprio(1); _Pragma("unroll") for (int m = 0; m < 4; ++m) _Pragma("unroll") for (int n = 0; n < 2; ++n) _Pragma("unroll") for (int k = 0; k < 2; ++k) \
        acc[ai][bj][m][n] = __builtin_amdgcn_mfma_f32_16x16x32_bf16(Bt[n][k], At[m][k], acc[ai][bj][m][n], 0, 0, 0); __builtin_amdgcn_s_setprio(0); } while (0)
#define PG8_WAIT_V(n) asm volatile("s_waitcnt vmcnt(" #n ")" ::: "memory")
#define PG8_WAIT_L(n) asm volatile("s_waitcnt lgkmcnt(" #n ")" ::: "memory")
#define PG8_BAR __builtin_amdgcn_s_barrier()
#define PG8_SCHED __builtin_amdgcn_sched_barrier(0)
#define PG8_GVO(dst, ui_) do { _Pragma("unroll") for (int _h = 0; _h < 2; ++_h) _Pragma("unroll") for (int _i = 0; _i < 2; ++_i) \
        dst[_h][_i] = (unsigned)gtab[(ui_) * 256 + _h * HALF + RA[_i]] * (unsigned)(K * 2) + (unsigned)(CA[_i] * 2); } while (0)
    Unit cur, nxt; int ui = 0;
    if (!S.next(0, cur)) return;
    f32x4 acc[2][2][4][2];
#pragma unroll
    for (int a = 0; a < 2; ++a)
#pragma unroll
        for (int b = 0; b < 2; ++b)
#pragma unroll
            for (int m = 0; m < 4; ++m)
#pragma unroll
                for (int n = 0; n < 2; ++n) acc[a][b][m][n] = (f32x4){0.f, 0.f, 0.f, 0.f};
    bf16x8 At[4][2], B0[2][2], B1[2][2];
    unsigned voC[2][2], voN[2][2];
    if constexpr (GATHER) { PG8_GVO(voC, 0); PG8_WAIT_L(0); }
    const char* gA = (const char*)g.A;
    const char* cA = GATHER ? gA : gA + (size_t)cur.pm * tstep; const char* cB = (const char*)g.Bt + (size_t)cur.pn * tstep;
    PG8_STAGE(PG8_SB(0, 0), cB, voffB); PG8_STAGE(PG8_SB(0, 1), cB + hstep, voffB); PG8_STAGE_A(PG8_SA(0, 0), cA, cA, 0, voC); PG8_STAGE_A(PG8_SA(0, 1), cA, cA, 1, voC);
    if (wr == 1) PG8_BAR;
    PG8_WAIT_V(2); PG8_BAR;
    PG8_STAGE(PG8_SB(1, 0), cB + kstep, voffB); PG8_STAGE_A(PG8_SA(1, 0), cA + kstep, cA + kstep, 0, voC); PG8_STAGE(PG8_SB(1, 1), cB + hstep + kstep, voffB);
    PG8_WAIT_V(6); PG8_BAR;
    for (;;) {
        const bool has_next = S.next(ui + 1, nxt);
        const char* nA = (has_next && !GATHER) ? gA + (size_t)nxt.pm * tstep : cA; const char* nB = has_next ? (const char*)g.Bt + (size_t)nxt.pn * tstep : cB;
        if constexpr (GATHER) { if (has_next) { PG8_GVO(voN, ui + 1); } else {
#pragma unroll
            for (int _h = 0; _h < 2; ++_h)
#pragma unroll
                for (int _i = 0; _i < 2; ++_i) voN[_h][_i] = voC[_h][_i]; } }
        for (int t = 0; t < nt; t += 2) {
            const bool last = (t == nt - 2);
            const char* a1 = cA + (size_t)(t + 1) * kstep;
            const char* a2 = last ? nA : cA + (size_t)(t + 2) * kstep; const char* b2 = last ? nB : cB + (size_t)(t + 2) * kstep;
            const char* a3 = a2 + kstep; const char* b3 = b2 + kstep;
            unsigned vs[2][2];
            if constexpr (GATHER) {
#pragma unroll
                for (int _h = 0; _h < 2; ++_h)
#pragma unroll
                    for (int _i = 0; _i < 2; ++_i) vs[_h][_i] = last ? voN[_h][_i] : voC[_h][_i]; }
            PG8_LDB(B0, 0, 0); PG8_LDB(B1, 0, 1); PG8_SCHED; PG8_LDA(At, 0, 0); PG8_STAGE_A(PG8_SA(1, 1), a1, a1, 1, voC);
            PG8_WAIT_V(8); PG8_WAIT_L(0); PG8_BAR; PG8_MMA(0, 0, At, B0); PG8_MMA(0, 1, At, B1); PG8_BAR; PG8_SCHED;
            PG8_LDA(At, 0, 1); PG8_STAGE(PG8_SB(0, 0), b2, voffB); PG8_STAGE(PG8_SB(0, 1), b2 + hstep, voffB); PG8_STAGE_A(PG8_SA(0, 0), a2, a2, 0, vs);
            PG8_WAIT_V(8); PG8_WAIT_L(0); PG8_BAR; PG8_MMA(1, 0, At, B0); PG8_MMA(1, 1, At, B1); PG8_BAR; PG8_SCHED;
            PG8_LDB(B0, 1, 0); PG8_LDB(B1, 1, 1); PG8_SCHED; PG8_LDA(At, 1, 0); PG8_STAGE_A(PG8_SA(0, 1), a2, a2, 1, vs);
            PG8_WAIT_V(8); PG8_WAIT_L(0); PG8_BAR; PG8_MMA(0, 0, At, B0); PG8_MMA(0, 1, At, B1); PG8_BAR; PG8_SCHED;
            PG8_LDA(At, 1, 1); PG8_STAGE(PG8_SB(1, 0), b3, voffB); PG8_STAGE(PG8_SB(1, 1), b3 + hstep, voffB); PG8_STAGE_A(PG8_SA(1, 0), a3, a3, 0, vs);
            PG8_WAIT_V(8); PG8_WAIT_L(0); PG8_BAR; PG8_MMA(1, 0, At, B0); PG8_MMA(1, 1, At, B1); PG8_BAR; PG8_SCHED;
        }
        if (wr == 0) PG8_BAR;
        E(acc, cur, wr, wc, fr, fq);
        if (!has_next) break;
#pragma unroll
        for (int a = 0; a < 2; ++a)
#pragma unroll
            for (int b = 0; b < 2; ++b)
#pragma unroll
                for (int m = 0; m < 4; ++m)
#pragma unroll
                    for (int n = 0; n < 2; ++n) acc[a][b][m][n] = (f32x4){0.f, 0.f, 0.f, 0.f};
        cur = nxt; cA = nA; cB = nB; ++ui;
        if constexpr (GATHER) {
#pragma unroll
            for (int _h = 0; _h < 2; ++_h)
#pragma unroll
                for (int _i = 0; _i < 2; ++_i) voC[_h][_i] = voN[_h][_i]; }
        if (wr == 1) PG8_BAR;
    }
    PG8_WAIT_V(0);
    PG8_BAR;
#undef PG8_SA
#undef PG8_SB
#undef PG8_STAGE
#undef PG8_STAGE_A
#undef PG8_LDA
#undef PG8_LDB
#undef PG8_MMA
#undef PG8_WAIT_V
#undef PG8_WAIT_L
#undef PG8_BAR
#undef PG8_SCHED
#undef PG8_GVO
}
struct GridOrder {
    int nMx, nN, x, j, W;
    __device__ __forceinline__ void init(int nM, int nN_, int G, int c) { nMx = nM / 8; nN = nN_; x = c & 7; j = c >> 3; W = (G - x + 7) >> 3; }
    __device__ __forceinline__ bool next(int i, Unit& u) const { const int L = i * W + j; if (L >= nMx * nN) return false; u.pm = x * nMx + L % nMx; u.pn = L / nMx; u.cn = u.pn; return true; }
};
struct ListOrder {
    int first, n, nN;
    __device__ __forceinline__ bool next(int i, Unit& u) const { if (i > 0 || first < 0 || first >= n) return false; u.pm = first / nN; u.pn = first % nN; u.cn = u.pn; return true; }
};
struct MoeOrder {
    int pe[16]; int nC, t0, t1, j, W;
    __device__ __forceinline__ void init(const unsigned* cnt, int nC_, int G, int c) { int a = 0;
#pragma unroll
        for (int e = 0; e < 16; ++e) { a += (int)((__builtin_amdgcn_readfirstlane(cnt[e]) + 255u) >> 8); pe[e] = a; }
        const int x = c & 7; nC = nC_; j = c >> 3; W = (G - x + 7) >> 3; t0 = (x * a) >> 3; t1 = ((x + 1) * a) >> 3; }
    __device__ __forceinline__ void expert_of(int rt, int& e, int& start) const { e = 0; start = 0;
#pragma unroll
        for (int q = 0; q < 16; ++q) if (rt >= pe[q]) { e = q + 1; start = pe[q]; } }
    __device__ __forceinline__ bool next(int i, Unit& u) const { const int L = i * W + j; const int rt = t0 + L / nC, cl = L % nC; if (rt >= t1) return false;
        int e, st; expert_of(rt, e, st); u.pm = rt; u.pn = e * nC + cl; u.cn = cl; return true; }
};
}

constexpr int GTAB_OFF = 131072 + 1024;
__device__ __forceinline__ void stage_proj(const Params& p, LAS unsigned char* lds, int l, int blk, int nblk, int wv_) {
    unsigned char* ws = p.ws;
    { pg8::Gemm g{(const bf16*)(ws + WS_XB), (const bf16*)(ws + WS_WT_IN) + (size_t)l * NPROJ * DM, DM}; pg8::GridOrder S; S.init(T / 256, NPROJ / 256, nblk, blk);
      pg8::EpiBf16 E{(bf16*)(ws + WS_P), NPROJ, 0, 0};
      pg8::gemm_phase<pg8::EpiBf16, pg8::GridOrder, false>(lds, g, S, E, nullptr, wv_); }
    if (l == 0) {
        pg8::Gemm g{(const bf16*)(ws + WS_MEMB), (const bf16*)(ws + WS_WT_KV), DM}; pg8::ListOrder S{nblk >= 208 ? blk - 192 : blk, 16, 4};
        pg8::EpiBf16 E{(bf16*)(ws + WS_KV), 512, 512, (size_t)1024 * 512};
        pg8::gemm_phase<pg8::EpiBf16, pg8::ListOrder, false>(lds, g, S, E, nullptr, wv_); }
}
__device__ __forceinline__ void stage_out(const Params& p, LAS unsigned char* lds, int l, int blk, int nblk, int wv_) {
    unsigned char* ws = p.ws;
    pg8::Gemm g{(const bf16*)(ws + WS_MIX), (const bf16*)(ws + WS_WT_OUT) + (size_t)l * DM * DM, DM}; pg8::GridOrder S; S.init(T / 256, DM / 256, nblk, blk);
    pg8::EpiResF32 E{l == 0 ? p.x : p.out, p.out, DM, ALPHA};
    pg8::gemm_phase<pg8::EpiResF32, pg8::GridOrder, false>(lds, g, S, E, nullptr, wv_);
}
__device__ __forceinline__ void stage_moe1(const Params& p, LAS unsigned char* lds, int l, int blk, int nblk, int wv_) {
    unsigned char* ws = p.ws; const unsigned* cnt = (const unsigned*)(ws + WS_CTL) + CW_CNT + l * 16; const int* LIST = (const int*)(ws + WS_LIST);
    pg8::MoeOrder S; S.init(cnt, 8, nblk, blk);
    LAS int* gtab = (LAS int*)(lds + GTAB_OFF);
    { pg8::Unit u; const int tid = otid();
      for (int i = 0; i < 12 && S.next(i, u); ++i) if (tid < 256) { int e, st; S.expert_of(u.pm, e, st); const int pos = (u.pm - st) * 256 + tid; gtab[i * 256 + tid] = pos < (int)cnt[e] ? LIST[e * T + pos] : 0; }
      __syncthreads(); }
    pg8::Gemm g{(const bf16*)(ws + WS_XB), (const bf16*)(ws + WS_WT_GU) + (size_t)l * 16 * 2048 * DM, DM};
    pg8::EpiSwiGLU E{(bf16*)(ws + WS_H), DM};
    pg8::gemm_phase<pg8::EpiSwiGLU, pg8::MoeOrder, true>(lds, g, S, E, gtab, wv_);
}
__device__ __forceinline__ void stage_moe2(const Params& p, LAS unsigned char* lds, int l, int blk, int nblk, int wv_) {
    unsigned char* ws = p.ws; const unsigned* cnt = (const unsigned*)(ws + WS_CTL) + CW_CNT + l * 16;
    pg8::MoeOrder S; S.init(cnt, 4, nblk, blk);
    pg8::Gemm g{(const bf16*)(ws + WS_H), (const bf16*)(ws + WS_WT_DN) + (size_t)l * 16 * DM * DM, DM};
    pg8::EpiBf16 E{(bf16*)(ws + WS_Y), DM, 0, 0};
    pg8::gemm_phase<pg8::EpiBf16, pg8::MoeOrder, false>(lds, g, S, E, nullptr, wv_);
}

constexpr int SSD_PITCH = 272, SSD_TILE = 128 * SSD_PITCH;
constexpr int SSD_TX = 0, SSD_TB = SSD_TILE, SSD_TC = 2 * SSD_TILE, SSD_TW = 3 * SSD_TILE, SSD_TAB = 4 * SSD_TILE;
constexpr size_t WS_ATOT = WS_DT + 512 * 1024;
typedef short s16x4 __attribute__((ext_vector_type(4)));
template <int PITCH = SSD_PITCH> __device__ __forceinline__ s16x4 tr_read4(const LAS unsigned char* tile, int row0, int col0, int lane) {
    const int i = lane & 15, cb = ((lane >> 4) & 1) * 16;
    const LAS unsigned char* a = tile + (row0 + (i >> 2)) * PITCH + (col0 + cb + 4 * (i & 3)) * 2;
    return __builtin_bit_cast(s16x4, __builtin_amdgcn_ds_read_tr16_b64_v4i16((LAS s16x4*)a));
}
__device__ __forceinline__ bf16x8 cat8(s16x4 a, s16x4 b) { return (bf16x8){a[0], a[1], a[2], a[3], b[0], b[1], b[2], b[3]}; }
__device__ __forceinline__ bf16x8 tr_frag_nat(const LAS unsigned char* tile, int r0, int col0, int lane) { const int hi = lane >> 5; return cat8(tr_read4(tile, r0 + 8 * hi, col0, lane), tr_read4(tile, r0 + 8 * hi + 4, col0, lane)); }
template <int PITCH = SSD_PITCH> __device__ __forceinline__ bf16x8 tr_frag_acc(const LAS unsigned char* tile, int r0, int col0, int lane) { const int hi = lane >> 5; return cat8(tr_read4<PITCH>(tile, r0 + 4 * hi, col0, lane), tr_read4<PITCH>(tile, r0 + 4 * hi + 8, col0, lane)); }
__device__ __forceinline__ bf16x8 row_frag(const LAS unsigned char* tile, int r0, int k0, int lane) { return *(const LAS bf16x8*)(tile + (r0 + (lane & 31)) * SSD_PITCH + (k0 + 8 * (lane >> 5)) * 2); }

__device__ __forceinline__ void ssd_stage_conv(const bf16* P, int t0, int s0, int pcol0, const float* cw, const float* cb, int cc0, LAS unsigned char* tile, int tid) {
    const int ch = tid & 15, rg = tid >> 4;
    float w[4][8], bias[8];
#pragma unroll
    for (int k = 0; k < 4; ++k) { const f32x4 a = *(const f32x4*)(cw + k * 768 + cc0 + ch * 8), b = *(const f32x4*)(cw + k * 768 + cc0 + ch * 8 + 4);
        w[k][0] = a.x; w[k][1] = a.y; w[k][2] = a.z; w[k][3] = a.w; w[k][4] = b.x; w[k][5] = b.y; w[k][6] = b.z; w[k][7] = b.w; }
    { const f32x4 a = *(const f32x4*)(cb + cc0 + ch * 8), b = *(const f32x4*)(cb + cc0 + ch * 8 + 4); bias[0] = a.x; bias[1] = a.y; bias[2] = a.z; bias[3] = a.w; bias[4] = b.x; bias[5] = b.y; bias[6] = b.z; bias[7] = b.w; }
    u32x4 in[7];
#pragma unroll
    for (int r = 0; r < 7; ++r) { const int row = 4 * rg - 3 + r; in[r] = (u32x4){0u, 0u, 0u, 0u}; if (s0 + row >= 0) in[r] = *(const u32x4*)(P + (size_t)(t0 + row) * NPROJ + pcol0 + ch * 8); }
#pragma unroll
    for (int j = 0; j < 4; ++j) { float o[8];
#pragma unroll
        for (int i = 0; i < 8; ++i) o[i] = bias[i];
#pragma unroll
        for (int k = 0; k < 4; ++k)
#pragma unroll
            for (int i2 = 0; i2 < 4; ++i2) { const unsigned wd = in[j + k][i2]; o[2 * i2] += w[k][2 * i2] * bflo(wd); o[2 * i2 + 1] += w[k][2 * i2 + 1] * bfhi(wd); }
        u32x4 ov;
#pragma unroll
        for (int i2 = 0; i2 < 4; ++i2) ov[i2] = pk2(silu_f(o[2 * i2]), silu_f(o[2 * i2 + 1]));
        *(LAS u32x4*)(tile + (4 * rg + j) * SSD_PITCH + ch * 16) = ov; }
}
__device__ __forceinline__ void ssd_tables(const Params& p, int l, int t0, int h0, int nh, LAS float* dtv, LAS float* acs, int tid) {
    const int hh = tid >> 7, row = tid & 127;
    if (hh < nh) { const int h = h0 + hh; const float a = -__expf(p.a_log[l * 4 + h]); const float dt = softplus_f(((const float*)(p.ws + WS_DT))[(size_t)(t0 + row) * 4 + h] + p.dt_bias[l * 4 + h]);
        dtv[hh * 128 + row] = dt; acs[hh * 128 + row] = a * dt; }
    __syncthreads();
    float cs = 0.f;
    if (hh < nh) for (int k = 0; k <= row; ++k) cs += acs[hh * 128 + k];
    __syncthreads();
    if (hh < nh) acs[hh * 128 + row] = cs;
    __syncthreads();
}
__device__ __forceinline__ void stage_ssd1(const Params& p, LAS unsigned char* lds, int l, int blk, int nblk, int wv_) {
    const int tid = otid(), lane = tid & 63, wave = __builtin_amdgcn_readfirstlane(tid >> 6);
    unsigned char* ws = p.ws; const bf16* P = (const bf16*)(ws + WS_P); float* SST = (float*)(ws + WS_SST); float* ATOT = (float*)(ws + WS_ATOT);
    const float* cw = p.conv_w + (size_t)l * 4 * 768; const float* cb = p.conv_b + (size_t)l * 768;
    LAS float* dtv = (LAS float*)(lds + SSD_TAB); LAS float* acs = dtv + 512;
    for (int u = blk; u < NB * 32 * 2; u += nblk) {
        const int g = u & 1, c = (u >> 1) & 31, b = u >> 6, t0 = b * SEQ + c * 128, s0 = c * 128;
        ssd_tables(p, l, t0, 2 * g, 2, dtv, acs, tid);
        if (tid < 2) ATOT[(b * 32 + c) * 4 + 2 * g + tid] = acs[tid * 128 + 127];
        ssd_stage_conv(P, t0, s0, C_XBC + g * 128, cw, cb, g * 128, lds + SSD_TX, tid);
        ssd_stage_conv(P, t0, s0, C_XBC + 256 + g * 128, cw, cb, 256 + g * 128, lds + SSD_TB, tid);
        __syncthreads();
        { const int row = tid >> 2, cq = tid & 3, hh = cq >> 1; const float sc = dtv[hh * 128 + row] * __expf(acs[hh * 128 + 127] - acs[hh * 128 + row]);
#pragma unroll
            for (int i = 0; i < 4; ++i) { const u32x4 v = *(const LAS u32x4*)(lds + SSD_TX + row * SSD_PITCH + cq * 64 + i * 16); u32x4 o;
#pragma unroll
                for (int q = 0; q < 4; ++q) o[q] = pk2(bflo(v[q]) * sc, bfhi(v[q]) * sc);
                *(LAS u32x4*)(lds + SSD_TW + row * SSD_PITCH + cq * 64 + i * 16) = o; } }
        __syncthreads();
        { const int hh = wave >> 2, nt = wave & 3, hi = lane >> 5; f32x16 acc0 = {}, acc1 = {};
#pragma unroll
            for (int ks = 0; ks < 8; ++ks) { const bf16x8 bfr = tr_frag_nat(lds + SSD_TB, 16 * ks, nt * 32, lane);
                const bf16x8 a0 = tr_frag_nat(lds + SSD_TW, 16 * ks, hh * 64, lane), a1 = tr_frag_nat(lds + SSD_TW, 16 * ks, hh * 64 + 32, lane);
                acc0 = __builtin_amdgcn_mfma_f32_32x32x16_bf16(a0, bfr, acc0, 0, 0, 0); acc1 = __builtin_amdgcn_mfma_f32_32x32x16_bf16(a1, bfr, acc1, 0, 0, 0); }
            float* So = SST + ((size_t)((b * 32 + c) * 4 + 2 * g + hh)) * 8192 + nt * 32 + (lane & 31);
#pragma unroll
            for (int r = 0; r < 16; ++r) { So[(size_t)crow(r, hi) * 128] = acc0[r]; So[(size_t)(32 + crow(r, hi)) * 128] = acc1[r]; } }
        __syncthreads();
    }
}
__device__ __forceinline__ void stage_ssd_scan(const Params& p, int blk, int nblk, int wv_) {
    unsigned char* ws = p.ws; float* SST = (float*)(ws + WS_SST); const float* ATOT = (const float*)(ws + WS_ATOT);
    for (int e = blk * NTHREADS + otid(); e < NB * 4 * 8192; e += nblk * NTHREADS) { const int el = e & 8191, h = (e >> 13) & 3, b = e >> 15;
        float run = 0.f;
        for (int c = 0; c < 32; ++c) { float* q = SST + ((size_t)((b * 32 + c) * 4 + h)) * 8192 + el; const float sv = *q; *q = run; run = run * __expf(ATOT[(b * 32 + c) * 4 + h]) + sv; } }
}
__device__ __forceinline__ void stage_ssd3(const Params& p, LAS unsigned char* lds, int l, int blk, int nblk, int wv_) {
    const int tid = otid(), lane = tid & 63, wave = __builtin_amdgcn_readfirstlane(tid >> 6), hi = lane >> 5, l31 = lane & 31;
    unsigned char* ws = p.ws; const bf16* P = (const bf16*)(ws + WS_P); const float* SST = (const float*)(ws + WS_SST); bf16* MIX = (bf16*)(ws + WS_MIX); float* YS = (float*)(ws + WS_YS);
    const float* cw = p.conv_w + (size_t)l * 4 * 768; const float* cb = p.conv_b + (size_t)l * 768;
    LAS float* dtv = (LAS float*)(lds + SSD_TAB); LAS float* acs = dtv + 512; LAS float* ssq = dtv + 1024;
    for (int u = blk; u < NB * 32; u += nblk) {
        const int c = u & 31, b = u >> 5, t0 = b * SEQ + c * 128, s0 = c * 128;
        ssd_tables(p, l, t0, 0, 4, dtv, acs, tid);
        const int hh = wave >> 2, j = wave & 3, lrow = 32 * j + l31;
        float ssq0 = 0.f, ssq1 = 0.f;
#pragma unroll 1
        for (int g = 0; g < 2; ++g) {
            ssd_stage_conv(P, t0, s0, C_XBC + g * 128, cw, cb, g * 128, lds + SSD_TX, tid);
            ssd_stage_conv(P, t0, s0, C_XBC + 256 + g * 128, cw, cb, 256 + g * 128, lds + SSD_TB, tid);
            ssd_stage_conv(P, t0, s0, C_XBC + 512 + g * 128, cw, cb, 512 + g * 128, lds + SSD_TC, tid);
            { const int row = tid >> 2, cq = tid & 3; const float* src = SST + ((size_t)((b * 32 + c) * 4 + 2 * g + (row >> 6))) * 8192 + (row & 63) * 128 + cq * 32;
#pragma unroll
                for (int i = 0; i < 4; ++i) { const f32x4 a = *(const f32x4*)(src + 8 * i), bq = *(const f32x4*)(src + 8 * i + 4); u32x4 o; o.x = pk2(a.x, a.y); o.y = pk2(a.z, a.w); o.z = pk2(bq.x, bq.y); o.w = pk2(bq.z, bq.w);
                    *(LAS u32x4*)(lds + SSD_TW + row * SSD_PITCH + cq * 64 + i * 16) = o; } }
            __syncthreads();
            const int h = 2 * g + hh; const LAS float* acsh = acs + h * 128; const LAS float* dth = dtv + h * 128; const float acs_l = acsh[lrow];
            f32x16 yd0 = {}, yd1 = {};
            for (int a = 0; a <= j; ++a) {
                f32x16 G = {};
#pragma unroll
                for (int ks = 0; ks < 8; ++ks) G = __builtin_amdgcn_mfma_f32_32x32x16_bf16(row_frag(lds + SSD_TB, 32 * a, 16 * ks, lane), row_frag(lds + SSD_TC, 32 * j, 16 * ks, lane), G, 0, 0, 0);
                unsigned mw[8];
#pragma unroll
                for (int r2 = 0; r2 < 8; ++r2) { float v2[2];
#pragma unroll
                    for (int q = 0; q < 2; ++q) { const int r = 2 * r2 + q, srow = 32 * a + crow(r, hi); float v = G[r] * __expf(acs_l - acsh[srow]) * dth[srow]; if (srow > lrow) v = 0.f; v2[q] = v; }
                    mw[r2] = pk2(v2[0], v2[1]); }
#pragma unroll
                for (int ks = 0; ks < 2; ++ks) { const bf16x8 mb = __builtin_bit_cast(bf16x8, (u32x4){mw[4 * ks], mw[4 * ks + 1], mw[4 * ks + 2], mw[4 * ks + 3]});
                    yd0 = __builtin_amdgcn_mfma_f32_32x32x16_bf16(tr_frag_acc(lds + SSD_TX, 32 * a + 16 * ks, hh * 64, lane), mb, yd0, 0, 0, 0);
                    yd1 = __builtin_amdgcn_mfma_f32_32x32x16_bf16(tr_frag_acc(lds + SSD_TX, 32 * a + 16 * ks, hh * 64 + 32, lane), mb, yd1, 0, 0, 0); }
            }
            f32x16 yo0 = {}, yo1 = {};
#pragma unroll
            for (int ks = 0; ks < 8; ++ks) { const bf16x8 cf = row_frag(lds + SSD_TC, 32 * j, 16 * ks, lane);
                yo0 = __builtin_amdgcn_mfma_f32_32x32x16_bf16(row_frag(lds + SSD_TW, hh * 64, 16 * ks, lane), cf, yo0, 0, 0, 0);
                yo1 = __builtin_amdgcn_mfma_f32_32x32x16_bf16(row_frag(lds + SSD_TW, hh * 64 + 32, 16 * ks, lane), cf, yo1, 0, 0, 0); }
            const float eo = __expf(acs_l), Dh = p.d_skip[l * 4 + h];
#pragma unroll
            for (int pt = 0; pt < 2; ++pt)
#pragma unroll
                for (int rg = 0; rg < 4; ++rg) { const int pc = pt * 32 + 8 * rg + 4 * hi;
                    const u32x2 xw = *(const LAS u32x2*)(lds + SSD_TX + lrow * SSD_PITCH + (hh * 64 + pc) * 2);
                    const u32x2 zw = *(const u32x2*)(P + (size_t)(t0 + lrow) * NPROJ + C_Z + h * 64 + pc);
                    const float xs[4] = {bflo(xw.x), bfhi(xw.x), bflo(xw.y), bfhi(xw.y)}, zs[4] = {bflo(zw.x), bfhi(zw.x), bflo(zw.y), bfhi(zw.y)};
                    f32x4 yo4;
#pragma unroll
                    for (int q = 0; q < 4; ++q) { const int r = 4 * rg + q; const float yy = ((pt ? yd1[r] : yd0[r]) + (pt ? yo1[r] : yo0[r]) * eo + Dh * xs[q]) * silu_f(zs[q]); yo4[q] = yy; if (g == 0) ssq0 += yy * yy; else ssq1 += yy * yy; }
                    *(f32x4*)(YS + (size_t)(t0 + lrow) * 256 + h * 64 + pc) = yo4; }
            __syncthreads();
        }
        {
            ssq0 += __shfl_xor(ssq0, 32); ssq1 += __shfl_xor(ssq1, 32);
            if (hi == 0) { ssq[hh * 128 + lrow] = ssq0; ssq[(2 + hh) * 128 + lrow] = ssq1; }
            __syncthreads();
            const float tot = ssq[lrow] + ssq[128 + lrow] + ssq[256 + lrow] + ssq[384 + lrow];
            const float rn = 1.f / sqrtf(tot * (1.f / 256.f) + RMS_EPS);
#pragma unroll 1
            for (int g = 0; g < 2; ++g)
#pragma unroll
                for (int pt = 0; pt < 2; ++pt)
#pragma unroll
                    for (int rg = 0; rg < 4; ++rg) { const int ch = (2 * g + hh) * 64 + pt * 32 + 8 * rg + 4 * hi; const f32x4 nw = *(const f32x4*)(p.ssd_norm_w + l * 256 + ch);
                        const f32x4 yq = *(const f32x4*)(YS + (size_t)(t0 + lrow) * 256 + ch);
                        u32x2 o; o.x = pk2(yq.x * rn * nw.x, yq.y * rn * nw.y); o.y = pk2(yq.z * rn * nw.z, yq.w * rn * nw.w);
                        *(u32x2*)(MIX + (size_t)(t0 + lrow) * DM + 512 + ch) = o; }
            __syncthreads();
        }
    }
}

constexpr int AT_VP = 144, AT_WAVE_LDS = 32 * AT_VP + 1056;
struct AttnState { float m, l; f32x16 o0, o1; };
__device__ __forceinline__ void attn_tile_update(AttnState& st, f32x16& S, unsigned validmask, const LAS unsigned char* vt, int lane) {
    float tmax = -1e30f;
#pragma unroll
    for (int r = 0; r < 16; ++r) tmax = fmaxf(tmax, S[r]);
    tmax = fmaxf(tmax, __shfl_xor(tmax, 32));
    const float mn = fmaxf(st.m, tmax), sc = __expf(st.m - mn); st.m = mn;
    float ps = 0.f; unsigned pw[8];
#pragma unroll
    for (int r2 = 0; r2 < 8; ++r2) { const float p0 = ((validmask >> (2 * r2)) & 1u) ? __expf(S[2 * r2] - mn) : 0.f, p1 = ((validmask >> (2 * r2 + 1)) & 1u) ? __expf(S[2 * r2 + 1] - mn) : 0.f; ps += p0 + p1; pw[r2] = pk2(p0, p1); }
    st.l = st.l * sc + ps;
#pragma unroll
    for (int r = 0; r < 16; ++r) { st.o0[r] *= sc; st.o1[r] *= sc; }
    asm volatile("s_waitcnt lgkmcnt(0)" ::: "memory");
#pragma unroll
    for (int ks = 0; ks < 2; ++ks) { const bf16x8 pb = __builtin_bit_cast(bf16x8, (u32x4){pw[4 * ks], pw[4 * ks + 1], pw[4 * ks + 2], pw[4 * ks + 3]});
        st.o0 = __builtin_amdgcn_mfma_f32_32x32x16_bf16(tr_frag_acc<AT_VP>(vt, 16 * ks, 0, lane), pb, st.o0, 0, 0, 0);
        st.o1 = __builtin_amdgcn_mfma_f32_32x32x16_bf16(tr_frag_acc<AT_VP>(vt, 16 * ks, 32, lane), pb, st.o1, 0, 0, 0); }
    asm volatile("s_waitcnt lgkmcnt(0)" ::: "memory");
}
__device__ __forceinline__ void stage_attn(const Params& p, LAS unsigned char* lds, int item0, int item_stride, int wv_) {
    const int tid = otid(), lane = tid & 63, wave = __builtin_amdgcn_readfirstlane(tid >> 6), hi = lane >> 5, l31 = lane & 31;
    unsigned char* ws = p.ws; const bf16* P = (const bf16*)(ws + WS_P); const float* BT = (const float*)(ws + WS_BIAST);
    bf16* AO = (bf16*)(ws + WS_ATTO); float* LSE = (float*)(ws + WS_LSE);
    LAS unsigned char* vt = lds + wave * AT_WAVE_LDS; LAS float* bt = (LAS float*)(vt + 32 * AT_VP);
    const int h = wave;
    for (int item = item0; item < 384; item += item_stride) {
        const int br = item >> 7, q7 = item & 127, b = q7 >> 5, q5 = q7 & 31;
        const int dil = br == 0 ? 1 : (br == 1 ? 4 : 16), r = br == 0 ? 0 : (br == 1 ? (q5 >> 3) : (q5 >> 1)), n = br == 0 ? q5 : (br == 1 ? (q5 & 7) : (q5 & 1));
        const int tokbase = b * SEQ + r, m0 = n * 128;
        asm volatile("s_waitcnt lgkmcnt(0)" ::: "memory");
        bt[lane] = BT[(br * 8 + h) * 132 + lane]; bt[64 + lane] = BT[(br * 8 + h) * 132 + 64 + lane]; if (lane == 0) bt[128] = BT[(br * 8 + h) * 132 + 128];
        for (int a = 0; a < 4; ++a) {
            const int tokq = tokbase + (m0 + 32 * a + l31) * dil;
            bf16x8 qf[4];
#pragma unroll
            for (int ks = 0; ks < 4; ++ks) qf[ks] = *(const bf16x8*)(P + (size_t)tokq * NPROJ + C_Q + h * 64 + 16 * ks + 8 * hi);
            AttnState st; st.m = -1e30f; st.l = 0.f; st.o0 = (f32x16){}; st.o1 = (f32x16){};
            const int jt0 = (n == 0 && a < 4) ? 4 : a;
            for (int jt = (jt0 > a ? jt0 : a); jt <= a + 4; ++jt) {
                const int mk0 = m0 - 128 + 32 * jt;
                {
#pragma unroll
                    for (int it = 0; it < 4; ++it) { const int row = it * 8 + (lane >> 3), chn = lane & 7;
                        const u32x4 v = *(const u32x4*)(P + (size_t)(tokbase + (mk0 + row) * dil) * NPROJ + C_V + h * 64 + chn * 8);
                        *(LAS u32x4*)(vt + row * AT_VP + chn * 16) = v; } }
                const int tokk = tokbase + (mk0 + l31) * dil;
                f32x16 S = {};
#pragma unroll
                for (int ks = 0; ks < 4; ++ks) { const bf16x8 kf = *(const bf16x8*)(P + (size_t)tokk * NPROJ + C_K + h * 64 + 16 * ks + 8 * hi); S = __builtin_amdgcn_mfma_f32_32x32x16_bf16(kf, qf[ks], S, 0, 0, 0); }
                const int bs = 32 * (a - jt) + 128 + l31; unsigned vm = 0u;
#pragma unroll
                for (int rr = 0; rr < 16; ++rr) { const int stp = bs - crow(rr, hi); const bool ok = stp >= 0 && stp <= 128; const int sti = stp < 0 ? 0 : (stp > 128 ? 128 : stp);
                    S[rr] = ok ? S[rr] + bt[sti] : -1e30f; vm |= ok ? (1u << rr) : 0u; }
                attn_tile_update(st, S, vm, vt, lane);
            }
            const float lt = st.l + __shfl_xor(st.l, 32), inv = 1.f / lt;
#pragma unroll
            for (int dt = 0; dt < 2; ++dt)
#pragma unroll
                for (int rg = 0; rg < 4; ++rg) { const f32x16& o = dt ? st.o1 : st.o0; u32x2 w; w.x = pk2(o[4 * rg] * inv, o[4 * rg + 1] * inv); w.y = pk2(o[4 * rg + 2] * inv, o[4 * rg + 3] * inv);
                    *(u32x2*)(AO + ((size_t)br * T + tokq) * 512 + h * 64 + dt * 32 + 8 * rg + 4 * hi) = w; }
            if (hi == 0) LSE[((size_t)br * T + tokq) * 8 + h] = st.m + __logf(lt);
        }
    }
}
__device__ __forceinline__ void stage_memattn(const Params& p, LAS unsigned char* lds, int l, int item0, int item_stride, int wv_) {
    const int tid = otid(), lane = tid & 63, wave = __builtin_amdgcn_readfirstlane(tid >> 6), hi = lane >> 5, l31 = lane & 31;
    unsigned char* ws = p.ws; const bf16* P = (const bf16*)(ws + WS_P); const bf16* KV = (const bf16*)(ws + WS_KV) + (size_t)l * 1024 * 512; bf16* MIX = (bf16*)(ws + WS_MIX);
    LAS unsigned char* vt = lds + wave * AT_WAVE_LDS; LAS float* bt = (LAS float*)(vt + 32 * AT_VP);
    for (int item = item0; item < (T / 32) * 4; item += item_stride) {
        const int h = item & 3, tt = item >> 2, t0 = tt * 32, b = t0 / SEQ; const int tokq = t0 + l31;
        asm volatile("s_waitcnt lgkmcnt(0)" ::: "memory");
#pragma unroll
        for (int i = 0; i < 4; ++i) bt[64 * i + lane] = p.mem_bias[(l * 4 + h) * NMEM + 64 * i + lane];
        bf16x8 qf[4];
#pragma unroll
        for (int ks = 0; ks < 4; ++ks) qf[ks] = *(const bf16x8*)(P + (size_t)tokq * NPROJ + C_QM + h * 64 + 16 * ks + 8 * hi);
        AttnState st; st.m = -1e30f; st.l = 0.f; st.o0 = (f32x16){}; st.o1 = (f32x16){};
        for (int jt = 0; jt < 8; ++jt) {
            const bf16* kvb = KV + (size_t)(b * NMEM + 32 * jt) * 512;
#pragma unroll
            for (int it = 0; it < 4; ++it) { const int row = it * 8 + (lane >> 3), chn = lane & 7; const u32x4 v = *(const u32x4*)(kvb + (size_t)row * 512 + 256 + h * 64 + chn * 8); *(LAS u32x4*)(vt + row * AT_VP + chn * 16) = v; }
            f32x16 S = {};
#pragma unroll
            for (int ks = 0; ks < 4; ++ks) { const bf16x8 kf = *(const bf16x8*)(kvb + (size_t)l31 * 512 + h * 64 + 16 * ks + 8 * hi); S = __builtin_amdgcn_mfma_f32_32x32x16_bf16(kf, qf[ks], S, 0, 0, 0); }
#pragma unroll
            for (int rr = 0; rr < 16; ++rr) S[rr] += bt[32 * jt + crow(rr, hi)];
            attn_tile_update(st, S, 0xffffu, vt, lane);
        }
        const float lt = st.l + __shfl_xor(st.l, 32), inv = 1.f / lt;
#pragma unroll
        for (int dt = 0; dt < 2; ++dt)
#pragma unroll
            for (int rg = 0; rg < 4; ++rg) { const f32x16& o = dt ? st.o1 : st.o0; u32x2 w; w.x = pk2(o[4 * rg] * inv, o[4 * rg + 1] * inv); w.y = pk2(o[4 * rg + 2] * inv, o[4 * rg + 3] * inv);
                *(u32x2*)(MIX + (size_t)tokq * DM + 768 + h * 64 + dt * 32 + 8 * rg + 4 * hi) = w; }
    }
}

struct Route { int e1, e2; float w1, w2; };
__device__ __forceinline__ Route route_row(float (&lg)[16], const float* b_router) {
    float mx = -INFINITY;
#pragma unroll
    for (int e = 0; e < 16; ++e) { lg[e] += b_router[e]; mx = fmaxf(mx, lg[e]); }
    float sum = 0.f;
#pragma unroll
    for (int e = 0; e < 16; ++e) { lg[e] = __expf(lg[e] - mx); sum += lg[e]; }
    const float inv = 1.f / sum;
#pragma unroll
    for (int e = 0; e < 16; ++e) lg[e] *= inv;
    int best = 0; float bs = -1.f, c0 = 0.f, c1 = 0.f, c2 = 0.f, c3 = 0.f;
#pragma unroll
    for (int g = 0; g < 4; ++g) { const float a = lg[4 * g], b = lg[4 * g + 1], c = lg[4 * g + 2], d = lg[4 * g + 3];
        const float h1 = fmaxf(a, b), l1 = fminf(a, b), h2 = fmaxf(c, d), l2 = fminf(c, d); const float gs = fmaxf(h1, h2) + fmaxf(fminf(h1, h2), fmaxf(l1, l2));
        const bool better = gs > bs; bs = better ? gs : bs; best = better ? g : best; c0 = better ? a : c0; c1 = better ? b : c1; c2 = better ? c : c2; c3 = better ? d : c3; }
    int i1 = 0; float s1 = c0; if (c1 > s1) { s1 = c1; i1 = 1; } if (c2 > s1) { s1 = c2; i1 = 2; } if (c3 > s1) { s1 = c3; i1 = 3; }
    int i2 = -1; float s2 = -1.f;
    if (i1 != 0 && c0 > s2) { s2 = c0; i2 = 0; } if (i1 != 1 && c1 > s2) { s2 = c1; i2 = 1; } if (i1 != 2 && c2 > s2) { s2 = c2; i2 = 2; } if (i1 != 3 && c3 > s2) { s2 = c3; i2 = 3; }
    Route r; r.e1 = best * 4 + i1; r.e2 = best * 4 + i2; const float wsn = 1.f / (s1 + s2); r.w1 = s1 * wsn; r.w2 = s2 * wsn; return r;
}
constexpr int RT_W = 0, RT_LCNT = 65536, RT_GB = 65536 + 64, RT_INFO = 65536 + 128;
__device__ __forceinline__ void stage_ln1_router2(const Params& p, LAS unsigned char* lds, int l, int blk, int nblk, int wv_) {
    const int tid = otid(), lane = tid & 63, wave = __builtin_amdgcn_readfirstlane(tid >> 6);
    unsigned char* ws = p.ws; bf16* XB = (bf16*)(ws + WS_XB); unsigned* cnt = (unsigned*)(ws + WS_CTL) + CW_CNT + l * 16;
    int* TOKE = (int*)(ws + WS_TOKE); int* TOKP = (int*)(ws + WS_TOKP); float* TOKW = (float*)(ws + WS_TOKW); int* LIST = (int*)(ws + WS_LIST);
    LAS f32x4* WL = (LAS f32x4*)(lds + RT_W); LAS unsigned* lcnt = (LAS unsigned*)(lds + RT_LCNT); LAS unsigned* gb = (LAS unsigned*)(lds + RT_GB); LAS int* info = (LAS int*)(lds + RT_INFO);
#pragma unroll
    for (int i = 0; i < 8; ++i) { const int chunk = tid + NTHREADS * i, k = chunk >> 2, q = chunk & 3, ln = (k & 255) >> 2, c = k & 3, j = k >> 8;
        WL[((j * 4 + c) * 4 + q) * 64 + ln] = *((const f32x4*)p.w_router + chunk); }
    for (int rb = blk; rb < T / 64; rb += nblk) {
        if (tid < 16) lcnt[tid] = 0u;
        __syncthreads();
#pragma unroll 1
        for (int pr = 0; pr < 4; ++pr) {
            const int r0 = wave * 8 + 2 * pr, t = rb * 64 + r0;
            f32x4 v0[4], v1[4]; f32x4* xr0 = (f32x4*)(p.out + (size_t)t * DM) + lane; f32x4* xr1 = xr0 + DM / 4;
#pragma unroll
            for (int j = 0; j < 4; ++j) { v0[j] = xr0[64 * j]; v1[j] = xr1[64 * j]; }
            ln_row(v0, p.ln1_g + l * DM, p.ln1_b + l * DM, lane); ln_row(v1, p.ln1_g + l * DM, p.ln1_b + l * DM, lane);
            float lg0[16], lg1[16];
#pragma unroll
            for (int e = 0; e < 16; ++e) { lg0[e] = 0.f; lg1[e] = 0.f; }
#pragma unroll
            for (int j = 0; j < 4; ++j) { xr0[64 * j] = v0[j]; xr1[64 * j] = v1[j];
                u32x2 o; o.x = pk2(v0[j].x, v0[j].y); o.y = pk2(v0[j].z, v0[j].w); *((u32x2*)(XB + (size_t)t * DM) + lane + 64 * j) = o;
                o.x = pk2(v1[j].x, v1[j].y); o.y = pk2(v1[j].z, v1[j].w); *((u32x2*)(XB + (size_t)(t + 1) * DM) + lane + 64 * j) = o;
#pragma unroll
                for (int c = 0; c < 4; ++c) { const float x0 = v0[j][c], x1 = v1[j][c];
#pragma unroll
                    for (int q = 0; q < 4; ++q) { const f32x4 w = WL[((j * 4 + c) * 4 + q) * 64 + lane];
                        lg0[4 * q] += x0 * w.x; lg0[4 * q + 1] += x0 * w.y; lg0[4 * q + 2] += x0 * w.z; lg0[4 * q + 3] += x0 * w.w;
                        lg1[4 * q] += x1 * w.x; lg1[4 * q + 1] += x1 * w.y; lg1[4 * q + 2] += x1 * w.z; lg1[4 * q + 3] += x1 * w.w; } } }
#pragma unroll
            for (int e = 0; e < 16; ++e) { lg0[e] = wave_sum(lg0[e]); lg1[e] = wave_sum(lg1[e]); }
            const Route ra = route_row(lg0, p.b_router), rc = route_row(lg1, p.b_router);
            if (lane == 0) {
                const int pa1 = (int)__hip_atomic_fetch_add(lcnt + ra.e1, 1u, __ATOMIC_RELAXED, __HIP_MEMORY_SCOPE_WORKGROUP), pa2 = (int)__hip_atomic_fetch_add(lcnt + ra.e2, 1u, __ATOMIC_RELAXED, __HIP_MEMORY_SCOPE_WORKGROUP);
                const int pc1 = (int)__hip_atomic_fetch_add(lcnt + rc.e1, 1u, __ATOMIC_RELAXED, __HIP_MEMORY_SCOPE_WORKGROUP), pc2 = (int)__hip_atomic_fetch_add(lcnt + rc.e2, 1u, __ATOMIC_RELAXED, __HIP_MEMORY_SCOPE_WORKGROUP);
                LAS int* ia = info + r0 * 6; ia[0] = ra.e1; ia[1] = ra.e2; ia[2] = pa1; ia[3] = pa2; ia[4] = __builtin_bit_cast(int, ra.w1); ia[5] = __builtin_bit_cast(int, ra.w2);
                ia[6] = rc.e1; ia[7] = rc.e2; ia[8] = pc1; ia[9] = pc2; ia[10] = __builtin_bit_cast(int, rc.w1); ia[11] = __builtin_bit_cast(int, rc.w2); }
        }
        __syncthreads();
        if (tid < 16) gb[tid] = atomicAdd(cnt + tid, lcnt[tid]);
        __syncthreads();
        if (tid < 64) { const int t = rb * 64 + tid; const LAS int* ia = info + tid * 6; const int e1 = ia[0], e2 = ia[1], p1 = (int)gb[e1] + ia[2], p2 = (int)gb[e2] + ia[3];
            LIST[e1 * T + p1] = t; LIST[e2 * T + p2] = t; TOKE[2 * t] = e1; TOKE[2 * t + 1] = e2; TOKP[2 * t] = p1; TOKP[2 * t + 1] = p2;
            TOKW[2 * t] = __builtin_bit_cast(float, ia[4]); TOKW[2 * t + 1] = __builtin_bit_cast(float, ia[5]); }
        __syncthreads();
    }
}
__device__ __forceinline__ void stage_ln2b(const Params& p, LAS unsigned char* lds, int l, int blk, int nblk, int wv_) {
    const int tid = otid(), lane = tid & 63, wave = __builtin_amdgcn_readfirstlane(tid >> 6), gw = blk * NWAVES + wave, ngw = nblk * NWAVES;
    unsigned char* ws = p.ws; bf16* XB = (bf16*)(ws + WS_XB); const unsigned* cnt = (const unsigned*)(ws + WS_CTL) + CW_CNT + l * 16; const bf16* Y = (const bf16*)(ws + WS_Y);
    const int* TOKE = (const int*)(ws + WS_TOKE); const int* TOKP = (const int*)(ws + WS_TOKP); const float* TOKW = (const float*)(ws + WS_TOKW); float* DT = (float*)(ws + WS_DT);
    LAS int* eb = (LAS int*)lds;
    if (tid == 0) { int a = 0; for (int e = 0; e < NE; ++e) { eb[e] = a; a += (int)((cnt[e] + 255u) >> 8) * 256; } }
    __syncthreads();
    const bool nextl = l + 1 < DEPTH;
    for (int t = 2 * gw; t < T; t += 2 * ngw) {
        asm volatile("" ::: "memory");
        const int ea1 = TOKE[2 * t], ea2 = TOKE[2 * t + 1], ec1 = TOKE[2 * t + 2], ec2 = TOKE[2 * t + 3];
        const int ra1 = TOKP[2 * t] + eb[ea1], ra2 = TOKP[2 * t + 1] + eb[ea2], rc1 = TOKP[2 * t + 2] + eb[ec1], rc2 = TOKP[2 * t + 3] + eb[ec2];
        const float wa1 = TOKW[2 * t], wa2 = TOKW[2 * t + 1], wc1 = TOKW[2 * t + 2], wc2 = TOKW[2 * t + 3];
        f32x4 v0[4], v1[4]; f32x4* xr0 = (f32x4*)(p.out + (size_t)t * DM) + lane; f32x4* xr1 = xr0 + DM / 4;
#pragma unroll
        for (int j = 0; j < 4; ++j) { const f32x4 xa = xr0[64 * j], xc = xr1[64 * j];
            const u32x2 a = *((const u32x2*)(Y + (size_t)ra1 * DM) + lane + 64 * j), b = *((const u32x2*)(Y + (size_t)ra2 * DM) + lane + 64 * j);
            const u32x2 c = *((const u32x2*)(Y + (size_t)rc1 * DM) + lane + 64 * j), d = *((const u32x2*)(Y + (size_t)rc2 * DM) + lane + 64 * j);
            v0[j].x = ALPHA * xa.x + (wa1 * bflo(a.x) + wa2 * bflo(b.x)); v0[j].y = ALPHA * xa.y + (wa1 * bfhi(a.x) + wa2 * bfhi(b.x));
            v0[j].z = ALPHA * xa.z + (wa1 * bflo(a.y) + wa2 * bflo(b.y)); v0[j].w = ALPHA * xa.w + (wa1 * bfhi(a.y) + wa2 * bfhi(b.y));
            v1[j].x = ALPHA * xc.x + (wc1 * bflo(c.x) + wc2 * bflo(d.x)); v1[j].y = ALPHA * xc.y + (wc1 * bfhi(c.x) + wc2 * bfhi(d.x));
            v1[j].z = ALPHA * xc.z + (wc1 * bflo(c.y) + wc2 * bflo(d.y)); v1[j].w = ALPHA * xc.w + (wc1 * bfhi(c.y) + wc2 * bfhi(d.y)); }
        ln_row(v0, p.ln2_g + l * DM, p.ln2_b + l * DM, lane); ln_row(v1, p.ln2_g + l * DM, p.ln2_b + l * DM, lane);
        float d0 = 0.f, d1 = 0.f, d2 = 0.f, d3 = 0.f, f0 = 0.f, f1 = 0.f, f2 = 0.f, f3 = 0.f;
#pragma unroll
        for (int j = 0; j < 4; ++j) { xr0[64 * j] = v0[j]; xr1[64 * j] = v1[j];
            if (nextl) { u32x2 o; o.x = pk2(v0[j].x, v0[j].y); o.y = pk2(v0[j].z, v0[j].w); *((u32x2*)(XB + (size_t)t * DM) + lane + 64 * j) = o;
                o.x = pk2(v1[j].x, v1[j].y); o.y = pk2(v1[j].z, v1[j].w); *((u32x2*)(XB + (size_t)(t + 1) * DM) + lane + 64 * j) = o;
#pragma unroll
                for (int c = 0; c < 4; ++c) { const int k = 4 * lane + 256 * j + c; const f32x4 w = *(const f32x4*)(p.w_in + ((size_t)(l + 1) * DM + k) * NCOLS_IN + 2560); const float xa = v0[j][c], xc = v1[j][c];
                    d0 += xa * w.x; d1 += xa * w.y; d2 += xa * w.z; d3 += xa * w.w; f0 += xc * w.x; f1 += xc * w.y; f2 += xc * w.z; f3 += xc * w.w; } } }
        if (nextl) { d0 = wave_sum(d0); d1 = wave_sum(d1); d2 = wave_sum(d2); d3 = wave_sum(d3); f0 = wave_sum(f0); f1 = wave_sum(f1); f2 = wave_sum(f2); f3 = wave_sum(f3);
            if (lane == 0) { *(f32x4*)(DT + (size_t)t * 4) = (f32x4){d0, d1, d2, d3}; *(f32x4*)(DT + (size_t)(t + 1) * 4) = (f32x4){f0, f1, f2, f3}; } }
    }
    __syncthreads();
}
__device__ __forceinline__ void stage_merge2(const Params& p, int blk, int nblk, int wv_) {
    const int tid = otid(), lane = tid & 63, wave = tid >> 6, gw = blk * NWAVES + wave, ngw = nblk * NWAVES, h = lane >> 3;
    unsigned char* ws = p.ws; const bf16* AO = (const bf16*)(ws + WS_ATTO); const float* LSE = (const float*)(ws + WS_LSE); bf16* MIX = (bf16*)(ws + WS_MIX);
    for (int t0 = 4 * gw; t0 < T; t0 += 4 * ngw) {
        u32x4 a[4][3]; float ls[4][3];
#pragma unroll
        for (int i = 0; i < 4; ++i)
#pragma unroll
            for (int br = 0; br < 3; ++br) { a[i][br] = *(const u32x4*)(AO + ((size_t)br * T + t0 + i) * 512 + lane * 8); ls[i][br] = LSE[((size_t)br * T + t0 + i) * 8 + h]; }
#pragma unroll
        for (int i = 0; i < 4; ++i) { const float mx = fmaxf(fmaxf(ls[i][0], ls[i][1]), ls[i][2]); float w0 = __expf(ls[i][0] - mx), w1 = __expf(ls[i][1] - mx), w2 = __expf(ls[i][2] - mx); const float inv = 1.f / (w0 + w1 + w2); w0 *= inv; w1 *= inv; w2 *= inv;
            u32x4 o;
#pragma unroll
            for (int q = 0; q < 4; ++q) o[q] = pk2(w0 * bflo(a[i][0][q]) + w1 * bflo(a[i][1][q]) + w2 * bflo(a[i][2][q]), w0 * bfhi(a[i][0][q]) + w1 * bfhi(a[i][1][q]) + w2 * bfhi(a[i][2][q]));
            *(u32x4*)(MIX + (size_t)(t0 + i) * DM + lane * 8) = o; }
    }
}
__device__ __forceinline__ void stage_ssd_scan2(const Params& p, int blk, int nblk, int wv_) {
    unsigned char* ws = p.ws; float* SST = (float*)(ws + WS_SST); const float* ATOT = (const float*)(ws + WS_ATOT);
    for (int e = blk * NTHREADS + otid(); e < NB * 4 * 8192; e += nblk * NTHREADS) { const int el = e & 8191, h = (e >> 13) & 3, b = e >> 15;
        float sv[32], dc[32];
#pragma unroll
        for (int c = 0; c < 32; ++c) { sv[c] = SST[((size_t)((b * 32 + c) * 4 + h)) * 8192 + el]; dc[c] = ATOT[(b * 32 + c) * 4 + h]; }
        float run = 0.f;
#pragma unroll
        for (int c = 0; c < 32; ++c) { const float in = sv[c]; sv[c] = run; run = run * __expf(dc[c]) + in; }
#pragma unroll
        for (int c = 0; c < 32; ++c) SST[((size_t)((b * 32 + c) * 4 + h)) * 8192 + el] = sv[c]; }
}

constexpr int CW_BAR = 4096;
#define XB_TMO      128
#define XB_XCNT(j)  (256  + 64 * (j))
#define XB_XSUB(j)  (1280 + 64 * (j))
#define XB_XGEN(j)  (2304 + 64 * (j))
#define XB_TOP      3328
#define XB_TOPGEN   3392
#define XCD_BAR_WORDS 3456
#define XB_SPIN_CAP (1u << 18)

__device__ __forceinline__ unsigned xb_ld(unsigned* p)              { return __hip_atomic_load(p, __ATOMIC_RELAXED, __HIP_MEMORY_SCOPE_AGENT); }
__device__ __forceinline__ unsigned xb_add(unsigned* p, unsigned v) { return __hip_atomic_fetch_add(p, v, __ATOMIC_RELAXED, __HIP_MEMORY_SCOPE_AGENT); }
__device__ __forceinline__ unsigned xb_xcc_id() { return (unsigned)__builtin_amdgcn_s_getreg((3 << 11) | 20) & 0xFu; }
#define XB_SPIN(cond, bar) do { unsigned _sp = 0; while (cond) { __builtin_amdgcn_s_sleep(1); \
    if ((++_sp & 255u) == 0u) { if (xb_ld(&(bar)[XB_TMO])) break; if (_sp > XB_SPIN_CAP) { atomicAdd(&(bar)[XB_TMO], 1u); break; } } } } while (0)

struct XcdBarrier {
    unsigned* bar; unsigned x;
    volatile LAS unsigned* st;
    bool leader;
};

__device__ __forceinline__ XcdBarrier xcd_barrier_post(unsigned* bar, volatile LAS unsigned* st) {
    XcdBarrier b; b.bar = bar; b.x = xb_xcc_id(); b.st = st; b.leader = (threadIdx.x == 0);
    if (threadIdx.x == 0) (void)xb_add(&bar[XB_XCNT(b.x)], 1u);
    return b;
}
__device__ __forceinline__ void xcd_barrier_complete(unsigned* bar, unsigned x, unsigned& nloc, unsigned& nx) {
    const unsigned G = gridDim.x * gridDim.y * gridDim.z;
    unsigned sum, cnt, mine, sp = 0u;
    for (;;) {
        sum = 0u; cnt = 0u; mine = 0u;
#pragma unroll
        for (unsigned j = 0; j < 16; ++j) { const unsigned c = xb_ld(&bar[XB_XCNT(j)]); sum += c; cnt += (c > 0u) ? 1u : 0u; mine = (j == x) ? c : mine; }
        if (sum == G) break;
        __builtin_amdgcn_s_sleep(1);
        if ((++sp & 255u) == 0u) { if (xb_ld(&bar[XB_TMO])) break; if (sp > XB_SPIN_CAP) { atomicAdd(&bar[XB_TMO], 1u); break; } }
    }
    nloc = mine > 0u ? mine : 1u; nx = cnt > 0u ? cnt : 1u;
}

__device__ __forceinline__ void xcd_barrier(const XcdBarrier& b) {
    asm volatile("s_waitcnt vmcnt(0)" ::: "memory");
    __syncthreads();
    if (b.leader) {
        unsigned* bar = b.bar;
        __builtin_amdgcn_s_waitcnt(0);
        unsigned nloc = b.st[0], nx = b.st[1];
        if (nloc == 0u) { xcd_barrier_complete(bar, b.x, nloc, nx); b.st[0] = nloc; b.st[1] = nx; }
        const unsigned old = xb_add(&bar[XB_XSUB(b.x)], 1u);
        const unsigned gen = old / nloc;
        if (old + 1u == (gen + 1u) * nloc) {
            __builtin_amdgcn_fence(__ATOMIC_RELEASE, "agent");
            asm volatile("s_waitcnt vmcnt(0)" ::: "memory");
            const unsigned og = xb_add(&bar[XB_TOP], 1u);
            const unsigned tg = og / nx;
            if (og + 1u == (tg + 1u) * nx) xb_add(&bar[XB_TOPGEN], 1u);
            else XB_SPIN(xb_ld(&bar[XB_TOPGEN]) == tg, bar);
            __builtin_amdgcn_fence(__ATOMIC_ACQUIRE, "agent");
            xb_add(&bar[XB_XGEN(b.x)], 1u);
            asm volatile("s_waitcnt vmcnt(0)" ::: "memory");
        } else {
            XB_SPIN(xb_ld(&bar[XB_XGEN(b.x)]) == gen, bar);
            __builtin_amdgcn_fence(__ATOMIC_ACQUIRE, "agent");
            asm volatile("s_waitcnt vmcnt(0)" ::: "memory");
        }
    }
    __syncthreads();
}

constexpr int RING_BYTES = 131072;
constexpr int LDS_BYTES = 147456;
constexpr int LDSCTL_OFF = LDS_BYTES - 512;
constexpr int MISC_OFF = LDSCTL_OFF;
constexpr int LDS_BYTES_UNUSED_ = 0;


__device__ __forceinline__ void launder(Params& q) {
#define LND(f) asm volatile("" : "+s"(q.f))
    LND(x); LND(mem); LND(w_in); LND(w_out); LND(rel_bias); LND(conv_w); LND(conv_b); LND(dt_bias); LND(a_log); LND(d_skip); LND(ssd_norm_w); LND(w_mem_kv); LND(mem_bias);
    LND(ln1_g); LND(ln1_b); LND(ln2_g); LND(ln2_b); LND(w_router); LND(b_router); LND(w_gate); LND(w_up); LND(w_down); LND(out); LND(ws);
#undef LND
}
constexpr int PROBE_STOP = -1;
__global__ void __launch_bounds__(NTHREADS, 2) mega_fwd(Params p, int stop) {
    extern __shared__ __attribute__((aligned(16))) unsigned char lds_raw[];
    LAS unsigned char* lds = (LAS unsigned char*)lds_raw;
    const int tid = threadIdx.x, blk = blockIdx.x, nblk = gridDim.x; const int wv_ = __builtin_amdgcn_readfirstlane(tid >> 6);
    for (int u = tid; u < (LDS_BYTES - LDSCTL_OFF) / 4; u += NTHREADS) ((LAS unsigned*)(lds + LDSCTL_OFF))[u] = 0u;
    __syncthreads();
    volatile LAS unsigned* MISC = (volatile LAS unsigned*)(lds + MISC_OFF);
    (void)xcd_barrier_post((unsigned*)(p.ws + WS_CTL) + CW_BAR, MISC + 8);
#define GRID_BAR() do { XcdBarrier b_; b_.bar = (unsigned*)(p.ws + WS_CTL) + CW_BAR; b_.x = xb_xcc_id(); b_.st = (volatile LAS unsigned*)(lds + MISC_OFF) + 8; b_.leader = (otid() == 0); xcd_barrier(b_); } while (0)
    stage_prologue(p, lds, blk, nblk, wv_);
    if (stop == 0) return;
    GRID_BAR();
#pragma unroll 1
    for (int l = 0; l < DEPTH; ++l) {
        Params q = p; launder(q);
        stage_proj(q, lds, l, blk, nblk, wv_);
        if (stop == l * 10 + 1) return;
        GRID_BAR();
        stage_ssd1(q, lds, l, blk, nblk, wv_); stage_attn(q, lds, blk, nblk, wv_); stage_memattn(q, lds, l, blk * NWAVES + wv_, nblk * NWAVES, wv_);
        if (stop == l * 10 + 2) return;
        GRID_BAR();
        stage_ssd_scan2(q, blk, nblk, wv_); stage_merge2(q, blk, nblk, wv_);
        if (stop == l * 10 + 3) return;
        GRID_BAR();
        stage_ssd3(q, lds, l, blk, nblk, wv_);
        if (stop == l * 10 + 4) return;
        GRID_BAR();
        stage_out(q, lds, l, blk, nblk, wv_);
        if (stop == l * 10 + 5) return;
        GRID_BAR();
        stage_ln1_router2(q, lds, l, blk, nblk, wv_);
        if (stop == l * 10 + 6) return;
        GRID_BAR();
        stage_moe1(q, lds, l, blk, nblk, wv_);
        if (stop == l * 10 + 7) return;
        GRID_BAR();
        stage_moe2(q, lds, l, blk, nblk, wv_);
        if (stop == l * 10 + 8) return;
        GRID_BAR();
        stage_ln2b(q, lds, l, blk, nblk, wv_);
        if (l + 1 < DEPTH) GRID_BAR();
    }
}

extern "C" void kernel_launch(void* const* d_in, const int* in_sizes, int n_in, void* d_out, int out_size, void* d_ws, size_t ws_size, hipStream_t stream) {
    if (n_in != 22 || out_size != T * DM || ws_size < WS_END) { fprintf(stderr, "kernel_launch: unexpected shapes (n_in %d out %d ws %zu)\n", n_in, out_size, ws_size); return; }
    static int grid = 0;
    if (grid == 0) {
        int dev = 0, cus = 0, per_cu = 0;
        if (hipGetDevice(&dev) != hipSuccess || hipDeviceGetAttribute(&cus, hipDeviceAttributeMultiprocessorCount, dev) != hipSuccess) { grid = -1; return; }
        if (hipFuncSetAttribute((const void*)mega_fwd, hipFuncAttributeMaxDynamicSharedMemorySize, LDS_BYTES) != hipSuccess) { fprintf(stderr, "kernel_launch: hipFuncSetAttribute failed\n"); grid = -1; return; }
        if (hipOccupancyMaxActiveBlocksPerMultiprocessor(&per_cu, (const void*)mega_fwd, NTHREADS, LDS_BYTES) != hipSuccess || per_cu < 1) fprintf(stderr, "kernel_launch: occupancy query reports %d\n", per_cu);
        (void)hipGetLastError();
        grid = cus;
    }
    if (grid < 0) return;
    Params p{};
    const float** pp = (const float**)&p;
    for (int i = 0; i < 22; ++i) pp[i] = (const float*)d_in[i];
    p.out = (float*)d_out; p.ws = (unsigned char*)d_ws;
    (void)hipMemsetAsync((char*)d_ws + WS_CTL, 0, CTL_ZERO_BYTES, stream);
    if (PROBE_STOP >= 0) { hipLaunchKernelGGL(mega_fwd, dim3(grid), dim3(NTHREADS), LDS_BYTES, stream, p, PROBE_STOP); (void)hipMemsetAsync((char*)d_ws + WS_CTL, 0, CTL_ZERO_BYTES, stream); }
    hipLaunchKernelGGL(mega_fwd, dim3(grid), dim3(NTHREADS), LDS_BYTES, stream, p, 1000);
}
```

```cpp
#include <hip/hip_runtime.h>
#include <cstdio>
#include <cstdint>

#define GAS __attribute__((address_space(1)))
#define LAS __attribute__((address_space(3)))
typedef unsigned short bf16;
typedef short bf16x8 __attribute__((ext_vector_type(8)));
typedef float f32x4 __attribute__((ext_vector_type(4)));
typedef float f32x16 __attribute__((ext_vector_type(16)));
typedef unsigned u32x4 __attribute__((ext_vector_type(4)));
typedef unsigned u32x2 __attribute__((ext_vector_type(2)));

constexpr int NB = 4, SEQ = 4096, T = NB * SEQ, DM = 1024, DEPTH = 2;
constexpr int NCOLS_IN = 2820, NPROJ = 2816;
constexpr int C_Q = 0, C_K = 512, C_V = 1024, C_Z = 1536, C_XBC = 1792, C_QM = 2560;
constexpr int NE = 16, NMEM = 256;
constexpr int HROWS = 36864;
constexpr float ALPHA = 1.41421356237309515f;
constexpr float LN_EPS = 1e-5f, RMS_EPS = 1e-5f;
constexpr int NTHREADS = 512, NWAVES = 8;

constexpr size_t MiB = 1u << 20;
constexpr size_t WS_CTL = 0, CTL_ZERO_BYTES = 1 * MiB;
constexpr size_t WS_BIAST = 1 * MiB;
constexpr size_t WS_KV = 2 * MiB;
constexpr size_t WS_MEMB = 4 * MiB;
constexpr size_t WS_WT_KV = 6 * MiB;
constexpr size_t WS_WT_OUT = 8 * MiB;
constexpr size_t WS_WT_IN = 12 * MiB;
constexpr size_t WS_WT_GU = 24 * MiB;
constexpr size_t WS_WT_DN = 152 * MiB;
constexpr size_t WS_XB = 216 * MiB;
constexpr size_t WS_MIX = 248 * MiB;
constexpr size_t WS_DT = 280 * MiB;
constexpr size_t WS_TOKE = 281 * MiB;
constexpr size_t WS_TOKP = WS_TOKE + 128 * 1024;
constexpr size_t WS_TOKW = WS_TOKP + 128 * 1024;
constexpr size_t WS_LIST = 282 * MiB;
constexpr size_t WS_SST = 284 * MiB;
constexpr size_t WS_P = 300 * MiB;
constexpr size_t WS_ATTO = 388 * MiB;
constexpr size_t WS_LSE = 436 * MiB;
constexpr size_t WS_H = 300 * MiB;
constexpr size_t WS_Y = 372 * MiB;
constexpr size_t WS_XBCC = 444 * MiB;
constexpr size_t WS_YS = 492 * MiB;
constexpr size_t WS_END = 508 * MiB;
constexpr int CW_CNT = 64;

struct Params {
    const float *x, *mem, *w_in, *w_out, *rel_bias, *conv_w, *conv_b, *dt_bias, *a_log, *d_skip, *ssd_norm_w, *w_mem_kv, *mem_bias,
        *ln1_g, *ln1_b, *ln2_g, *ln2_b, *w_router, *b_router, *w_gate, *w_up, *w_down;
    float* out; unsigned char* ws;
};

__device__ __forceinline__ int otid_w(int wv) { int t; asm volatile("v_mbcnt_lo_u32_b32 %0, -1, 0\n\tv_mbcnt_hi_u32_b32 %0, -1, %0\n\tv_lshl_add_u32 %0, %1, 6, %0" : "=&v"(t) : "s"(wv)); return t; }
#define otid() otid_w(wv_)
__device__ __forceinline__ unsigned f2bf(float f) { unsigned u = __builtin_bit_cast(unsigned, f); return (u + 0x7fffu + ((u >> 16) & 1u)) >> 16; }
__device__ __forceinline__ unsigned pk2(float lo, float hi) { return f2bf(lo) | (f2bf(hi) << 16); }
__device__ __forceinline__ float bf2f(unsigned b) { return __builtin_bit_cast(float, b << 16); }
__device__ __forceinline__ float bflo(unsigned w) { return __builtin_bit_cast(float, w << 16); }
__device__ __forceinline__ float bfhi(unsigned w) { return __builtin_bit_cast(float, w & 0xffff0000u); }
__device__ __forceinline__ float wave_sum(float v) {
#pragma unroll
    for (int o = 1; o < 64; o <<= 1) v += __shfl_xor(v, o);
    return v;
}
__device__ __forceinline__ float wave_max(float v) {
#pragma unroll
    for (int o = 1; o < 64; o <<= 1) v = fmaxf(v, __shfl_xor(v, o));
    return v;
}
__device__ __forceinline__ float silu_f(float v) { return v / (1.f + __expf(-v)); }
__device__ __forceinline__ float softplus_f(float v) { return v > 20.f ? v : log1pf(__expf(v)); }
__device__ __forceinline__ int crow(int r, int hi) { return (r & 3) + 8 * (r >> 2) + 4 * hi; }

template <class TT> __device__ __forceinline__ TT gld(const void* ptr) { return *(const GAS TT*)ptr; }
template <class TT> __device__ __forceinline__ void gst(void* ptr, TT v) { *(GAS TT*)ptr = v; }
__device__ __forceinline__ void transpose_item(const float* W, int ldw, int src_col0, bf16* WT, int K, int dst_row0, float scale, LAS float* scr, int k0, int lane) {
    f32x4 v[16];
#pragma unroll
    for (int i = 0; i < 16; ++i) v[i] = *(const f32x4*)(W + (size_t)(k0 + 4 * i + (lane >> 4)) * ldw + src_col0 + 4 * (lane & 15));
#pragma unroll
    for (int i = 0; i < 16; ++i) { LAS float* d = scr + (4 * i + (lane >> 4)) * 65 + 4 * (lane & 15); d[0] = v[i].x; d[1] = v[i].y; d[2] = v[i].z; d[3] = v[i].w; }
    asm volatile("s_waitcnt lgkmcnt(0)" ::: "memory");
    const int c = lane >> 3, nn = lane & 7;
#pragma unroll
    for (int jj = 0; jj < 8; ++jj) { const int n = nn + 8 * jj; const LAS float* sp = scr + (8 * c) * 65 + n;
        u32x4 o; o.x = pk2(sp[0 * 65] * scale, sp[1 * 65] * scale); o.y = pk2(sp[2 * 65] * scale, sp[3 * 65] * scale); o.z = pk2(sp[4 * 65] * scale, sp[5 * 65] * scale); o.w = pk2(sp[6 * 65] * scale, sp[7 * 65] * scale);
        *(u32x4*)(WT + (size_t)(dst_row0 + n) * K + k0 + 8 * c) = o; }
    asm volatile("s_waitcnt lgkmcnt(0)" ::: "memory");
}
constexpr int I_IN = 2 * 16 * 44, I_OUT = 2 * 16 * 16, I_KV = 2 * 16 * 8, I_GU = 32 * 16 * 32, I_DN = 32 * 16 * 16;
constexpr int I_TOTAL = I_IN + I_OUT + I_KV + I_GU + I_DN;

__device__ __forceinline__ void stage_prologue(const Params& p, LAS unsigned char* lds, int blk, int nblk, int wv_) {
    const int tid = otid(), lane = tid & 63, wave = tid >> 6;
    const int gw = blk * NWAVES + wave, ngw = nblk * NWAVES;
    LAS float* scr = (LAS float*)(lds + wave * 16640);
    unsigned char* ws = p.ws;
    for (int it = gw; it < I_TOTAL; it += ngw) {
        int r = it;
        if (r < I_IN) { const int l = r / (16 * 44), q = r % (16 * 44), kb = q / 44, nb = q % 44, n0 = nb * 64;
            transpose_item(p.w_in + (size_t)l * DM * NCOLS_IN, NCOLS_IN, n0 < 2560 ? n0 : n0 + 4, (bf16*)(ws + WS_WT_IN) + (size_t)l * NPROJ * DM, DM, n0, (n0 < 512 || n0 >= 2560) ? 0.125f : 1.f, scr, kb * 64, lane); continue; }
        r -= I_IN;
        if (r < I_OUT) { const int l = r / (16 * 16), q = r % (16 * 16), kb = q / 16, nb = q % 16;
            transpose_item(p.w_out + (size_t)l * DM * DM, DM, nb * 64, (bf16*)(ws + WS_WT_OUT) + (size_t)l * DM * DM, DM, nb * 64, 1.f, scr, kb * 64, lane); continue; }
        r -= I_OUT;
        if (r < I_KV) { const int l = r / (16 * 8), q = r % (16 * 8), kb = q / 8, nb = q % 8;
            transpose_item(p.w_mem_kv + (size_t)l * DM * 512, 512, nb * 64, (bf16*)(ws + WS_WT_KV) + (size_t)l * 512 * DM, DM, nb * 64, 1.f, scr, kb * 64, lane); continue; }
        r -= I_KV;
        if (r < I_GU) { const int le = r / (16 * 32), q = r % (16 * 32), kb = q / 32, nb = q % 32, n0 = nb * 64, pn = n0 >> 8, bj = (n0 >> 7) & 1, j0 = n0 & 127;
            transpose_item((bj ? p.w_up : p.w_gate) + (size_t)le * DM * DM, DM, 128 * pn + j0, (bf16*)(ws + WS_WT_GU) + (size_t)le * 2048 * DM, DM, n0, 1.f, scr, kb * 64, lane); continue; }
        r -= I_GU;
        { const int le = r / (16 * 16), q = r % (16 * 16), kb = q / 16, nb = q % 16;
            transpose_item(p.w_down + (size_t)le * DM * DM, DM, nb * 64, (bf16*)(ws + WS_WT_DN) + (size_t)le * DM * DM, DM, nb * 64, 1.f, scr, kb * 64, lane); }
    }
    {
        bf16* XB = (bf16*)(ws + WS_XB); float* DT = (float*)(ws + WS_DT);
        for (int m = 2 * gw; m < T; m += 2 * ngw) {
            const f32x4* xr = (const f32x4*)(p.x + (size_t)m * DM) + lane;
            f32x4 va[4], vb[4];
#pragma unroll
            for (int j = 0; j < 4; ++j) { va[j] = xr[64 * j]; vb[j] = xr[DM / 4 + 64 * j]; }
            float d0 = 0.f, d1 = 0.f, d2 = 0.f, d3 = 0.f, f0 = 0.f, f1 = 0.f, f2 = 0.f, f3 = 0.f;
#pragma unroll
            for (int j = 0; j < 4; ++j) {
                u32x2 o; o.x = pk2(va[j].x, va[j].y); o.y = pk2(va[j].z, va[j].w); *((u32x2*)(XB + (size_t)m * DM) + lane + 64 * j) = o;
                o.x = pk2(vb[j].x, vb[j].y); o.y = pk2(vb[j].z, vb[j].w); *((u32x2*)(XB + (size_t)(m + 1) * DM) + lane + 64 * j) = o;
#pragma unroll
                for (int c = 0; c < 4; ++c) { const int k = 4 * lane + 256 * j + c; const f32x4 w = *(const f32x4*)(p.w_in + (size_t)k * NCOLS_IN + 2560); const float xa = va[j][c], xc = vb[j][c];
                    d0 += xa * w.x; d1 += xa * w.y; d2 += xa * w.z; d3 += xa * w.w; f0 += xc * w.x; f1 += xc * w.y; f2 += xc * w.z; f3 += xc * w.w; } }
            d0 = wave_sum(d0); d1 = wave_sum(d1); d2 = wave_sum(d2); d3 = wave_sum(d3); f0 = wave_sum(f0); f1 = wave_sum(f1); f2 = wave_sum(f2); f3 = wave_sum(f3);
            if (lane == 0) { *(f32x4*)(DT + (size_t)m * 4) = (f32x4){d0, d1, d2, d3}; *(f32x4*)(DT + (size_t)(m + 1) * 4) = (f32x4){f0, f1, f2, f3}; }
        }
    }
    {
        bf16* MB = (bf16*)(ws + WS_MEMB);
        for (int m = gw; m < NB * NMEM; m += ngw) {
            const f32x4* xr = (const f32x4*)(p.mem + (size_t)m * DM) + lane;
#pragma unroll
            for (int j = 0; j < 4; ++j) { const f32x4 v = xr[64 * j]; u32x2 o; o.x = pk2(v.x, v.y); o.y = pk2(v.z, v.w); *((u32x2*)(MB + (size_t)m * DM) + lane + 64 * j) = o; }
        }
    }
    if (blk == 0) {
        float* BT = (float*)(ws + WS_BIAST);
        for (int i = tid; i < 3 * 129; i += NTHREADS) { const int br = i / 129, st = i % 129, dil = br == 0 ? 1 : (br == 1 ? 4 : 16), n = st * dil; int bucket;
            if (n < 16) bucket = n; else { const float nf = (float)n; int lg = 16 + (int)(logf(nf / 16.f) / logf(128.f) * 16.f); bucket = lg < 31 ? lg : 31; }
#pragma unroll
            for (int h = 0; h < 8; ++h) BT[(br * 8 + h) * 132 + st] = p.rel_bias[bucket * 8 + h]; }
    }
}

template <class RowPtr, class Epi>
__device__ __forceinline__ void wave_gemm_tile(RowPtr arow  , const bf16* brow  , int K, int lane, Epi epi) {
    const int hi = lane >> 5;
    const bf16* ap = arow + 8 * hi; const bf16* bp = brow + 8 * hi;
    f32x16 acc = {};
    for (int k0 = 0; k0 < K; k0 += 16) { const bf16x8 a = *(const bf16x8*)(ap + k0); const bf16x8 b = *(const bf16x8*)(bp + k0); acc = __builtin_amdgcn_mfma_f32_32x32x16_bf16(b, a, acc, 0, 0, 0); }
#pragma unroll
    for (int g = 0; g < 4; ++g) epi(8 * g + 4 * hi, acc[4 * g], acc[4 * g + 1], acc[4 * g + 2], acc[4 * g + 3]);
}

__device__ __forceinline__ void stage_proj_ref(const Params& p, int l, int blk, int nblk, int wv_) {
    const int tid = otid(), lane = tid & 63, wave = tid >> 6, gw = blk * NWAVES + wave, ngw = nblk * NWAVES;
    unsigned char* ws = p.ws;
    const bf16* XB = (const bf16*)(ws + WS_XB); const bf16* WT = (const bf16*)(ws + WS_WT_IN) + (size_t)l * NPROJ * DM; bf16* P = (bf16*)(ws + WS_P);
    constexpr int NT = NPROJ / 32, MT = T / 32;
    for (int tile = gw; tile < MT * NT; tile += ngw) { const int tm = tile / NT, tn = tile % NT; const int m = tm * 32 + (lane & 31);
        wave_gemm_tile(XB + (size_t)m * DM, WT + (size_t)(tn * 32 + (lane & 31)) * DM, DM, lane, [&](int nn, float a, float b, float c, float d) {
            u32x2 o; o.x = pk2(a, b); o.y = pk2(c, d); *(u32x2*)(P + (size_t)m * NPROJ + tn * 32 + nn) = o; }); }
    if (l == 0) {
        const bf16* MB = (const bf16*)(ws + WS_MEMB);
        constexpr int NT2 = 512 / 32, MT2 = NB * NMEM / 32;
        for (int tile = gw; tile < 2 * MT2 * NT2; tile += ngw) { const int ll = tile / (MT2 * NT2), q = tile % (MT2 * NT2), tm = q / NT2, tn = q % NT2; const int m = tm * 32 + (lane & 31);
            const bf16* WK = (const bf16*)(ws + WS_WT_KV) + (size_t)ll * 512 * DM; bf16* KV = (bf16*)(ws + WS_KV) + (size_t)ll * 1024 * 512;
            wave_gemm_tile(MB + (size_t)m * DM, WK + (size_t)(tn * 32 + (lane & 31)) * DM, DM, lane, [&](int nn, float a, float b, float c, float d) {
                u32x2 o; o.x = pk2(a, b); o.y = pk2(c, d); *(u32x2*)(KV + (size_t)m * 512 + tn * 32 + nn) = o; }); }
    }
}

__device__ __forceinline__ float dot64(const bf16* row, const unsigned (&qw)[32]) {
    float s = 0.f;
#pragma unroll
    for (int c = 0; c < 8; ++c) { const u32x4 kv = *(const u32x4*)(row + 8 * c);
        s += bflo(kv.x) * bflo(qw[4 * c]) + bfhi(kv.x) * bfhi(qw[4 * c]); s += bflo(kv.y) * bflo(qw[4 * c + 1]) + bfhi(kv.y) * bfhi(qw[4 * c + 1]);
        s += bflo(kv.z) * bflo(qw[4 * c + 2]) + bfhi(kv.z) * bfhi(qw[4 * c + 2]); s += bflo(kv.w) * bflo(qw[4 * c + 3]) + bfhi(kv.w) * bfhi(qw[4 * c + 3]); }
    return s;
}
__device__ __forceinline__ void stage_attn_ref(const Params& p, int l, int blk, int nblk, int wv_) {
    const int tid = otid(), lane = tid & 63, wave = tid >> 6, gw = blk * NWAVES + wave, ngw = nblk * NWAVES;
    unsigned char* ws = p.ws; const bf16* P = (const bf16*)(ws + WS_P); const float* BT = (const float*)(ws + WS_BIAST);
    bf16* AO = (bf16*)(ws + WS_ATTO); float* LSE = (float*)(ws + WS_LSE);
    for (int task = gw; task < 3 * T * 8; task += ngw) {
        const int br = task / (T * 8), q = task % (T * 8), t = q >> 3, h = q & 7, s = t % SEQ, dil = br == 0 ? 1 : (br == 1 ? 4 : 16);
        unsigned qw[32];
        { const u32x4* qp = (const u32x4*)(P + (size_t)t * NPROJ + C_Q + h * 64);
#pragma unroll
            for (int c = 0; c < 8; ++c) { const u32x4 v = qp[c]; qw[4 * c] = v.x; qw[4 * c + 1] = v.y; qw[4 * c + 2] = v.z; qw[4 * c + 3] = v.w; } }
        float sc[3];
#pragma unroll
        for (int kk = 0; kk < 3; ++kk) { const int st = lane + 64 * kk; const bool valid = st <= 128 && s - st * dil >= 0; sc[kk] = -INFINITY;
            if (valid) sc[kk] = dot64(P + (size_t)(t - st * dil) * NPROJ + C_K + h * 64, qw) + BT[(br * 8 + h) * 132 + st]; }
        const float mx = wave_max(fmaxf(fmaxf(sc[0], sc[1]), sc[2]));
        float pr[3], ls = 0.f;
#pragma unroll
        for (int kk = 0; kk < 3; ++kk) { pr[kk] = __expf(sc[kk] - mx); ls += pr[kk]; }
        ls = wave_sum(ls);
        float o = 0.f;
        const int nst = min(128, s / dil);
        for (int st = 0; st <= nst; ++st) { const float pj = __shfl(st < 64 ? pr[0] : (st < 128 ? pr[1] : pr[2]), st & 63);
            o += pj * bf2f(P[(size_t)(t - st * dil) * NPROJ + C_V + h * 64 + lane]); }
        AO[((size_t)br * T + t) * 512 + h * 64 + lane] = (bf16)f2bf(o / ls);
        if (lane == 0) LSE[((size_t)br * T + t) * 8 + h] = mx + __logf(ls);
    }
}
__device__ __forceinline__ void stage_merge(const Params& p, int blk, int nblk, int wv_) {
    const int tid = otid(), lane = tid & 63, wave = tid >> 6, gw = blk * NWAVES + wave, ngw = nblk * NWAVES;
    unsigned char* ws = p.ws; const bf16* AO = (const bf16*)(ws + WS_ATTO); const float* LSE = (const float*)(ws + WS_LSE); bf16* MIX = (bf16*)(ws + WS_MIX);
    for (int t = gw; t < T; t += ngw) {
        const int h = lane >> 3;
        const float l0 = LSE[((size_t)0 * T + t) * 8 + h], l1 = LSE[((size_t)1 * T + t) * 8 + h], l2 = LSE[((size_t)2 * T + t) * 8 + h];
        const float mx = fmaxf(fmaxf(l0, l1), l2); float w0 = __expf(l0 - mx), w1 = __expf(l1 - mx), w2 = __expf(l2 - mx); const float inv = 1.f / (w0 + w1 + w2); w0 *= inv; w1 *= inv; w2 *= inv;
        const u32x4 a = *(const u32x4*)(AO + ((size_t)0 * T + t) * 512 + lane * 8), b = *(const u32x4*)(AO + ((size_t)1 * T + t) * 512 + lane * 8), c = *(const u32x4*)(AO + ((size_t)2 * T + t) * 512 + lane * 8);
        u32x4 o;
#pragma unroll
        for (int i = 0; i < 4; ++i) o[i] = pk2(w0 * bflo(a[i]) + w1 * bflo(b[i]) + w2 * bflo(c[i]), w0 * bfhi(a[i]) + w1 * bfhi(b[i]) + w2 * bfhi(c[i]));
        *(u32x4*)(MIX + (size_t)t * DM + lane * 8) = o;
    }
}
__device__ __forceinline__ void stage_memattn_ref(const Params& p, int l, int blk, int nblk, int wv_) {
    const int tid = otid(), lane = tid & 63, wave = tid >> 6, gw = blk * NWAVES + wave, ngw = nblk * NWAVES;
    unsigned char* ws = p.ws; const bf16* P = (const bf16*)(ws + WS_P); const bf16* KV = (const bf16*)(ws + WS_KV) + (size_t)l * 1024 * 512; bf16* MIX = (bf16*)(ws + WS_MIX);
    for (int task = gw; task < T * 4; task += ngw) {
        const int t = task >> 2, h = task & 3, b = t / SEQ;
        unsigned qw[32];
        { const u32x4* qp = (const u32x4*)(P + (size_t)t * NPROJ + C_QM + h * 64);
#pragma unroll
            for (int c = 0; c < 8; ++c) { const u32x4 v = qp[c]; qw[4 * c] = v.x; qw[4 * c + 1] = v.y; qw[4 * c + 2] = v.z; qw[4 * c + 3] = v.w; } }
        float sc[4];
#pragma unroll
        for (int kk = 0; kk < 4; ++kk) { const int j = lane + 64 * kk; sc[kk] = dot64(KV + (size_t)(b * NMEM + j) * 512 + h * 64, qw) + p.mem_bias[(l * 4 + h) * NMEM + j]; }
        const float mx = wave_max(fmaxf(fmaxf(sc[0], sc[1]), fmaxf(sc[2], sc[3])));
        float pr[4], ls = 0.f;
#pragma unroll
        for (int kk = 0; kk < 4; ++kk) { pr[kk] = __expf(sc[kk] - mx); ls += pr[kk]; }
        ls = wave_sum(ls);
        float o = 0.f;
        for (int j = 0; j < NMEM; ++j) { const int kk = j >> 6; const float pj = __shfl(kk == 0 ? pr[0] : (kk == 1 ? pr[1] : (kk == 2 ? pr[2] : pr[3])), j & 63);
            o += pj * bf2f(KV[(size_t)(b * NMEM + j) * 512 + 256 + h * 64 + lane]); }
        MIX[(size_t)t * DM + 768 + h * 64 + lane] = (bf16)f2bf(o / ls);
    }
}
__device__ __forceinline__ void stage_conv_ref(const Params& p, int l, int blk, int nblk, int wv_) {
    unsigned char* ws = p.ws; const bf16* P = (const bf16*)(ws + WS_P); float* XC = (float*)(ws + WS_XBCC);
    const float* cw = p.conv_w + (size_t)l * 4 * 768; const float* cb = p.conv_b + (size_t)l * 768;
    for (size_t i = (size_t)blk * NTHREADS + otid(); i < (size_t)T * 768; i += (size_t)nblk * NTHREADS) {
        const int t = (int)(i / 768), c = (int)(i % 768), s = t % SEQ; float a = cb[c];
#pragma unroll
        for (int k = 0; k < 4; ++k) { const int sp = s + k - 3; if (sp >= 0) a += cw[k * 768 + c] * bf2f(P[(size_t)(t + k - 3) * NPROJ + C_XBC + c]); }
        XC[i] = silu_f(a);
    }
}
__device__ __forceinline__ void stage_ssd_ref(const Params& p, int l, int blk, int nblk, int wv_) {
    unsigned char* ws = p.ws; const float* XC = (const float*)(ws + WS_XBCC); const float* DT = (const float*)(ws + WS_DT); float* YS = (float*)(ws + WS_YS);
    const int tid = otid();
    for (int u = blk; u < NB * 4; u += nblk) {
        const int b = u >> 2, h = u & 3, g = h >> 1, pp = tid >> 3, ns = (tid & 7) * 16;
        const float a = -__expf(p.a_log[l * 4 + h]), dtb = p.dt_bias[l * 4 + h], Dh = p.d_skip[l * 4 + h];
        float hst[16];
#pragma unroll
        for (int i = 0; i < 16; ++i) hst[i] = 0.f;
        for (int s = 0; s < SEQ; ++s) { const size_t t = (size_t)b * SEQ + s;
            const float dt = softplus_f(DT[t * 4 + h] + dtb), da = __expf(a * dt);
            const float xv = XC[t * 768 + h * 64 + pp], xd = xv * dt;
            const f32x4* Bp = (const f32x4*)(XC + t * 768 + 256 + g * 128 + ns); const f32x4* Cp = (const f32x4*)(XC + t * 768 + 512 + g * 128 + ns);
            float acc = 0.f;
#pragma unroll
            for (int i4 = 0; i4 < 4; ++i4) { const f32x4 bv = Bp[i4], cv = Cp[i4];
#pragma unroll
                for (int c = 0; c < 4; ++c) { float& hh = hst[4 * i4 + c]; hh = hh * da + xd * bv[c]; acc += cv[c] * hh; } }
            acc += __shfl_xor(acc, 1); acc += __shfl_xor(acc, 2); acc += __shfl_xor(acc, 4);
            if ((tid & 7) == 0) YS[t * 256 + h * 64 + pp] = acc + Dh * xv;
        }
    }
}
__device__ __forceinline__ void stage_gate_ref(const Params& p, int l, int blk, int nblk, int wv_) {
    const int tid = otid(), lane = tid & 63, wave = tid >> 6, gw = blk * NWAVES + wave, ngw = nblk * NWAVES;
    unsigned char* ws = p.ws; const bf16* P = (const bf16*)(ws + WS_P); const float* YS = (const float*)(ws + WS_YS); bf16* MIX = (bf16*)(ws + WS_MIX);
    const f32x4 nw = *(const f32x4*)(p.ssd_norm_w + l * 256 + 4 * lane);
    for (int t = gw; t < T; t += ngw) {
        f32x4 y = *(const f32x4*)(YS + (size_t)t * 256 + 4 * lane); const u32x2 zw = *(const u32x2*)(P + (size_t)t * NPROJ + C_Z + 4 * lane);
        y.x *= silu_f(bflo(zw.x)); y.y *= silu_f(bfhi(zw.x)); y.z *= silu_f(bflo(zw.y)); y.w *= silu_f(bfhi(zw.y));
        const float ms = wave_sum(y.x * y.x + y.y * y.y + y.z * y.z + y.w * y.w) * (1.f / 256.f); const float r = 1.f / sqrtf(ms + RMS_EPS);
        u32x2 o; o.x = pk2(y.x * r * nw.x, y.y * r * nw.y); o.y = pk2(y.z * r * nw.z, y.w * r * nw.w);
        *(u32x2*)(MIX + (size_t)t * DM + 512 + 4 * lane) = o;
    }
}
__device__ __forceinline__ void stage_out_ref(const Params& p, int l, int blk, int nblk, int wv_) {
    const int tid = otid(), lane = tid & 63, wave = tid >> 6, gw = blk * NWAVES + wave, ngw = nblk * NWAVES;
    unsigned char* ws = p.ws; const bf16* MIX = (const bf16*)(ws + WS_MIX); const bf16* WT = (const bf16*)(ws + WS_WT_OUT) + (size_t)l * DM * DM;
    const float* xin = l == 0 ? p.x : p.out; float* out = p.out;
    constexpr int NT = DM / 32, MT = T / 32;
    for (int tile = gw; tile < MT * NT; tile += ngw) { const int tm = tile / NT, tn = tile % NT; const int m = tm * 32 + (lane & 31);
        wave_gemm_tile(MIX + (size_t)m * DM, WT + (size_t)(tn * 32 + (lane & 31)) * DM, DM, lane, [&](int nn, float a, float b, float c, float d) {
            const size_t off = (size_t)m * DM + tn * 32 + nn; const f32x4 xv = *(const f32x4*)(xin + off);
            *(f32x4*)(out + off) = (f32x4){ALPHA * xv.x + a, ALPHA * xv.y + b, ALPHA * xv.z + c, ALPHA * xv.w + d}; }); }
}

__device__ __forceinline__ void ln_row(f32x4 (&v)[4], const float* g, const float* bta, int lane) {
    float s = 0.f;
#pragma unroll
    for (int j = 0; j < 4; ++j) s += (v[j].x + v[j].y) + (v[j].z + v[j].w);
    const float mean = wave_sum(s) * (1.f / DM); float s2 = 0.f;
#pragma unroll
    for (int j = 0; j < 4; ++j) { v[j] = v[j] - mean; s2 += (v[j].x * v[j].x + v[j].y * v[j].y) + (v[j].z * v[j].z + v[j].w * v[j].w); }
    const float rstd = 1.f / sqrtf(wave_sum(s2) * (1.f / DM) + LN_EPS);
#pragma unroll
    for (int j = 0; j < 4; ++j) { const f32x4 gg = *((const f32x4*)g + lane + 64 * j), bb = *((const f32x4*)bta + lane + 64 * j); v[j] = v[j] * rstd * gg + bb; }
}
__device__ __forceinline__ void stage_ln1_router(const Params& p, int l, int blk, int nblk, int wv_) {
    const int tid = otid(), lane = tid & 63, wave = tid >> 6, gw = blk * NWAVES + wave, ngw = nblk * NWAVES;
    unsigned char* ws = p.ws; bf16* XB = (bf16*)(ws + WS_XB); unsigned* cnt = (unsigned*)(ws + WS_CTL) + CW_CNT + l * 16;
    int* TOKE = (int*)(ws + WS_TOKE); int* TOKP = (int*)(ws + WS_TOKP); float* TOKW = (float*)(ws + WS_TOKW); int* LIST = (int*)(ws + WS_LIST);
    for (int t = gw; t < T; t += ngw) {
        asm volatile("" ::: "memory");
        f32x4 v[4]; f32x4* xr = (f32x4*)(p.out + (size_t)t * DM) + lane;
#pragma unroll
        for (int j = 0; j < 4; ++j) v[j] = xr[64 * j];
        ln_row(v, p.ln1_g + l * DM, p.ln1_b + l * DM, lane);
        float lg[16];
#pragma unroll
        for (int e = 0; e < 16; ++e) lg[e] = 0.f;
#pragma unroll
        for (int j = 0; j < 4; ++j) { xr[64 * j] = v[j]; u32x2 o; o.x = pk2(v[j].x, v[j].y); o.y = pk2(v[j].z, v[j].w); *((u32x2*)(XB + (size_t)t * DM) + lane + 64 * j) = o;
#pragma unroll
            for (int c = 0; c < 4; ++c) { const int k = 4 * lane + 256 * j + c; const float xv = v[j][c]; const f32x4* wr = (const f32x4*)(p.w_router + (size_t)k * 16);
#pragma unroll
                for (int q = 0; q < 4; ++q) { const f32x4 w = wr[q]; lg[4 * q] += xv * w.x; lg[4 * q + 1] += xv * w.y; lg[4 * q + 2] += xv * w.z; lg[4 * q + 3] += xv * w.w; } } }
        float mx = -INFINITY;
#pragma unroll
        for (int e = 0; e < 16; ++e) { lg[e] = wave_sum(lg[e]) + p.b_router[e]; mx = fmaxf(mx, lg[e]); }
        float sum = 0.f;
#pragma unroll
        for (int e = 0; e < 16; ++e) { lg[e] = __expf(lg[e] - mx); sum += lg[e]; }
        const float inv = 1.f / sum;
#pragma unroll
        for (int e = 0; e < 16; ++e) lg[e] *= inv;
        int best = 0; float bs = -1.f;
#pragma unroll
        for (int g = 0; g < 4; ++g) { const float a = lg[4 * g], b = lg[4 * g + 1], c = lg[4 * g + 2], d = lg[4 * g + 3];
            const float h1 = fmaxf(a, b), l1 = fminf(a, b), h2 = fmaxf(c, d), l2 = fminf(c, d); const float gs = fmaxf(h1, h2) + fmaxf(fminf(h1, h2), fmaxf(l1, l2));
            if (gs > bs) { bs = gs; best = g; } }
        const float c0 = best == 0 ? lg[0] : (best == 1 ? lg[4] : (best == 2 ? lg[8] : lg[12]));
        const float c1 = best == 0 ? lg[1] : (best == 1 ? lg[5] : (best == 2 ? lg[9] : lg[13]));
        const float c2 = best == 0 ? lg[2] : (best == 1 ? lg[6] : (best == 2 ? lg[10] : lg[14]));
        const float c3 = best == 0 ? lg[3] : (best == 1 ? lg[7] : (best == 2 ? lg[11] : lg[15]));
        int i1 = 0; float s1 = c0; if (c1 > s1) { s1 = c1; i1 = 1; } if (c2 > s1) { s1 = c2; i1 = 2; } if (c3 > s1) { s1 = c3; i1 = 3; }
        int i2 = -1; float s2 = -1.f;
        if (i1 != 0 && c0 > s2) { s2 = c0; i2 = 0; } if (i1 != 1 && c1 > s2) { s2 = c1; i2 = 1; } if (i1 != 2 && c2 > s2) { s2 = c2; i2 = 2; } if (i1 != 3 && c3 > s2) { s2 = c3; i2 = 3; }
        if (lane == 0) { const int e1 = best * 4 + i1, e2 = best * 4 + i2; const float ws_ = 1.f / (s1 + s2);
            const int p1 = (int)atomicAdd(cnt + e1, 1u), p2 = (int)atomicAdd(cnt + e2, 1u);
            LIST[e1 * T + p1] = t; LIST[e2 * T + p2] = t;
            TOKE[2 * t] = e1; TOKE[2 * t + 1] = e2; TOKP[2 * t] = p1; TOKP[2 * t + 1] = p2; TOKW[2 * t] = s1 * ws_; TOKW[2 * t + 1] = s2 * ws_; }
    }
}
__device__ __forceinline__ void stage_moe1_ref(const Params& p, int l, int blk, int nblk, int wv_) {
    const int tid = otid(), lane = tid & 63, wave = tid >> 6, gw = blk * NWAVES + wave, ngw = nblk * NWAVES;
    unsigned char* ws = p.ws; const bf16* XB = (const bf16*)(ws + WS_XB); const unsigned* cnt = (const unsigned*)(ws + WS_CTL) + CW_CNT + l * 16; const int* LIST = (const int*)(ws + WS_LIST);
    bf16* H = (bf16*)(ws + WS_H);
    int total = 0;
    for (int e = 0; e < NE; ++e) total += (int)((cnt[e] + 255u) >> 8) * 256;
    const int ntask = (total / 32) * 32;
    for (int task = gw; task < ntask; task += ngw) { const int rt = task >> 5, ct = task & 31; const int row0 = rt * 32;
        int e = 0, base = 0;
        for (int q = 0; q < NE; ++q) { const int sz = (int)((cnt[q] + 255u) >> 8) * 256; if (row0 >= base + sz) { base += sz; e = q + 1; } else break; }
        const int i = row0 + (lane & 31) - base; const int tok = i < (int)cnt[e] ? LIST[e * T + i] : 0;
        const bf16* WG = (const bf16*)(ws + WS_WT_GU) + (size_t)(l * 16 + e) * 2048 * DM; const int c0 = ct * 32, pn = c0 >> 7, j0 = c0 & 127;
        const int hi = lane >> 5;
        const bf16* ap = XB + (size_t)tok * DM + 8 * hi; const bf16* gp = WG + (size_t)(256 * pn + j0 + (lane & 31)) * DM + 8 * hi; const bf16* up = gp + (size_t)128 * DM;
        f32x16 ag = {}, au = {};
        for (int k0 = 0; k0 < DM; k0 += 16) { const bf16x8 a = *(const bf16x8*)(ap + k0); ag = __builtin_amdgcn_mfma_f32_32x32x16_bf16(*(const bf16x8*)(gp + k0), a, ag, 0, 0, 0); au = __builtin_amdgcn_mfma_f32_32x32x16_bf16(*(const bf16x8*)(up + k0), a, au, 0, 0, 0); }
        const int row = row0 + (lane & 31);
#pragma unroll
        for (int g = 0; g < 4; ++g) { u32x2 o; o.x = pk2(silu_f(ag[4 * g]) * au[4 * g], silu_f(ag[4 * g + 1]) * au[4 * g + 1]); o.y = pk2(silu_f(ag[4 * g + 2]) * au[4 * g + 2], silu_f(ag[4 * g + 3]) * au[4 * g + 3]);
            *(u32x2*)(H + (size_t)row * DM + c0 + 8 * g + 4 * hi) = o; }
    }
}
__device__ __forceinline__ void stage_moe2_ref(const Params& p, int l, int blk, int nblk, int wv_) {
    const int tid = otid(), lane = tid & 63, wave = tid >> 6, gw = blk * NWAVES + wave, ngw = nblk * NWAVES;
    unsigned char* ws = p.ws; const unsigned* cnt = (const unsigned*)(ws + WS_CTL) + CW_CNT + l * 16; const bf16* H = (const bf16*)(ws + WS_H); bf16* Y = (bf16*)(ws + WS_Y);
    int total = 0;
    for (int e = 0; e < NE; ++e) total += (int)((cnt[e] + 255u) >> 8) * 256;
    const int ntask = (total / 32) * 32;
    for (int task = gw; task < ntask; task += ngw) { const int rt = task >> 5, ct = task & 31; const int row0 = rt * 32;
        int e = 0, base = 0;
        for (int q = 0; q < NE; ++q) { const int sz = (int)((cnt[q] + 255u) >> 8) * 256; if (row0 >= base + sz) { base += sz; e = q + 1; } else break; }
        const bf16* WD = (const bf16*)(ws + WS_WT_DN) + (size_t)(l * 16 + e) * DM * DM; const int row = row0 + (lane & 31);
        wave_gemm_tile(H + (size_t)row * DM, WD + (size_t)(ct * 32 + (lane & 31)) * DM, DM, lane, [&](int nn, float a, float b, float c, float d) {
            u32x2 o; o.x = pk2(a, b); o.y = pk2(c, d); *(u32x2*)(Y + (size_t)row * DM + ct * 32 + nn) = o; });
    }
}
__device__ __forceinline__ void stage_ln2(const Params& p, int l, int blk, int nblk, int wv_) {
    const int tid = otid(), lane = tid & 63, wave = tid >> 6, gw = blk * NWAVES + wave, ngw = nblk * NWAVES;
    unsigned char* ws = p.ws; bf16* XB = (bf16*)(ws + WS_XB); const unsigned* cnt = (const unsigned*)(ws + WS_CTL) + CW_CNT + l * 16; const bf16* Y = (const bf16*)(ws + WS_Y);
    const int* TOKE = (const int*)(ws + WS_TOKE); const int* TOKP = (const int*)(ws + WS_TOKP); const float* TOKW = (const float*)(ws + WS_TOKW); float* DT = (float*)(ws + WS_DT);
    for (int t = gw; t < T; t += ngw) {
        asm volatile("" ::: "memory");
        const int e1 = TOKE[2 * t], e2 = TOKE[2 * t + 1]; int r1 = TOKP[2 * t], r2 = TOKP[2 * t + 1]; const float w1 = TOKW[2 * t], w2 = TOKW[2 * t + 1];
        for (int e = 0; e < NE; ++e) { const int sz = (int)((cnt[e] + 255u) >> 8) * 256; if (e < e1) r1 += sz; if (e < e2) r2 += sz; }
        f32x4 v[4]; f32x4* xr = (f32x4*)(p.out + (size_t)t * DM) + lane;
#pragma unroll
        for (int j = 0; j < 4; ++j) { const f32x4 xv = xr[64 * j]; const u32x2 a = *((const u32x2*)(Y + (size_t)r1 * DM) + lane + 64 * j), b = *((const u32x2*)(Y + (size_t)r2 * DM) + lane + 64 * j);
            v[j].x = ALPHA * xv.x + (w1 * bflo(a.x) + w2 * bflo(b.x)); v[j].y = ALPHA * xv.y + (w1 * bfhi(a.x) + w2 * bfhi(b.x));
            v[j].z = ALPHA * xv.z + (w1 * bflo(a.y) + w2 * bflo(b.y)); v[j].w = ALPHA * xv.w + (w1 * bfhi(a.y) + w2 * bfhi(b.y)); }
        ln_row(v, p.ln2_g + l * DM, p.ln2_b + l * DM, lane);
        float d0 = 0.f, d1 = 0.f, d2 = 0.f, d3 = 0.f;
#pragma unroll
        for (int j = 0; j < 4; ++j) { xr[64 * j] = v[j];
            if (l + 1 < DEPTH) { u32x2 o; o.x = pk2(v[j].x, v[j].y); o.y = pk2(v[j].z, v[j].w); *((u32x2*)(XB + (size_t)t * DM) + lane + 64 * j) = o;
#pragma unroll
                for (int c = 0; c < 4; ++c) { const int k = 4 * lane + 256 * j + c; const f32x4 w = *(const f32x4*)(p.w_in + ((size_t)(l + 1) * DM + k) * NCOLS_IN + 2560); const float xv = v[j][c];
                    d0 += xv * w.x; d1 += xv * w.y; d2 += xv * w.z; d3 += xv * w.w; } } }
        if (l + 1 < DEPTH) { d0 = wave_sum(d0); d1 = wave_sum(d1); d2 = wave_sum(d2); d3 = wave_sum(d3); if (lane == 0) *(f32x4*)(DT + (size_t)t * 4) = (f32x4){d0, d1, d2, d3}; }
    }
}


namespace pg8 {
constexpr int BM = 256, BK = 64, HALF = 128, HTB = HALF * BK * 2  , STAGE_BYTES = 8 * HTB;
__host__ __device__ __forceinline__ int lds_byte(int r, int c) { const int st = (r >> 4) * 2 + (c >> 5), rr = r & 15, cc = c & 31, ob = rr * 64 + cc * 2; return st * 1024 + (ob ^ (((ob >> 9) & 1) << 5)); }
__host__ __device__ __forceinline__ void stage_rc(int b, int& R, int& C) { const int st = b / 1024, sb = b % 1024, swz = sb ^ (((sb >> 9) & 1) << 5); R = (st >> 1) * 16 + swz / 64; C = (st & 1) * 32 + (swz % 64) / 2; }
__host__ __device__ __forceinline__ int perm32(int rho) { const int n = rho >> 4, i = rho & 15; return 8 * (i >> 2) + 4 * n + (i & 3); }
struct Unit { int pm, pn, cn; };
struct Gemm { const bf16* A; const bf16* Bt; int K; };

__device__ __forceinline__ unsigned cvt_pk_bf16(float lo, float hi) { unsigned r; asm volatile("v_cvt_pk_bf16_f32 %0, %1, %2" : "=v"(r) : "v"(lo), "v"(hi)); return r; }

struct EpiBf16 {
    static constexpr bool PERM = true;
    bf16* O; int ldc; int split_cols; size_t split_stride;
    __device__ __forceinline__ void operator()(const f32x4 (&acc)[2][2][4][2], const Unit& u, int wr, int wc, int fr, int fq) const {
        const int row0 = u.pm * BM + wr * 64 + fr; int colt = u.cn * BM; bf16* base = O;
        if (split_cols) { const int t = colt / split_cols; base += (size_t)t * split_stride; colt -= t * split_cols; }
        const int col0 = colt + wc * 32 + 8 * fq;
#pragma unroll
        for (int ai = 0; ai < 2; ++ai)
#pragma unroll
            for (int m = 0; m < 4; ++m) { bf16* rowp = base + (size_t)(row0 + ai * HALF + m * 16) * ldc + col0;
#pragma unroll
                for (int bj = 0; bj < 2; ++bj) { const f32x4 v0 = acc[ai][bj][m][0], v1 = acc[ai][bj][m][1];
                    u32x4 w; w.x = cvt_pk_bf16(v0[0], v0[1]); w.y = cvt_pk_bf16(v0[2], v0[3]); w.z = cvt_pk_bf16(v1[0], v1[1]); w.w = cvt_pk_bf16(v1[2], v1[3]);
                    *(u32x4*)(rowp + bj * HALF) = w; } }
    }
};
struct EpiSwiGLU {
    static constexpr bool PERM = true;
    bf16* O; int ldc;
    __device__ __forceinline__ void operator()(const f32x4 (&acc)[2][2][4][2], const Unit& u, int wr, int wc, int fr, int fq) const {
        const int row0 = u.pm * BM + wr * 64 + fr; const int col0 = u.cn * HALF + wc * 32 + 8 * fq;
#pragma unroll
        for (int ai = 0; ai < 2; ++ai)
#pragma unroll
            for (int m = 0; m < 4; ++m) { float h[8];
#pragma unroll
                for (int n = 0; n < 2; ++n)
#pragma unroll
                    for (int c = 0; c < 4; ++c) { const float g = acc[ai][0][m][n][c], uu = acc[ai][1][m][n][c]; h[4 * n + c] = g * __builtin_amdgcn_rcpf(1.f + __expf(-g)) * uu; }
                u32x4 w; w.x = cvt_pk_bf16(h[0], h[1]); w.y = cvt_pk_bf16(h[2], h[3]); w.z = cvt_pk_bf16(h[4], h[5]); w.w = cvt_pk_bf16(h[6], h[7]);
                *(u32x4*)(O + (size_t)(row0 + ai * HALF + m * 16) * ldc + col0) = w; }
    }
};
struct EpiResF32 {
    static constexpr bool PERM = false;
    const float* base; float* out; int ldc; float alpha;
    __device__ __forceinline__ void operator()(const f32x4 (&acc)[2][2][4][2], const Unit& u, int wr, int wc, int fr, int fq) const {
        const int row0 = u.pm * BM + wr * 64 + fr; const int col0 = u.cn * BM + wc * 32 + 4 * fq;
#pragma unroll
        for (int ai = 0; ai < 2; ++ai)
#pragma unroll
            for (int m = 0; m < 4; ++m) { const size_t off = (size_t)(row0 + ai * HALF + m * 16) * ldc + col0;
#pragma unroll
                for (int bj = 0; bj < 2; ++bj)
#pragma unroll
                    for (int n = 0; n < 2; ++n) { const f32x4 bs = *(const f32x4*)(base + off + bj * HALF + n * 16); *(f32x4*)(out + off + bj * HALF + n * 16) = bs * alpha + acc[ai][bj][m][n]; } }
    }
};

template <class Epi, class Sched, bool GATHER>
__device__ __forceinline__ void gemm_phase(LAS unsigned char* lds, const Gemm g, const Sched& S, const Epi& E, const LAS int* gtab, int wv_) {
    const int tid = otid(), wid = __builtin_amdgcn_readfirstlane(tid >> 6), lane = tid & 63, wr = wid >> 2, wc = wid & 3, fr = lane & 15, fq = lane >> 4;
    const int K = g.K, nt = K / BK;
    unsigned voffA[2], voffB[2]; int RA[2], CA[2];
#pragma unroll
    for (int i = 0; i < 2; ++i) { int R, C; stage_rc(tid * 16 + i * 8192, R, C); const int Rb = Epi::PERM ? ((R & ~31) + perm32(R & 31)) : R; RA[i] = R; CA[i] = C;
        voffA[i] = (unsigned)(R * K + C) * 2u; voffB[i] = (unsigned)(Rb * K + C) * 2u; }
    const size_t kstep = (size_t)(BK * 2);
    const size_t hstep = (size_t)HALF * K * 2;
    const size_t tstep = 2 * hstep;
    const unsigned ldsw = (unsigned)wid * 1024u;
    const int aoff = lds_byte(wr * 64 + fr, fq * 8), boff = lds_byte(wc * 32 + fr, fq * 8);
#define PG8_SA(b, h) (((b) * 2 + (h)) * HTB)
#define PG8_SB(b, h) ((4 + (b) * 2 + (h)) * HTB)
#define PG8_STAGE(bufoff, gbase, voff) do { _Pragma("unroll") for (int _i = 0; _i < 2; ++_i) \
        __builtin_amdgcn_global_load_lds((const unsigned*)((const char*)(gbase) + (voff)[_i]), (LAS unsigned*)(lds + (bufoff) + ldsw + _i * 8192), 16, 0, 0); } while (0)
#define PG8_STAGE_A(bufoff, pbase, gbase, h, vo) do { if constexpr (GATHER) { PG8_STAGE(bufoff, gbase, (vo)[h]); } else { PG8_STAGE(bufoff, (pbase) + (h) * hstep, voffA); } } while (0)
#define PG8_LDA(dst, b, h) do { _Pragma("unroll") for (int m = 0; m < 4; ++m) _Pragma("unroll") for (int k = 0; k < 2; ++k) dst[m][k] = *(const LAS bf16x8*)(lds + PG8_SA(b, h) + aoff + m * 2048 + k * 1024); } while (0)
#define PG8_LDB(dst, b, h) do { _Pragma("unroll") for (int n = 0; n < 2; ++n) _Pragma("unroll") for (int k = 0; k < 2; ++k) dst[n][k] = *(const LAS bf16x8*)(lds + PG8_SB(b, h) + boff + n * 2048 + k * 1024); } while (0)
#define PG8_MMA(ai, bj, At, Bt) do { __builtin_amdgcn_s_setprio(1); _Pragma("unroll") for (int m = 0; m < 4; ++m) _Pragma("unroll") for (int n = 0; n < 2; ++n) _Pragma("unroll") for (int k = 0; k < 2; ++k) \
        acc[ai][bj][m][n] = __builtin_amdgcn_mfma_f32_16x16x32_bf16(Bt[n][k], At[m][k], acc[ai][bj][m][n], 0, 0, 0); __builtin_amdgcn_s_setprio(0); } while (0)
#define PG8_WAIT_V(n) asm volatile("s_waitcnt vmcnt(" #n ")" ::: "memory")
#define PG8_WAIT_L(n) asm volatile("s_waitcnt lgkmcnt(" #n ")" ::: "memory")
#define PG8_BAR __builtin_amdgcn_s_barrier()
#define PG8_SCHED __builtin_amdgcn_sched_barrier(0)
#define PG8_GVO(dst, ui_) do { _Pragma("unroll") for (int _h = 0; _h < 2; ++_h) _Pragma("unroll") for (int _i = 0; _i < 2; ++_i) \
        dst[_h][_i] = (unsigned)gtab[(ui_) * 256 + _h * HALF + RA[_i]] * (unsigned)(K * 2) + (unsigned)(CA[_i] * 2); } while (0)
    Unit cur, nxt; int ui = 0;
    if (!S.next(0, cur)) return;
    f32x4 acc[2][2][4][2];
#pragma unroll
    for (int a = 0; a < 2; ++a)
#pragma unroll
        for (int b = 0; b < 2; ++b)
#pragma unroll
            for (int m = 0; m < 4; ++m)
#pragma unroll
                for (int n = 0; n < 2; ++n) acc[a][b][m][n] = (f32x4){0.f, 0.f, 0.f, 0.f};
    bf16x8 At[4][2], B0[2][2], B1[2][2];
    unsigned voC[2][2], voN[2][2];
    if constexpr (GATHER) { PG8_GVO(voC, 0); PG8_WAIT_L(0); }
    const char* gA = (const char*)g.A;
    const char* cA = GATHER ? gA : gA + (size_t)cur.pm * tstep; const char* cB = (const char*)g.Bt + (size_t)cur.pn * tstep;
    PG8_STAGE(PG8_SB(0, 0), cB, voffB); PG8_STAGE(PG8_SB(0, 1), cB + hstep, voffB); PG8_STAGE_A(PG8_SA(0, 0), cA, cA, 0, voC); PG8_STAGE_A(PG8_SA(0, 1), cA, cA, 1, voC);
    if (wr == 1) PG8_BAR;
    PG8_WAIT_V(2); PG8_BAR;
    PG8_STAGE(PG8_SB(1, 0), cB + kstep, voffB); PG8_STAGE_A(PG8_SA(1, 0), cA + kstep, cA + kstep, 0, voC); PG8_STAGE(PG8_SB(1, 1), cB + hstep + kstep, voffB);
    PG8_WAIT_V(6); PG8_BAR;
    for (;;) {
        const bool has_next = S.next(ui + 1, nxt);
        const char* nA = (has_next && !GATHER) ? gA + (size_t)nxt.pm * tstep : cA; const char* nB = has_next ? (const char*)g.Bt + (size_t)nxt.pn * tstep : cB;
        if constexpr (GATHER) { if (has_next) { PG8_GVO(voN, ui + 1); } else {
#pragma unroll
            for (int _h = 0; _h < 2; ++_h)
#pragma unroll
                for (int _i = 0; _i < 2; ++_i) voN[_h][_i] = voC[_h][_i]; } }
        for (int t = 0; t < nt; t += 2) {
            const bool last = (t == nt - 2);
            const char* a1 = cA + (size_t)(t + 1) * kstep;
            const char* a2 = last ? nA : cA + (size_t)(t + 2) * kstep; const char* b2 = last ? nB : cB + (size_t)(t + 2) * kstep;
            const char* a3 = a2 + kstep; const char* b3 = b2 + kstep;
            unsigned vs[2][2];
            if constexpr (GATHER) {
#pragma unroll
                for (int _h = 0; _h < 2; ++_h)
#pragma unroll
                    for (int _i = 0; _i < 2; ++_i) vs[_h][_i] = last ? voN[_h][_i] : voC[_h][_i]; }
            PG8_LDB(B0, 0, 0); PG8_LDB(B1, 0, 1); PG8_SCHED; PG8_LDA(At, 0, 0); PG8_STAGE_A(PG8_SA(1, 1), a1, a1, 1, voC);
            PG8_WAIT_V(8); PG8_WAIT_L(0); PG8_BAR; PG8_MMA(0, 0, At, B0); PG8_MMA(0, 1, At, B1); PG8_BAR; PG8_SCHED;
            PG8_LDA(At, 0, 1); PG8_STAGE(PG8_SB(0, 0), b2, voffB); PG8_STAGE(PG8_SB(0, 1), b2 + hstep, voffB); PG8_STAGE_A(PG8_SA(0, 0), a2, a2, 0, vs);
            PG8_WAIT_V(8); PG8_WAIT_L(0); PG8_BAR; PG8_MMA(1, 0, At, B0); PG8_MMA(1, 1, At, B1); PG8_BAR; PG8_SCHED;
            PG8_LDB(B0, 1, 0); PG8_LDB(B1, 1, 1); PG8_SCHED; PG8_LDA(At, 1, 0); PG8_STAGE_A(PG8_SA(0, 1), a2, a2, 1, vs);
            PG8_WAIT_V(8); PG8_WAIT_L(0); PG8_BAR; PG8_MMA(0, 0, At, B0); PG8_MMA(0, 1, At, B1); PG8_BAR; PG8_SCHED;
            PG8_LDA(At, 1, 1); PG8_STAGE(PG8_SB(1, 0), b3, voffB); PG8_STAGE(PG8_SB(1, 1), b3 + hstep, voffB); PG8_STAGE_A(PG8_SA(1, 0), a3, a3, 0, vs);
            PG8_WAIT_V(8); PG8_WAIT_L(0); PG8_BAR; PG8_MMA(1, 0, At, B0); PG8_MMA(1, 1, At, B1); PG8_BAR; PG8_SCHED;
        }
        if (wr == 0) PG8_BAR;
        E(acc, cur, wr, wc, fr, fq);
        if (!has_next) break;
#pragma unroll
        for (int a = 0; a < 2; ++a)
#pragma unroll
            for (int b = 0; b < 2; ++b)
#pragma unroll
                for (int m = 0; m < 4; ++m)
#pragma unroll
                    for (int n = 0; n < 2; ++n) acc[a][b][m][n] = (f32x4){0.f, 0.f, 0.f, 0.f};
        cur = nxt; cA = nA; cB = nB; ++ui;
        if constexpr (GATHER) {
#pragma unroll
            for (int _h = 0; _h < 2; ++_h)
#pragma unroll
                for (int _i = 0; _i < 2; ++_i) voC[_h][_i] = voN[_h][_i]; }
        if (wr == 1) PG8_BAR;
    }
    PG8_WAIT_V(0);
    PG8_BAR;
#undef PG8_SA
#undef PG8_SB
#undef PG8_STAGE
#undef PG8_STAGE_A
#undef PG8_LDA
#undef PG8_LDB
#undef PG8_MMA
#undef PG8_WAIT_V
#undef PG8_WAIT_L
#undef PG8_BAR
#undef PG8_SCHED
#undef PG8_GVO
}
struct GridOrder {
    int nMx, nN, x, j, W;
    __device__ __forceinline__ void init(int nM, int nN_, int G, int c) { nMx = nM / 8; nN = nN_; x = c & 7; j = c >> 3; W = (G - x + 7) >> 3; }
    __device__ __forceinline__ bool next(int i, Unit& u) const { const int L = i * W + j; if (L >= nMx * nN) return false; u.pm = x * nMx + L % nMx; u.pn = L / nMx; u.cn = u.pn; return true; }
};
struct ListOrder {
    int first, n, nN;
    __device__ __forceinline__ bool next(int i, Unit& u) const { if (i > 0 || first < 0 || first >= n) return false; u.pm = first / nN; u.pn = first % nN; u.cn = u.pn; return true; }
};
struct MoeOrder {
    int pe[16]; int nC, t0, t1, j, W;
    __device__ __forceinline__ void init(const unsigned* cnt, int nC_, int G, int c) { int a = 0;
#pragma unroll
        for (int e = 0; e < 16; ++e) { a += (int)((__builtin_amdgcn_readfirstlane(cnt[e]) + 255u) >> 8); pe[e] = a; }
        const int x = c & 7; nC = nC_; j = c >> 3; W = (G - x + 7) >> 3; t0 = (x * a) >> 3; t1 = ((x + 1) * a) >> 3; }
    __device__ __forceinline__ void expert_of(int rt, int& e, int& start) const { e = 0; start = 0;
#pragma unroll
        for (int q = 0; q < 16; ++q) if (rt >= pe[q]) { e = q + 1; start = pe[q]; } }
    __device__ __forceinline__ bool next(int i, Unit& u) const { const int L = i * W + j; const int rt = t0 + L / nC, cl = L % nC; if (rt >= t1) return false;
        int e, st; expert_of(rt, e, st); u.pm = rt; u.pn = e * nC + cl; u.cn = cl; return true; }
};
}

constexpr int GTAB_OFF = 131072 + 1024;
__device__ __forceinline__ void stage_proj(const Params& p, LAS unsigned char* lds, int l, int blk, int nblk, int wv_) {
    unsigned char* ws = p.ws;
    { pg8::Gemm g{(const bf16*)(ws + WS_XB), (const bf16*)(ws + WS_WT_IN) + (size_t)l * NPROJ * DM, DM}; pg8::GridOrder S; S.init(T / 256, NPROJ / 256, nblk, blk);
      pg8::EpiBf16 E{(bf16*)(ws + WS_P), NPROJ, 0, 0};
      pg8::gemm_phase<pg8::EpiBf16, pg8::GridOrder, false>(lds, g, S, E, nullptr, wv_); }
    if (l == 0) {
        pg8::Gemm g{(const bf16*)(ws + WS_MEMB), (const bf16*)(ws + WS_WT_KV), DM}; pg8::ListOrder S{nblk >= 208 ? blk - 192 : blk, 16, 4};
        pg8::EpiBf16 E{(bf16*)(ws + WS_KV), 512, 512, (size_t)1024 * 512};
        pg8::gemm_phase<pg8::EpiBf16, pg8::ListOrder, false>(lds, g, S, E, nullptr, wv_); }
}
__device__ __forceinline__ void stage_out(const Params& p, LAS unsigned char* lds, int l, int blk, int nblk, int wv_) {
    unsigned char* ws = p.ws;
    pg8::Gemm g{(const bf16*)(ws + WS_MIX), (const bf16*)(ws + WS_WT_OUT) + (size_t)l * DM * DM, DM}; pg8::GridOrder S; S.init(T / 256, DM / 256, nblk, blk);
    pg8::EpiResF32 E{l == 0 ? p.x : p.out, p.out, DM, ALPHA};
    pg8::gemm_phase<pg8::EpiResF32, pg8::GridOrder, false>(lds, g, S, E, nullptr, wv_);
}
__device__ __forceinline__ void stage_moe1(const Params& p, LAS unsigned char* lds, int l, int blk, int nblk, int wv_) {
    unsigned char* ws = p.ws; const unsigned* cnt = (const unsigned*)(ws + WS_CTL) + CW_CNT + l * 16; const int* LIST = (const int*)(ws + WS_LIST);
    pg8::MoeOrder S; S.init(cnt, 8, nblk, blk);
    LAS int* gtab = (LAS int*)(lds + GTAB_OFF);
    { pg8::Unit u; const int tid = otid();
      for (int i = 0; i < 12 && S.next(i, u); ++i) if (tid < 256) { int e, st; S.expert_of(u.pm, e, st); const int pos = (u.pm - st) * 256 + tid; gtab[i * 256 + tid] = pos < (int)cnt[e] ? LIST[e * T + pos] : 0; }
      __syncthreads(); }
    pg8::Gemm g{(const bf16*)(ws + WS_XB), (const bf16*)(ws + WS_WT_GU) + (size_t)l * 16 * 2048 * DM, DM};
    pg8::EpiSwiGLU E{(bf16*)(ws + WS_H), DM};
    pg8::gemm_phase<pg8::EpiSwiGLU, pg8::MoeOrder, true>(lds, g, S, E, gtab, wv_);
}
__device__ __forceinline__ void stage_moe2(const Params& p, LAS unsigned char* lds, int l, int blk, int nblk, int wv_) {
    unsigned char* ws = p.ws; const unsigned* cnt = (const unsigned*)(ws + WS_CTL) + CW_CNT + l * 16;
    pg8::MoeOrder S; S.init(cnt, 4, nblk, blk);
    pg8::Gemm g{(const bf16*)(ws + WS_H), (const bf16*)(ws + WS_WT_DN) + (size_t)l * 16 * DM * DM, DM};
    pg8::EpiBf16 E{(bf16*)(ws + WS_Y), DM, 0, 0};
    pg8::gemm_phase<pg8::EpiBf16, pg8::MoeOrder, false>(lds, g, S, E, nullptr, wv_);
}

constexpr int SSD_PITCH = 272, SSD_TILE = 128 * SSD_PITCH;
constexpr int SSD_TX = 0, SSD_TB = SSD_TILE, SSD_TC = 2 * SSD_TILE, SSD_TW = 3 * SSD_TILE, SSD_TAB = 4 * SSD_TILE;
constexpr size_t WS_ATOT = WS_DT + 512 * 1024;
typedef short s16x4 __attribute__((ext_vector_type(4)));
template <int PITCH = SSD_PITCH> __device__ __forceinline__ s16x4 tr_read4(const LAS unsigned char* tile, int row0, int col0, int lane) {
    const int i = lane & 15, cb = ((lane >> 4) & 1) * 16;
    const LAS unsigned char* a = tile + (row0 + (i >> 2)) * PITCH + (col0 + cb + 4 * (i & 3)) * 2;
    return __builtin_bit_cast(s16x4, __builtin_amdgcn_ds_read_tr16_b64_v4i16((LAS s16x4*)a));
}
__device__ __forceinline__ bf16x8 cat8(s16x4 a, s16x4 b) { return (bf16x8){a[0], a[1], a[2], a[3], b[0], b[1], b[2], b[3]}; }
__device__ __forceinline__ bf16x8 tr_frag_nat(const LAS unsigned char* tile, int r0, int col0, int lane) { const int hi = lane >> 5; return cat8(tr_read4(tile, r0 + 8 * hi, col0, lane), tr_read4(tile, r0 + 8 * hi + 4, col0, lane)); }
template <int PITCH = SSD_PITCH> __device__ __forceinline__ bf16x8 tr_frag_acc(const LAS unsigned char* tile, int r0, int col0, int lane) { const int hi = lane >> 5; return cat8(tr_read4<PITCH>(tile, r0 + 4 * hi, col0, lane), tr_read4<PITCH>(tile, r0 + 4 * hi + 8, col0, lane)); }
__device__ __forceinline__ bf16x8 row_frag(const LAS unsigned char* tile, int r0, int k0, int lane) { return *(const LAS bf16x8*)(tile + (r0 + (lane & 31)) * SSD_PITCH + (k0 + 8 * (lane >> 5)) * 2); }

__device__ __forceinline__ void ssd_stage_conv(const bf16* P, int t0, int s0, int pcol0, const float* cw, const float* cb, int cc0, LAS unsigned char* tile, int tid) {
    const int ch = tid & 15, rg = tid >> 4;
    float w[4][8], bias[8];
#pragma unroll
    for (int k = 0; k < 4; ++k) { const f32x4 a = *(const f32x4*)(cw + k * 768 + cc0 + ch * 8), b = *(const f32x4*)(cw + k * 768 + cc0 + ch * 8 + 4);
        w[k][0] = a.x; w[k][1] = a.y; w[k][2] = a.z; w[k][3] = a.w; w[k][4] = b.x; w[k][5] = b.y; w[k][6] = b.z; w[k][7] = b.w; }
    { const f32x4 a = *(const f32x4*)(cb + cc0 + ch * 8), b = *(const f32x4*)(cb + cc0 + ch * 8 + 4); bias[0] = a.x; bias[1] = a.y; bias[2] = a.z; bias[3] = a.w; bias[4] = b.x; bias[5] = b.y; bias[6] = b.z; bias[7] = b.w; }
    u32x4 in[7];
#pragma unroll
    for (int r = 0; r < 7; ++r) { const int row = 4 * rg - 3 + r; in[r] = (u32x4){0u, 0u, 0u, 0u}; if (s0 + row >= 0) in[r] = *(const u32x4*)(P + (size_t)(t0 + row) * NPROJ + pcol0 + ch * 8); }
#pragma unroll
    for (int j = 0; j < 4; ++j) { float o[8];
#pragma unroll
        for (int i = 0; i < 8; ++i) o[i] = bias[i];
#pragma unroll
        for (int k = 0; k < 4; ++k)
#pragma unroll
            for (int i2 = 0; i2 < 4; ++i2) { const unsigned wd = in[j + k][i2]; o[2 * i2] += w[k][2 * i2] * bflo(wd); o[2 * i2 + 1] += w[k][2 * i2 + 1] * bfhi(wd); }
        u32x4 ov;
#pragma unroll
        for (int i2 = 0; i2 < 4; ++i2) ov[i2] = pk2(silu_f(o[2 * i2]), silu_f(o[2 * i2 + 1]));
        *(LAS u32x4*)(tile + (4 * rg + j) * SSD_PITCH + ch * 16) = ov; }
}
__device__ __forceinline__ void ssd_tables(const Params& p, int l, int t0, int h0, int nh, LAS float* dtv, LAS float* acs, int tid) {
    const int hh = tid >> 7, row = tid & 127;
    if (hh < nh) { const int h = h0 + hh; const float a = -__expf(p.a_log[l * 4 + h]); const float dt = softplus_f(((const float*)(p.ws + WS_DT))[(size_t)(t0 + row) * 4 + h] + p.dt_bias[l * 4 + h]);
        dtv[hh * 128 + row] = dt; acs[hh * 128 + row] = a * dt; }
    __syncthreads();
    float cs = 0.f;
    if (hh < nh) for (int k = 0; k <= row; ++k) cs += acs[hh * 128 + k];
    __syncthreads();
    if (hh < nh) acs[hh * 128 + row] = cs;
    __syncthreads();
}
__device__ __forceinline__ void stage_ssd1(const Params& p, LAS unsigned char* lds, int l, int blk, int nblk, int wv_) {
    const int tid = otid(), lane = tid & 63, wave = __builtin_amdgcn_readfirstlane(tid >> 6);
    unsigned char* ws = p.ws; const bf16* P = (const bf16*)(ws + WS_P); float* SST = (float*)(ws + WS_SST); float* ATOT = (float*)(ws + WS_ATOT);
    const float* cw = p.conv_w + (size_t)l * 4 * 768; const float* cb = p.conv_b + (size_t)l * 768;
    LAS float* dtv = (LAS float*)(lds + SSD_TAB); LAS float* acs = dtv + 512;
    for (int u = blk; u < NB * 32 * 2; u += nblk) {
        const int g = u & 1, c = (u >> 1) & 31, b = u >> 6, t0 = b * SEQ + c * 128, s0 = c * 128;
        ssd_tables(p, l, t0, 2 * g, 2, dtv, acs, tid);
        if (tid < 2) ATOT[(b * 32 + c) * 4 + 2 * g + tid] = acs[tid * 128 + 127];
        ssd_stage_conv(P, t0, s0, C_XBC + g * 128, cw, cb, g * 128, lds + SSD_TX, tid);
        ssd_stage_conv(P, t0, s0, C_XBC + 256 + g * 128, cw, cb, 256 + g * 128, lds + SSD_TB, tid);
        __syncthreads();
        { const int row = tid >> 2, cq = tid & 3, hh = cq >> 1; const float sc = dtv[hh * 128 + row] * __expf(acs[hh * 128 + 127] - acs[hh * 128 + row]);
#pragma unroll
            for (int i = 0; i < 4; ++i) { const u32x4 v = *(const LAS u32x4*)(lds + SSD_TX + row * SSD_PITCH + cq * 64 + i * 16); u32x4 o;
#pragma unroll
                for (int q = 0; q < 4; ++q) o[q] = pk2(bflo(v[q]) * sc, bfhi(v[q]) * sc);
                *(LAS u32x4*)(lds + SSD_TW + row * SSD_PITCH + cq * 64 + i * 16) = o; } }
        __syncthreads();
        { const int hh = wave >> 2, nt = wave & 3, hi = lane >> 5; f32x16 acc0 = {}, acc1 = {};
#pragma unroll
            for (int ks = 0; ks < 8; ++ks) { const bf16x8 bfr = tr_frag_nat(lds + SSD_TB, 16 * ks, nt * 32, lane);
                const bf16x8 a0 = tr_frag_nat(lds + SSD_TW, 16 * ks, hh * 64, lane), a1 = tr_frag_nat(lds + SSD_TW, 16 * ks, hh * 64 + 32, lane);
                acc0 = __builtin_amdgcn_mfma_f32_32x32x16_bf16(a0, bfr, acc0, 0, 0, 0); acc1 = __builtin_amdgcn_mfma_f32_32x32x16_bf16(a1, bfr, acc1, 0, 0, 0); }
            float* So = SST + ((size_t)((b * 32 + c) * 4 + 2 * g + hh)) * 8192 + nt * 32 + (lane & 31);
#pragma unroll
            for (int r = 0; r < 16; ++r) { So[(size_t)crow(r, hi) * 128] = acc0[r]; So[(size_t)(32 + crow(r, hi)) * 128] = acc1[r]; } }
        __syncthreads();
    }
}
__device__ __forceinline__ void stage_ssd_scan(const Params& p, int blk, int nblk, int wv_) {
    unsigned char* ws = p.ws; float* SST = (float*)(ws + WS_SST); const float* ATOT = (const float*)(ws + WS_ATOT);
    for (int e = blk * NTHREADS + otid(); e < NB * 4 * 8192; e += nblk * NTHREADS) { const int el = e & 8191, h = (e >> 13) & 3, b = e >> 15;
        float run = 0.f;
        for (int c = 0; c < 32; ++c) { float* q = SST + ((size_t)((b * 32 + c) * 4 + h)) * 8192 + el; const float sv = *q; *q = run; run = run * __expf(ATOT[(b * 32 + c) * 4 + h]) + sv; } }
}
__device__ __forceinline__ void stage_ssd3(const Params& p, LAS unsigned char* lds, int l, int blk, int nblk, int wv_) {
    const int tid = otid(), lane = tid & 63, wave = __builtin_amdgcn_readfirstlane(tid >> 6), hi = lane >> 5, l31 = lane & 31;
    unsigned char* ws = p.ws; const bf16* P = (const bf16*)(ws + WS_P); const float* SST = (const float*)(ws + WS_SST); bf16* MIX = (bf16*)(ws + WS_MIX); float* YS = (float*)(ws + WS_YS);
    const float* cw = p.conv_w + (size_t)l * 4 * 768; const float* cb = p.conv_b + (size_t)l * 768;
    LAS float* dtv = (LAS float*)(lds + SSD_TAB); LAS float* acs = dtv + 512; LAS float* ssq = dtv + 1024;
    for (int u = blk; u < NB * 32; u += nblk) {
        const int c = u & 31, b = u >> 5, t0 = b * SEQ + c * 128, s0 = c * 128;
        ssd_tables(p, l, t0, 0, 4, dtv, acs, tid);
        const int hh = wave >> 2, j = wave & 3, lrow = 32 * j + l31;
        float ssq0 = 0.f, ssq1 = 0.f;
#pragma unroll 1
        for (int g = 0; g < 2; ++g) {
            ssd_stage_conv(P, t0, s0, C_XBC + g * 128, cw, cb, g * 128, lds + SSD_TX, tid);
            ssd_stage_conv(P, t0, s0, C_XBC + 256 + g * 128, cw, cb, 256 + g * 128, lds + SSD_TB, tid);
            ssd_stage_conv(P, t0, s0, C_XBC + 512 + g * 128, cw, cb, 512 + g * 128, lds + SSD_TC, tid);
            { const int row = tid >> 2, cq = tid & 3; const float* src = SST + ((size_t)((b * 32 + c) * 4 + 2 * g + (row >> 6))) * 8192 + (row & 63) * 128 + cq * 32;
#pragma unroll
                for (int i = 0; i < 4; ++i) { const f32x4 a = *(const f32x4*)(src + 8 * i), bq = *(const f32x4*)(src + 8 * i + 4); u32x4 o; o.x = pk2(a.x, a.y); o.y = pk2(a.z, a.w); o.z = pk2(bq.x, bq.y); o.w = pk2(bq.z, bq.w);
                    *(LAS u32x4*)(lds + SSD_TW + row * SSD_PITCH + cq * 64 + i * 16) = o; } }
            __syncthreads();
            const int h = 2 * g + hh; const LAS float* acsh = acs + h * 128; const LAS float* dth = dtv + h * 128; const float acs_l = acsh[lrow];
            f32x16 yd0 = {}, yd1 = {};
            for (int a = 0; a <= j; ++a) {
                f32x16 G = {};
#pragma unroll
                for (int ks = 0; ks < 8; ++ks) G = __builtin_amdgcn_mfma_f32_32x32x16_bf16(row_frag(lds + SSD_TB, 32 * a, 16 * ks, lane), row_frag(lds + SSD_TC, 32 * j, 16 * ks, lane), G, 0, 0, 0);
                unsigned mw[8];
#pragma unroll
                for (int r2 = 0; r2 < 8; ++r2) { float v2[2];
#pragma unroll
                    for (int q = 0; q < 2; ++q) { const int r = 2 * r2 + q, srow = 32 * a + crow(r, hi); float v = G[r] * __expf(acs_l - acsh[srow]) * dth[srow]; if (srow > lrow) v = 0.f; v2[q] = v; }
                    mw[r2] = pk2(v2[0], v2[1]); }
#pragma unroll
                for (int ks = 0; ks < 2; ++ks) { const bf16x8 mb = __builtin_bit_cast(bf16x8, (u32x4){mw[4 * ks], mw[4 * ks + 1], mw[4 * ks + 2], mw[4 * ks + 3]});
                    yd0 = __builtin_amdgcn_mfma_f32_32x32x16_bf16(tr_frag_acc(lds + SSD_TX, 32 * a + 16 * ks, hh * 64, lane), mb, yd0, 0, 0, 0);
                    yd1 = __builtin_amdgcn_mfma_f32_32x32x16_bf16(tr_frag_acc(lds + SSD_TX, 32 * a + 16 * ks, hh * 64 + 32, lane), mb, yd1, 0, 0, 0); }
            }
            f32x16 yo0 = {}, yo1 = {};
#pragma unroll
            for (int ks = 0; ks < 8; ++ks) { const bf16x8 cf = row_frag(lds + SSD_TC, 32 * j, 16 * ks, lane);
                yo0 = __builtin_amdgcn_mfma_f32_32x32x16_bf16(row_frag(lds + SSD_TW, hh * 64, 16 * ks, lane), cf, yo0, 0, 0, 0);
                yo1 = __builtin_amdgcn_mfma_f32_32x32x16_bf16(row_frag(lds + SSD_TW, hh * 64 + 32, 16 * ks, lane), cf, yo1, 0, 0, 0); }
            const float eo = __expf(acs_l), Dh = p.d_skip[l * 4 + h];
#pragma unroll
            for (int pt = 0; pt < 2; ++pt)
#pragma unroll
                for (int rg = 0; rg < 4; ++rg) { const int pc = pt * 32 + 8 * rg + 4 * hi;
                    const u32x2 xw = *(const LAS u32x2*)(lds + SSD_TX + lrow * SSD_PITCH + (hh * 64 + pc) * 2);
                    const u32x2 zw = *(const u32x2*)(P + (size_t)(t0 + lrow) * NPROJ + C_Z + h * 64 + pc);
                    const float xs[4] = {bflo(xw.x), bfhi(xw.x), bflo(xw.y), bfhi(xw.y)}, zs[4] = {bflo(zw.x), bfhi(zw.x), bflo(zw.y), bfhi(zw.y)};
                    f32x4 yo4;
#pragma unroll
                    for (int q = 0; q < 4; ++q) { const int r = 4 * rg + q; const float yy = ((pt ? yd1[r] : yd0[r]) + (pt ? yo1[r] : yo0[r]) * eo + Dh * xs[q]) * silu_f(zs[q]); yo4[q] = yy; if (g == 0) ssq0 += yy * yy; else ssq1 += yy * yy; }
                    *(f32x4*)(YS + (size_t)(t0 + lrow) * 256 + h * 64 + pc) = yo4; }
            __syncthreads();
        }
        {
            ssq0 += __shfl_xor(ssq0, 32); ssq1 += __shfl_xor(ssq1, 32);
            if (hi == 0) { ssq[hh * 128 + lrow] = ssq0; ssq[(2 + hh) * 128 + lrow] = ssq1; }
            __syncthreads();
            const float tot = ssq[lrow] + ssq[128 + lrow] + ssq[256 + lrow] + ssq[384 + lrow];
            const float rn = 1.f / sqrtf(tot * (1.f / 256.f) + RMS_EPS);
#pragma unroll 1
            for (int g = 0; g < 2; ++g)
#pragma unroll
                for (int pt = 0; pt < 2; ++pt)
#pragma unroll
                    for (int rg = 0; rg < 4; ++rg) { const int ch = (2 * g + hh) * 64 + pt * 32 + 8 * rg + 4 * hi; const f32x4 nw = *(const f32x4*)(p.ssd_norm_w + l * 256 + ch);
                        const f32x4 yq = *(const f32x4*)(YS + (size_t)(t0 + lrow) * 256 + ch);
                        u32x2 o; o.x = pk2(yq.x * rn * nw.x, yq.y * rn * nw.y); o.y = pk2(yq.z * rn * nw.z, yq.w * rn * nw.w);
                        *(u32x2*)(MIX + (size_t)(t0 + lrow) * DM + 512 + ch) = o; }
            __syncthreads();
        }
    }
}

constexpr int AT_VP = 144, AT_WAVE_LDS = 32 * AT_VP + 1056;
struct AttnState { float m, l; f32x16 o0, o1; };
__device__ __forceinline__ void attn_tile_update(AttnState& st, f32x16& S, unsigned validmask, const LAS unsigned char* vt, int lane) {
    float tmax = -1e30f;
#pragma unroll
    for (int r = 0; r < 16; ++r) tmax = fmaxf(tmax, S[r]);
    tmax = fmaxf(tmax, __shfl_xor(tmax, 32));
    const float mn = fmaxf(st.m, tmax), sc = __expf(st.m - mn); st.m = mn;
    float ps = 0.f; unsigned pw[8]; (void)validmask;
#pragma unroll
    for (int r2 = 0; r2 < 8; ++r2) { float p0 = __expf(S[2 * r2] - mn), p1 = __expf(S[2 * r2 + 1] - mn); p0 = S[2 * r2] > -1e29f ? p0 : 0.f; p1 = S[2 * r2 + 1] > -1e29f ? p1 : 0.f;
        ps += p0 + p1; pw[r2] = pk2(p0, p1); }
    st.l = st.l * sc + ps;
#pragma unroll
    for (int r = 0; r < 16; ++r) { st.o0[r] *= sc; st.o1[r] *= sc; }
    asm volatile("s_waitcnt lgkmcnt(0)" ::: "memory");
#pragma unroll
    for (int ks = 0; ks < 2; ++ks) { const bf16x8 pb = __builtin_bit_cast(bf16x8, (u32x4){pw[4 * ks], pw[4 * ks + 1], pw[4 * ks + 2], pw[4 * ks + 3]});
        st.o0 = __builtin_amdgcn_mfma_f32_32x32x16_bf16(tr_frag_acc<AT_VP>(vt, 16 * ks, 0, lane), pb, st.o0, 0, 0, 0);
        st.o1 = __builtin_amdgcn_mfma_f32_32x32x16_bf16(tr_frag_acc<AT_VP>(vt, 16 * ks, 32, lane), pb, st.o1, 0, 0, 0); }
    asm volatile("s_waitcnt lgkmcnt(0)" ::: "memory");
}
__device__ __forceinline__ void stage_attn(const Params& p, LAS unsigned char* lds, int item0, int item_stride, int wv_) {
    const int tid = otid(), lane = tid & 63, wave = __builtin_amdgcn_readfirstlane(tid >> 6), hi = lane >> 5, l31 = lane & 31;
    unsigned char* ws = p.ws; const bf16* P = (const bf16*)(ws + WS_P); const float* BT = (const float*)(ws + WS_BIAST);
    bf16* AO = (bf16*)(ws + WS_ATTO); float* LSE = (float*)(ws + WS_LSE);
    LAS unsigned char* vt = lds + wave * AT_WAVE_LDS; LAS float* bt = (LAS float*)(vt + 32 * AT_VP);
    const int h = wave;
    for (int item = item0; item < 384; item += item_stride) {
        const int br = item >> 7, q7 = item & 127, b = q7 >> 5, q5 = q7 & 31;
        const int dil = br == 0 ? 1 : (br == 1 ? 4 : 16), r = br == 0 ? 0 : (br == 1 ? (q5 >> 3) : (q5 >> 1)), n = br == 0 ? q5 : (br == 1 ? (q5 & 7) : (q5 & 1));
        const int tokbase = b * SEQ + r, m0 = n * 128;
        asm volatile("s_waitcnt lgkmcnt(0)" ::: "memory");
        bt[lane] = BT[(br * 8 + h) * 132 + lane]; bt[64 + lane] = BT[(br * 8 + h) * 132 + 64 + lane]; if (lane == 0) bt[128] = BT[(br * 8 + h) * 132 + 128];
        for (int a = 0; a < 4; ++a) {
            const int tokq = tokbase + (m0 + 32 * a + l31) * dil;
            bf16x8 qf[4];
#pragma unroll
            for (int ks = 0; ks < 4; ++ks) qf[ks] = *(const bf16x8*)(P + (size_t)tokq * NPROJ + C_Q + h * 64 + 16 * ks + 8 * hi);
            AttnState st; st.m = -1e30f; st.l = 0.f; st.o0 = (f32x16){}; st.o1 = (f32x16){};
            const int jt0 = (n == 0 && a < 4) ? 4 : a;
            for (int jt = (jt0 > a ? jt0 : a); jt <= a + 4; ++jt) {
                const int mk0 = m0 - 128 + 32 * jt;
                {
#pragma unroll
                    for (int it = 0; it < 4; ++it) { const int row = it * 8 + (lane >> 3), chn = lane & 7;
                        const u32x4 v = *(const u32x4*)(P + (size_t)(tokbase + (mk0 + row) * dil) * NPROJ + C_V + h * 64 + chn * 8);
                        *(LAS u32x4*)(vt + row * AT_VP + chn * 16) = v; } }
                const int tokk = tokbase + (mk0 + l31) * dil;
                f32x16 S = {};
#pragma unroll
                for (int ks = 0; ks < 4; ++ks) { const bf16x8 kf = *(const bf16x8*)(P + (size_t)tokk * NPROJ + C_K + h * 64 + 16 * ks + 8 * hi); S = __builtin_amdgcn_mfma_f32_32x32x16_bf16(kf, qf[ks], S, 0, 0, 0); }
                const int bs = 32 * (a - jt) + 128 + l31; unsigned vm = 0u;
#pragma unroll
                for (int rr = 0; rr < 16; ++rr) { const int stp = bs - crow(rr, hi); const bool ok = stp >= 0 && stp <= 128; const int sti = stp < 0 ? 0 : (stp > 128 ? 128 : stp);
                    const float bv = bt[sti]; S[rr] = ok ? S[rr] + bv : -1e30f; }
                attn_tile_update(st, S, vm, vt, lane);
            }
            const float lt = st.l + __shfl_xor(st.l, 32), inv = 1.f / lt;
#pragma unroll
            for (int dt = 0; dt < 2; ++dt)
#pragma unroll
                for (int rg = 0; rg < 4; ++rg) { const f32x16& o = dt ? st.o1 : st.o0; u32x2 w; w.x = pk2(o[4 * rg] * inv, o[4 * rg + 1] * inv); w.y = pk2(o[4 * rg + 2] * inv, o[4 * rg + 3] * inv);
                    *(u32x2*)(AO + ((size_t)br * T + tokq) * 512 + h * 64 + dt * 32 + 8 * rg + 4 * hi) = w; }
            if (hi == 0) LSE[((size_t)br * T + tokq) * 8 + h] = st.m + __logf(lt);
        }
    }
}
__device__ __forceinline__ void stage_memattn(const Params& p, LAS unsigned char* lds, int l, int item0, int item_stride, int wv_) {
    const int tid = otid(), lane = tid & 63, wave = __builtin_amdgcn_readfirstlane(tid >> 6), hi = lane >> 5, l31 = lane & 31;
    unsigned char* ws = p.ws; const bf16* P = (const bf16*)(ws + WS_P); const bf16* KV = (const bf16*)(ws + WS_KV) + (size_t)l * 1024 * 512; bf16* MIX = (bf16*)(ws + WS_MIX);
    LAS unsigned char* vt = lds + wave * AT_WAVE_LDS; LAS float* bt = (LAS float*)(vt + 32 * AT_VP);
    for (int item = item0; item < (T / 32) * 4; item += item_stride) {
        const int h = item & 3, tt = item >> 2, t0 = tt * 32, b = t0 / SEQ; const int tokq = t0 + l31;
        asm volatile("s_waitcnt lgkmcnt(0)" ::: "memory");
#pragma unroll
        for (int i = 0; i < 4; ++i) bt[64 * i + lane] = p.mem_bias[(l * 4 + h) * NMEM + 64 * i + lane];
        bf16x8 qf[4];
#pragma unroll
        for (int ks = 0; ks < 4; ++ks) qf[ks] = *(const bf16x8*)(P + (size_t)tokq * NPROJ + C_QM + h * 64 + 16 * ks + 8 * hi);
        AttnState st; st.m = -1e30f; st.l = 0.f; st.o0 = (f32x16){}; st.o1 = (f32x16){};
        for (int jt = 0; jt < 8; ++jt) {
            const bf16* kvb = KV + (size_t)(b * NMEM + 32 * jt) * 512;
#pragma unroll
            for (int it = 0; it < 4; ++it) { const int row = it * 8 + (lane >> 3), chn = lane & 7; const u32x4 v = *(const u32x4*)(kvb + (size_t)row * 512 + 256 + h * 64 + chn * 8); *(LAS u32x4*)(vt + row * AT_VP + chn * 16) = v; }
            f32x16 S = {};
#pragma unroll
            for (int ks = 0; ks < 4; ++ks) { const bf16x8 kf = *(const bf16x8*)(kvb + (size_t)l31 * 512 + h * 64 + 16 * ks + 8 * hi); S = __builtin_amdgcn_mfma_f32_32x32x16_bf16(kf, qf[ks], S, 0, 0, 0); }
#pragma unroll
            for (int rr = 0; rr < 16; ++rr) S[rr] += bt[32 * jt + crow(rr, hi)];
            attn_tile_update(st, S, 0xffffu, vt, lane);
        }
        const float lt = st.l + __shfl_xor(st.l, 32), inv = 1.f / lt;
#pragma unroll
        for (int dt = 0; dt < 2; ++dt)
#pragma unroll
            for (int rg = 0; rg < 4; ++rg) { const f32x16& o = dt ? st.o1 : st.o0; u32x2 w; w.x = pk2(o[4 * rg] * inv, o[4 * rg + 1] * inv); w.y = pk2(o[4 * rg + 2] * inv, o[4 * rg + 3] * inv);
                *(u32x2*)(MIX + (size_t)tokq * DM + 768 + h * 64 + dt * 32 + 8 * rg + 4 * hi) = w; }
    }
}

struct Route { int e1, e2; float w1, w2; };
__device__ __forceinline__ Route route_row(float (&lg)[16], const float* b_router) {
    float mx = -INFINITY;
#pragma unroll
    for (int e = 0; e < 16; ++e) { lg[e] += b_router[e]; mx = fmaxf(mx, lg[e]); }
    float sum = 0.f;
#pragma unroll
    for (int e = 0; e < 16; ++e) { lg[e] = __expf(lg[e] - mx); sum += lg[e]; }
    const float inv = 1.f / sum;
#pragma unroll
    for (int e = 0; e < 16; ++e) lg[e] *= inv;
    int best = 0; float bs = -1.f, c0 = 0.f, c1 = 0.f, c2 = 0.f, c3 = 0.f;
#pragma unroll
    for (int g = 0; g < 4; ++g) { const float a = lg[4 * g], b = lg[4 * g + 1], c = lg[4 * g + 2], d = lg[4 * g + 3];
        const float h1 = fmaxf(a, b), l1 = fminf(a, b), h2 = fmaxf(c, d), l2 = fminf(c, d); const float gs = fmaxf(h1, h2) + fmaxf(fminf(h1, h2), fmaxf(l1, l2));
        const bool better = gs > bs; bs = better ? gs : bs; best = better ? g : best; c0 = better ? a : c0; c1 = better ? b : c1; c2 = better ? c : c2; c3 = better ? d : c3; }
    int i1 = 0; float s1 = c0; if (c1 > s1) { s1 = c1; i1 = 1; } if (c2 > s1) { s1 = c2; i1 = 2; } if (c3 > s1) { s1 = c3; i1 = 3; }
    int i2 = -1; float s2 = -1.f;
    if (i1 != 0 && c0 > s2) { s2 = c0; i2 = 0; } if (i1 != 1 && c1 > s2) { s2 = c1; i2 = 1; } if (i1 != 2 && c2 > s2) { s2 = c2; i2 = 2; } if (i1 != 3 && c3 > s2) { s2 = c3; i2 = 3; }
    Route r; r.e1 = best * 4 + i1; r.e2 = best * 4 + i2; const float wsn = 1.f / (s1 + s2); r.w1 = s1 * wsn; r.w2 = s2 * wsn; return r;
}
constexpr int RT_W = 0, RT_LCNT = 65536, RT_GB = 65536 + 64, RT_INFO = 65536 + 128;
__device__ __forceinline__ void stage_ln1_router2(const Params& p, LAS unsigned char* lds, int l, int blk, int nblk, int wv_) {
    const int tid = otid(), lane = tid & 63, wave = __builtin_amdgcn_readfirstlane(tid >> 6);
    unsigned char* ws = p.ws; bf16* XB = (bf16*)(ws + WS_XB); unsigned* cnt = (unsigned*)(ws + WS_CTL) + CW_CNT + l * 16;
    int* TOKE = (int*)(ws + WS_TOKE); int* TOKP = (int*)(ws + WS_TOKP); float* TOKW = (float*)(ws + WS_TOKW); int* LIST = (int*)(ws + WS_LIST);
    LAS f32x4* WL = (LAS f32x4*)(lds + RT_W); LAS unsigned* lcnt = (LAS unsigned*)(lds + RT_LCNT); LAS unsigned* gb = (LAS unsigned*)(lds + RT_GB); LAS int* info = (LAS int*)(lds + RT_INFO);
#pragma unroll
    for (int i = 0; i < 8; ++i) { const int chunk = tid + NTHREADS * i, k = chunk >> 2, q = chunk & 3, ln = (k & 255) >> 2, c = k & 3, j = k >> 8;
        WL[((j * 4 + c) * 4 + q) * 64 + ln] = *((const f32x4*)p.w_router + chunk); }
    for (int rb = blk; rb < T / 64; rb += nblk) {
        if (tid < 16) lcnt[tid] = 0u;
        __syncthreads();
#pragma unroll 1
        for (int pr = 0; pr < 4; ++pr) {
            const int r0 = wave * 8 + 2 * pr, t = rb * 64 + r0;
            f32x4 v0[4], v1[4]; f32x4* xr0 = (f32x4*)(p.out + (size_t)t * DM) + lane; f32x4* xr1 = xr0 + DM / 4;
#pragma unroll
            for (int j = 0; j < 4; ++j) { v0[j] = xr0[64 * j]; v1[j] = xr1[64 * j]; }
            ln_row(v0, p.ln1_g + l * DM, p.ln1_b + l * DM, lane); ln_row(v1, p.ln1_g + l * DM, p.ln1_b + l * DM, lane);
            float lg0[16], lg1[16];
#pragma unroll
            for (int e = 0; e < 16; ++e) { lg0[e] = 0.f; lg1[e] = 0.f; }
#pragma unroll
            for (int j = 0; j < 4; ++j) { xr0[64 * j] = v0[j]; xr1[64 * j] = v1[j];
                u32x2 o; o.x = pk2(v0[j].x, v0[j].y); o.y = pk2(v0[j].z, v0[j].w); *((u32x2*)(XB + (size_t)t * DM) + lane + 64 * j) = o;
                o.x = pk2(v1[j].x, v1[j].y); o.y = pk2(v1[j].z, v1[j].w); *((u32x2*)(XB + (size_t)(t + 1) * DM) + lane + 64 * j) = o;
#pragma unroll
                for (int c = 0; c < 4; ++c) { const float x0 = v0[j][c], x1 = v1[j][c];
#pragma unroll
                    for (int q = 0; q < 4; ++q) { const f32x4 w = WL[((j * 4 + c) * 4 + q) * 64 + lane];
                        lg0[4 * q] += x0 * w.x; lg0[4 * q + 1] += x0 * w.y; lg0[4 * q + 2] += x0 * w.z; lg0[4 * q + 3] += x0 * w.w;
                        lg1[4 * q] += x1 * w.x; lg1[4 * q + 1] += x1 * w.y; lg1[4 * q + 2] += x1 * w.z; lg1[4 * q + 3] += x1 * w.w; } } }
#pragma unroll
            for (int e = 0; e < 16; ++e) { lg0[e] = wave_sum(lg0[e]); lg1[e] = wave_sum(lg1[e]); }
            const Route ra = route_row(lg0, p.b_router), rc = route_row(lg1, p.b_router);
            if (lane == 0) {
                const int pa1 = (int)__hip_atomic_fetch_add(lcnt + ra.e1, 1u, __ATOMIC_RELAXED, __HIP_MEMORY_SCOPE_WORKGROUP), pa2 = (int)__hip_atomic_fetch_add(lcnt + ra.e2, 1u, __ATOMIC_RELAXED, __HIP_MEMORY_SCOPE_WORKGROUP);
                const int pc1 = (int)__hip_atomic_fetch_add(lcnt + rc.e1, 1u, __ATOMIC_RELAXED, __HIP_MEMORY_SCOPE_WORKGROUP), pc2 = (int)__hip_atomic_fetch_add(lcnt + rc.e2, 1u, __ATOMIC_RELAXED, __HIP_MEMORY_SCOPE_WORKGROUP);
                LAS int* ia = info + r0 * 6; ia[0] = ra.e1; ia[1] = ra.e2; ia[2] = pa1; ia[3] = pa2; ia[4] = __builtin_bit_cast(int, ra.w1); ia[5] = __builtin_bit_cast(int, ra.w2);
                ia[6] = rc.e1; ia[7] = rc.e2; ia[8] = pc1; ia[9] = pc2; ia[10] = __builtin_bit_cast(int, rc.w1); ia[11] = __builtin_bit_cast(int, rc.w2); }
        }
        __syncthreads();
        if (tid < 16) gb[tid] = atomicAdd(cnt + tid, lcnt[tid]);
        __syncthreads();
        if (tid < 64) { const int t = rb * 64 + tid; const LAS int* ia = info + tid * 6; const int e1 = ia[0], e2 = ia[1], p1 = (int)gb[e1] + ia[2], p2 = (int)gb[e2] + ia[3];
            LIST[e1 * T + p1] = t; LIST[e2 * T + p2] = t; TOKE[2 * t] = e1; TOKE[2 * t + 1] = e2; TOKP[2 * t] = p1; TOKP[2 * t + 1] = p2;
            TOKW[2 * t] = __builtin_bit_cast(float, ia[4]); TOKW[2 * t + 1] = __builtin_bit_cast(float, ia[5]); }
        __syncthreads();
    }
}
__device__ __forceinline__ void stage_ln2b(const Params& p, LAS unsigned char* lds, int l, int blk, int nblk, int wv_) {
    const int tid = otid(), lane = tid & 63, wave = __builtin_amdgcn_readfirstlane(tid >> 6), gw = blk * NWAVES + wave, ngw = nblk * NWAVES;
    unsigned char* ws = p.ws; bf16* XB = (bf16*)(ws + WS_XB); const unsigned* cnt = (const unsigned*)(ws + WS_CTL) + CW_CNT + l * 16; const bf16* Y = (const bf16*)(ws + WS_Y);
    const int* TOKE = (const int*)(ws + WS_TOKE); const int* TOKP = (const int*)(ws + WS_TOKP); const float* TOKW = (const float*)(ws + WS_TOKW); float* DT = (float*)(ws + WS_DT);
    LAS int* eb = (LAS int*)lds;
    if (tid == 0) { int a = 0; for (int e = 0; e < NE; ++e) { eb[e] = a; a += (int)((cnt[e] + 255u) >> 8) * 256; } }
    __syncthreads();
    const bool nextl = l + 1 < DEPTH;
    for (int t = 2 * gw; t < T; t += 2 * ngw) {
        asm volatile("" ::: "memory");
        const int ea1 = TOKE[2 * t], ea2 = TOKE[2 * t + 1], ec1 = TOKE[2 * t + 2], ec2 = TOKE[2 * t + 3];
        const int ra1 = TOKP[2 * t] + eb[ea1], ra2 = TOKP[2 * t + 1] + eb[ea2], rc1 = TOKP[2 * t + 2] + eb[ec1], rc2 = TOKP[2 * t + 3] + eb[ec2];
        const float wa1 = TOKW[2 * t], wa2 = TOKW[2 * t + 1], wc1 = TOKW[2 * t + 2], wc2 = TOKW[2 * t + 3];
        f32x4 v0[4], v1[4]; f32x4* xr0 = (f32x4*)(p.out + (size_t)t * DM) + lane; f32x4* xr1 = xr0 + DM / 4;
#pragma unroll
        for (int j = 0; j < 4; ++j) { const f32x4 xa = xr0[64 * j], xc = xr1[64 * j];
            const u32x2 a = *((const u32x2*)(Y + (size_t)ra1 * DM) + lane + 64 * j), b = *((const u32x2*)(Y + (size_t)ra2 * DM) + lane + 64 * j);
            const u32x2 c = *((const u32x2*)(Y + (size_t)rc1 * DM) + lane + 64 * j), d = *((const u32x2*)(Y + (size_t)rc2 * DM) + lane + 64 * j);
            v0[j].x = ALPHA * xa.x + (wa1 * bflo(a.x) + wa2 * bflo(b.x)); v0[j].y = ALPHA * xa.y + (wa1 * bfhi(a.x) + wa2 * bfhi(b.x));
            v0[j].z = ALPHA * xa.z + (wa1 * bflo(a.y) + wa2 * bflo(b.y)); v0[j].w = ALPHA * xa.w + (wa1 * bfhi(a.y) + wa2 * bfhi(b.y));
            v1[j].x = ALPHA * xc.x + (wc1 * bflo(c.x) + wc2 * bflo(d.x)); v1[j].y = ALPHA * xc.y + (wc1 * bfhi(c.x) + wc2 * bfhi(d.x));
            v1[j].z = ALPHA * xc.z + (wc1 * bflo(c.y) + wc2 * bflo(d.y)); v1[j].w = ALPHA * xc.w + (wc1 * bfhi(c.y) + wc2 * bfhi(d.y)); }
        ln_row(v0, p.ln2_g + l * DM, p.ln2_b + l * DM, lane); ln_row(v1, p.ln2_g + l * DM, p.ln2_b + l * DM, lane);
        float d0 = 0.f, d1 = 0.f, d2 = 0.f, d3 = 0.f, f0 = 0.f, f1 = 0.f, f2 = 0.f, f3 = 0.f;
#pragma unroll
        for (int j = 0; j < 4; ++j) { xr0[64 * j] = v0[j]; xr1[64 * j] = v1[j];
            if (nextl) { u32x2 o; o.x = pk2(v0[j].x, v0[j].y); o.y = pk2(v0[j].z, v0[j].w); *((u32x2*)(XB + (size_t)t * DM) + lane + 64 * j) = o;
                o.x = pk2(v1[j].x, v1[j].y); o.y = pk2(v1[j].z, v1[j].w); *((u32x2*)(XB + (size_t)(t + 1) * DM) + lane + 64 * j) = o;
#pragma unroll
                for (int c = 0; c < 4; ++c) { const int k = 4 * lane + 256 * j + c; const f32x4 w = *(const f32x4*)(p.w_in + ((size_t)(l + 1) * DM + k) * NCOLS_IN + 2560); const float xa = v0[j][c], xc = v1[j][c];
                    d0 += xa * w.x; d1 += xa * w.y; d2 += xa * w.z; d3 += xa * w.w; f0 += xc * w.x; f1 += xc * w.y; f2 += xc * w.z; f3 += xc * w.w; } } }
        if (nextl) { d0 = wave_sum(d0); d1 = wave_sum(d1); d2 = wave_sum(d2); d3 = wave_sum(d3); f0 = wave_sum(f0); f1 = wave_sum(f1); f2 = wave_sum(f2); f3 = wave_sum(f3);
            if (lane == 0) { *(f32x4*)(DT + (size_t)t * 4) = (f32x4){d0, d1, d2, d3}; *(f32x4*)(DT + (size_t)(t + 1) * 4) = (f32x4){f0, f1, f2, f3}; } }
    }
    __syncthreads();
}
__device__ __forceinline__ void stage_merge2(const Params& p, int blk, int nblk, int wv_) {
    const int tid = otid(), lane = tid & 63, wave = tid >> 6, gw = blk * NWAVES + wave, ngw = nblk * NWAVES, h = lane >> 3;
    unsigned char* ws = p.ws; const bf16* AO = (const bf16*)(ws + WS_ATTO); const float* LSE = (const float*)(ws + WS_LSE); bf16* MIX = (bf16*)(ws + WS_MIX);
    for (int t0 = 4 * gw; t0 < T; t0 += 4 * ngw) {
        u32x4 a[4][3]; float ls[4][3];
#pragma unroll
        for (int i = 0; i < 4; ++i)
#pragma unroll
            for (int br = 0; br < 3; ++br) { a[i][br] = *(const u32x4*)(AO + ((size_t)br * T + t0 + i) * 512 + lane * 8); ls[i][br] = LSE[((size_t)br * T + t0 + i) * 8 + h]; }
#pragma unroll
        for (int i = 0; i < 4; ++i) { const float mx = fmaxf(fmaxf(ls[i][0], ls[i][1]), ls[i][2]); float w0 = __expf(ls[i][0] - mx), w1 = __expf(ls[i][1] - mx), w2 = __expf(ls[i][2] - mx); const float inv = 1.f / (w0 + w1 + w2); w0 *= inv; w1 *= inv; w2 *= inv;
            u32x4 o;
#pragma unroll
            for (int q = 0; q < 4; ++q) o[q] = pk2(w0 * bflo(a[i][0][q]) + w1 * bflo(a[i][1][q]) + w2 * bflo(a[i][2][q]), w0 * bfhi(a[i][0][q]) + w1 * bfhi(a[i][1][q]) + w2 * bfhi(a[i][2][q]));
            *(u32x4*)(MIX + (size_t)(t0 + i) * DM + lane * 8) = o; }
    }
}
__device__ __forceinline__ void stage_ssd_scan2(const Params& p, int blk, int nblk, int wv_) {
    unsigned char* ws = p.ws; float* SST = (float*)(ws + WS_SST); const float* ATOT = (const float*)(ws + WS_ATOT);
    for (int e = blk * NTHREADS + otid(); e < NB * 4 * 8192; e += nblk * NTHREADS) { const int el = e & 8191, h = (e >> 13) & 3, b = e >> 15;
        float sv[32], dc[32];
#pragma unroll
        for (int c = 0; c < 32; ++c) { sv[c] = SST[((size_t)((b * 32 + c) * 4 + h)) * 8192 + el]; dc[c] = ATOT[(b * 32 + c) * 4 + h]; }
        float run = 0.f;
#pragma unroll
        for (int c = 0; c < 32; ++c) { const float in = sv[c]; sv[c] = run; run = run * __expf(dc[c]) + in; }
#pragma unroll
        for (int c = 0; c < 32; ++c) SST[((size_t)((b * 32 + c) * 4 + h)) * 8192 + el] = sv[c]; }
}

__device__ __forceinline__ void stage_attn2(const Params& p, LAS unsigned char* lds, int item0, int item_stride, int wv_) {
    const int tid = otid(), lane = tid & 63, wave = __builtin_amdgcn_readfirstlane(tid >> 6), hi = lane >> 5, l31 = lane & 31;
    unsigned char* ws = p.ws; const bf16* P = (const bf16*)(ws + WS_P); const float* BT = (const float*)(ws + WS_BIAST);
    bf16* AO = (bf16*)(ws + WS_ATTO); float* LSE = (float*)(ws + WS_LSE);
    LAS unsigned char* vt = lds + wave * AT_WAVE_LDS; LAS float* bt = (LAS float*)(vt + 32 * AT_VP);
    const int h = wave;
    for (int hitem = item0; hitem < 768; hitem += item_stride) {
        const int item = hitem >> 1, half = hitem & 1;
        const int br = item >> 7, q7 = item & 127, b = q7 >> 5, q5 = q7 & 31;
        const int dil = br == 0 ? 1 : (br == 1 ? 4 : 16), r = br == 0 ? 0 : (br == 1 ? (q5 >> 3) : (q5 >> 1)), n = br == 0 ? q5 : (br == 1 ? (q5 & 7) : (q5 & 1));
        const int tokbase = b * SEQ + r, m0 = n * 128;
        asm volatile("s_waitcnt lgkmcnt(0)" ::: "memory");
#pragma unroll
        for (int i = 0; i < 3; ++i) { const int idx = lane + 64 * i, jj = idx - 32; bt[idx] = (jj >= 0 && jj <= 128) ? gld<float>(BT + (br * 8 + h) * 132 + 128 - jj) : -1e30f; }
        const int sb = n == 0 ? (half ? 3 : 0) : 10 * half, ns = n == 0 ? (half ? 10 : 3) : 10 * half + 10;
#define AT_DECODE(s_, a_, jt_) do { if (n != 0) { a_ = (s_) / 5; jt_ = a_ + (s_) % 5; } else { a_ = (s_) < 1 ? 0 : ((s_) < 3 ? 1 : ((s_) < 6 ? 2 : 3)); jt_ = 4 + (s_) - (a_ == 0 ? 0 : (a_ == 1 ? 1 : (a_ == 2 ? 3 : 6))); } } while (0)
#define AT_LOADKV(a_, jt_) do { const int mk0_ = m0 - 128 + 32 * (jt_); const bf16* kp_ = P + (size_t)(tokbase + (mk0_ + l31) * dil) * NPROJ + C_K + h * 64 + 8 * hi; \
            _Pragma("unroll") for (int ks = 0; ks < 4; ++ks) kn[ks] = gld<bf16x8>(kp_ + 16 * ks); \
            _Pragma("unroll") for (int it = 0; it < 4; ++it) vn[it] = gld<u32x4>(P + (size_t)(tokbase + (mk0_ + it * 8 + (lane >> 3)) * dil) * NPROJ + C_V + h * 64 + (lane & 7) * 8); } while (0)
#define AT_LOADQ(a_) do { const bf16* qp_ = P + (size_t)(tokbase + (m0 + 32 * (a_) + l31) * dil) * NPROJ + C_Q + h * 64 + 8 * hi; _Pragma("unroll") for (int ks = 0; ks < 4; ++ks) qn[ks] = gld<bf16x8>(qp_ + 16 * ks); } while (0)
        bf16x8 kn[4], qn[4], qf[4]; u32x4 vn[4];
        int a, jt; AT_DECODE(sb, a, jt); AT_LOADQ(a); AT_LOADKV(a, jt);
        AttnState st; st.m = -1e30f; st.l = 0.f; st.o0 = (f32x16){}; st.o1 = (f32x16){};
        int cur_a = -1;
        for (int s_ = sb; s_ < ns; ++s_) {
            AT_DECODE(s_, a, jt);
            bf16x8 kc[4]; u32x4 vc[4];
#pragma unroll
            for (int i = 0; i < 4; ++i) { kc[i] = kn[i]; vc[i] = vn[i]; }
            if (a != cur_a) { cur_a = a;
#pragma unroll
                for (int i = 0; i < 4; ++i) qf[i] = qn[i];
                st.m = -1e30f; st.l = 0.f; st.o0 = (f32x16){}; st.o1 = (f32x16){}; }
            int a2 = -1, jt2 = 0;
            if (s_ + 1 < ns) { AT_DECODE(s_ + 1, a2, jt2); AT_LOADKV(a2, jt2); if (a2 != a) AT_LOADQ(a2); }
#pragma unroll
            for (int it = 0; it < 4; ++it) *(LAS u32x4*)(vt + (it * 8 + (lane >> 3)) * AT_VP + (lane & 7) * 16) = vc[it];
            f32x16 S = {};
#pragma unroll
            for (int ks = 0; ks < 4; ++ks) S = __builtin_amdgcn_mfma_f32_32x32x16_bf16(kc[ks], qf[ks], S, 0, 0, 0);
            const LAS float* rb = bt + 32 + 32 * (jt - a) - l31 + 4 * hi;
#pragma unroll
            for (int rr = 0; rr < 16; ++rr) S[rr] += rb[(rr & 3) + 8 * (rr >> 2)];
            attn_tile_update(st, S, 0u, vt, lane);
            if (a2 != a) {
                const int tokq = tokbase + (m0 + 32 * a + l31) * dil;
                const float lt = st.l + __shfl_xor(st.l, 32), inv = 1.f / lt;
#pragma unroll
                for (int dt = 0; dt < 2; ++dt)
#pragma unroll
                    for (int rg = 0; rg < 4; ++rg) { const f32x16& o = dt ? st.o1 : st.o0; u32x2 w; w.x = pk2(o[4 * rg] * inv, o[4 * rg + 1] * inv); w.y = pk2(o[4 * rg + 2] * inv, o[4 * rg + 3] * inv);
                        gst<u32x2>(AO + ((size_t)br * T + tokq) * 512 + h * 64 + dt * 32 + 8 * rg + 4 * hi, w); }
                if (hi == 0) gst<float>(LSE + ((size_t)br * T + tokq) * 8 + h, st.m + __logf(lt));
            }
        }
#undef AT_DECODE
#undef AT_LOADKV
#undef AT_LOADQ
    }
}
__device__ __forceinline__ void stage_memattn2(const Params& p, LAS unsigned char* lds, int l, int item0, int item_stride, int wv_) {
    const int tid = otid(), lane = tid & 63, wave = __builtin_amdgcn_readfirstlane(tid >> 6), hi = lane >> 5, l31 = lane & 31;
    unsigned char* ws = p.ws; const bf16* P = (const bf16*)(ws + WS_P); const bf16* KV = (const bf16*)(ws + WS_KV) + (size_t)l * 1024 * 512; bf16* MIX = (bf16*)(ws + WS_MIX);
    LAS unsigned char* vt = lds + wave * AT_WAVE_LDS; LAS float* bt = (LAS float*)(vt + 32 * AT_VP);
    for (int item = item0; item < (T / 32) * 4; item += item_stride) {
        const int h = item & 3, tt = item >> 2, t0 = tt * 32, b = t0 / SEQ; const int tokq = t0 + l31;
        asm volatile("s_waitcnt lgkmcnt(0)" ::: "memory");
#pragma unroll
        for (int i = 0; i < 4; ++i) bt[64 * i + lane] = gld<float>(p.mem_bias + (l * 4 + h) * NMEM + 64 * i + lane);
        bf16x8 qf[4], kn[4]; u32x4 vn[4];
#pragma unroll
        for (int ks = 0; ks < 4; ++ks) qf[ks] = gld<bf16x8>(P + (size_t)tokq * NPROJ + C_QM + h * 64 + 16 * ks + 8 * hi);
#define MA_LOADKV(jt_) do { const bf16* kvb_ = KV + (size_t)(b * NMEM + 32 * (jt_)) * 512; \
            _Pragma("unroll") for (int ks = 0; ks < 4; ++ks) kn[ks] = gld<bf16x8>(kvb_ + (size_t)l31 * 512 + h * 64 + 16 * ks + 8 * hi); \
            _Pragma("unroll") for (int it = 0; it < 4; ++it) vn[it] = gld<u32x4>(kvb_ + (size_t)(it * 8 + (lane >> 3)) * 512 + 256 + h * 64 + (lane & 7) * 8); } while (0)
        MA_LOADKV(0);
        AttnState st; st.m = -1e30f; st.l = 0.f; st.o0 = (f32x16){}; st.o1 = (f32x16){};
        for (int jt = 0; jt < 8; ++jt) {
            bf16x8 kc[4]; u32x4 vc[4];
#pragma unroll
            for (int i = 0; i < 4; ++i) { kc[i] = kn[i]; vc[i] = vn[i]; }
            if (jt + 1 < 8) MA_LOADKV(jt + 1);
#pragma unroll
            for (int it = 0; it < 4; ++it) *(LAS u32x4*)(vt + (it * 8 + (lane >> 3)) * AT_VP + (lane & 7) * 16) = vc[it];
            f32x16 S = {};
#pragma unroll
            for (int ks = 0; ks < 4; ++ks) S = __builtin_amdgcn_mfma_f32_32x32x16_bf16(kc[ks], qf[ks], S, 0, 0, 0);
#pragma unroll
            for (int rr = 0; rr < 16; ++rr) S[rr] += bt[32 * jt + crow(rr, hi)];
            attn_tile_update(st, S, 0xffffu, vt, lane);
        }
#undef MA_LOADKV
        const float lt = st.l + __shfl_xor(st.l, 32), inv = 1.f / lt;
#pragma unroll
        for (int dt = 0; dt < 2; ++dt)
#pragma unroll
            for (int rg = 0; rg < 4; ++rg) { const f32x16& o = dt ? st.o1 : st.o0; u32x2 w; w.x = pk2(o[4 * rg] * inv, o[4 * rg + 1] * inv); w.y = pk2(o[4 * rg + 2] * inv, o[4 * rg + 3] * inv);
                gst<u32x2>(MIX + (size_t)tokq * DM + 768 + h * 64 + dt * 32 + 8 * rg + 4 * hi, w); }
    }
}

__device__ __forceinline__ void stage_attn3(const Params& p, LAS unsigned char* lds, int blk, int nblk, int wv_) {
    const int tid = otid(), lane = tid & 63, wave = __builtin_amdgcn_readfirstlane(tid >> 6), hi = lane >> 5, l31 = lane & 31;
    unsigned char* ws = p.ws; const bf16* P = (const bf16*)(ws + WS_P); const float* BT = (const float*)(ws + WS_BIAST);
    bf16* AO = (bf16*)(ws + WS_ATTO); float* LSE = (float*)(ws + WS_LSE);
    LAS unsigned char* vt = lds + wave * AT_WAVE_LDS; LAS float* bt = (LAS float*)(vt + 32 * AT_VP);
    const int h = wave;
    for (int rnd = 0; rnd * nblk < 768; ++rnd) {
        const int c = blk, item = rnd * 128 + (c & 7) + 8 * ((c >> 3) >> 1), half = (c >> 3) & 1;
        if (nblk != 256 || item >= 384) { if (nblk == 256) break; }
        int it2 = item, hf2 = half;
        if (nblk != 256) { const int hitem = blk + rnd * nblk; if (hitem >= 768) break; it2 = hitem >> 1; hf2 = hitem & 1; }
        const int br = it2 >> 7, q7 = it2 & 127, b = q7 >> 5, q5 = q7 & 31;
        const int dil = br == 0 ? 1 : (br == 1 ? 4 : 16), r = br == 0 ? 0 : (br == 1 ? (q5 >> 3) : (q5 >> 1)), n = br == 0 ? q5 : (br == 1 ? (q5 & 7) : (q5 & 1));
        const int tokbase = b * SEQ + r, m0 = n * 128, a0 = 2 * hf2;
        asm volatile("s_waitcnt lgkmcnt(0)" ::: "memory");
#pragma unroll
        for (int i = 0; i < 3; ++i) { const int idx = lane + 64 * i, jj = idx - 32; bt[idx] = (jj >= 0 && jj <= 128) ? gld<float>(BT + (br * 8 + h) * 132 + 128 - jj) : -1e30f; }
        const int jlo = n == 0 ? 4 : a0, jhi = a0 + 5;
#define AT_LOADKV(jt_) do { const int mk0_ = m0 - 128 + 32 * (jt_); const bf16* kp_ = P + (size_t)(tokbase + (mk0_ + l31) * dil) * NPROJ + C_K + h * 64 + 8 * hi; \
            _Pragma("unroll") for (int ks = 0; ks < 4; ++ks) kn[ks] = gld<bf16x8>(kp_ + 16 * ks); \
            _Pragma("unroll") for (int it = 0; it < 4; ++it) vn[it] = gld<u32x4>(P + (size_t)(tokbase + (mk0_ + it * 8 + (lane >> 3)) * dil) * NPROJ + C_V + h * 64 + (lane & 7) * 8); } while (0)
        bf16x8 kn[4], q0[4], q1[4]; u32x4 vn[4];
        const int tokq0 = tokbase + (m0 + 32 * a0 + l31) * dil, tokq1 = tokq0 + 32 * dil;
#pragma unroll
        for (int ks = 0; ks < 4; ++ks) { q0[ks] = gld<bf16x8>(P + (size_t)tokq0 * NPROJ + C_Q + h * 64 + 8 * hi + 16 * ks); q1[ks] = gld<bf16x8>(P + (size_t)tokq1 * NPROJ + C_Q + h * 64 + 8 * hi + 16 * ks); }
        AT_LOADKV(jlo);
        AttnState s0, s1; s0.m = -1e30f; s0.l = 0.f; s0.o0 = (f32x16){}; s0.o1 = (f32x16){}; s1.m = -1e30f; s1.l = 0.f; s1.o0 = (f32x16){}; s1.o1 = (f32x16){};
        for (int jt = jlo; jt <= jhi; ++jt) {
            bf16x8 kc[4]; u32x4 vc[4];
#pragma unroll
            for (int i = 0; i < 4; ++i) { kc[i] = kn[i]; vc[i] = vn[i]; }
            if (jt < jhi) AT_LOADKV(jt + 1);
#pragma unroll
            for (int it = 0; it < 4; ++it) *(LAS u32x4*)(vt + (it * 8 + (lane >> 3)) * AT_VP + (lane & 7) * 16) = vc[it];
            if (jt <= a0 + 4) {
                f32x16 S = {};
#pragma unroll
                for (int ks = 0; ks < 4; ++ks) S = __builtin_amdgcn_mfma_f32_32x32x16_bf16(kc[ks], q0[ks], S, 0, 0, 0);
                const LAS float* rb = bt + 32 + 32 * (jt - a0) - l31 + 4 * hi;
#pragma unroll
                for (int rr = 0; rr < 16; ++rr) S[rr] += rb[(rr & 3) + 8 * (rr >> 2)];
                attn_tile_update(s0, S, 0u, vt, lane);
            }
            if (jt >= a0 + 1) {
                f32x16 S = {};
#pragma unroll
                for (int ks = 0; ks < 4; ++ks) S = __builtin_amdgcn_mfma_f32_32x32x16_bf16(kc[ks], q1[ks], S, 0, 0, 0);
                const LAS float* rb = bt + 32 + 32 * (jt - a0 - 1) - l31 + 4 * hi;
#pragma unroll
                for (int rr = 0; rr < 16; ++rr) S[rr] += rb[(rr & 3) + 8 * (rr >> 2)];
                attn_tile_update(s1, S, 0u, vt, lane);
            }
        }
#undef AT_LOADKV
#pragma unroll
        for (int qt = 0; qt < 2; ++qt) { const AttnState& st = qt ? s1 : s0; const int tokq = qt ? tokq1 : tokq0;
            const float lt = st.l + __shfl_xor(st.l, 32), inv = 1.f / lt;
#pragma unroll
            for (int dt = 0; dt < 2; ++dt)
#pragma unroll
                for (int rg = 0; rg < 4; ++rg) { const f32x16& o = dt ? st.o1 : st.o0; u32x2 w; w.x = pk2(o[4 * rg] * inv, o[4 * rg + 1] * inv); w.y = pk2(o[4 * rg + 2] * inv, o[4 * rg + 3] * inv);
                    gst<u32x2>(AO + ((size_t)br * T + tokq) * 512 + h * 64 + dt * 32 + 8 * rg + 4 * hi, w); }
            if (hi == 0) gst<float>(LSE + ((size_t)br * T + tokq) * 8 + h, st.m + __logf(lt)); }
    }
}

constexpr int CW_BAR = 4096;
#define XB_TMO      128
#define XB_XCNT(j)  (256  + 64 * (j))
#define XB_XSUB(j)  (1280 + 64 * (j))
#define XB_XGEN(j)  (2304 + 64 * (j))
#define XB_TOP      3328
#define XB_TOPGEN   3392
#define XCD_BAR_WORDS 3456
#define XB_SPIN_CAP (1u << 18)

__device__ __forceinline__ unsigned xb_ld(unsigned* p)              { return __hip_atomic_load(p, __ATOMIC_RELAXED, __HIP_MEMORY_SCOPE_AGENT); }
__device__ __forceinline__ unsigned xb_add(unsigned* p, unsigned v) { return __hip_atomic_fetch_add(p, v, __ATOMIC_RELAXED, __HIP_MEMORY_SCOPE_AGENT); }
__device__ __forceinline__ unsigned xb_xcc_id() { return (unsigned)__builtin_amdgcn_s_getreg((3 << 11) | 20) & 0xFu; }
#define XB_SPIN(cond, bar) do { unsigned _sp = 0; while (cond) { __builtin_amdgcn_s_sleep(1); \
    if ((++_sp & 255u) == 0u) { if (xb_ld(&(bar)[XB_TMO])) break; if (_sp > XB_SPIN_CAP) { atomicAdd(&(bar)[XB_TMO], 1u); break; } } } } while (0)

struct XcdBarrier {
    unsigned* bar; unsigned x;
    volatile LAS unsigned* st;
    bool leader;
};

__device__ __forceinline__ XcdBarrier xcd_barrier_post(unsigned* bar, volatile LAS unsigned* st) {
    XcdBarrier b; b.bar = bar; b.x = xb_xcc_id(); b.st = st; b.leader = (threadIdx.x == 0);
    if (threadIdx.x == 0) (void)xb_add(&bar[XB_XCNT(b.x)], 1u);
    return b;
}
__device__ __forceinline__ void xcd_barrier_complete(unsigned* bar, unsigned x, unsigned& nloc, unsigned& nx) {
    const unsigned G = gridDim.x * gridDim.y * gridDim.z;
    unsigned sum, cnt, mine, sp = 0u;
    for (;;) {
        sum = 0u; cnt = 0u; mine = 0u;
#pragma unroll
        for (unsigned j = 0; j < 16; ++j) { const unsigned c = xb_ld(&bar[XB_XCNT(j)]); sum += c; cnt += (c > 0u) ? 1u : 0u; mine = (j == x) ? c : mine; }
        if (sum == G) break;
        __builtin_amdgcn_s_sleep(1);
        if ((++sp & 255u) == 0u) { if (xb_ld(&bar[XB_TMO])) break; if (sp > XB_SPIN_CAP) { atomicAdd(&bar[XB_TMO], 1u); break; } }
    }
    nloc = mine > 0u ? mine : 1u; nx = cnt > 0u ? cnt : 1u;
}

__device__ __forceinline__ void xcd_barrier(const XcdBarrier& b) {
    asm volatile("s_waitcnt vmcnt(0)" ::: "memory");
    __syncthreads();
    if (b.leader) {
        unsigned* bar = b.bar;
        __builtin_amdgcn_s_waitcnt(0);
        unsigned nloc = b.st[0], nx = b.st[1];
        if (nloc == 0u) { xcd_barrier_complete(bar, b.x, nloc, nx); b.st[0] = nloc; b.st[1] = nx; }
        const unsigned old = xb_add(&bar[XB_XSUB(b.x)], 1u);
        const unsigned gen = old / nloc;
        if (old + 1u == (gen + 1u) * nloc) {
            __builtin_amdgcn_fence(__ATOMIC_RELEASE, "agent");
            asm volatile("s_waitcnt vmcnt(0)" ::: "memory");
            const unsigned og = xb_add(&bar[XB_TOP], 1u);
            const unsigned tg = og / nx;
            if (og + 1u == (tg + 1u) * nx) xb_add(&bar[XB_TOPGEN], 1u);
            else XB_SPIN(xb_ld(&bar[XB_TOPGEN]) == tg, bar);
            __builtin_amdgcn_fence(__ATOMIC_ACQUIRE, "agent");
            xb_add(&bar[XB_XGEN(b.x)], 1u);
            asm volatile("s_waitcnt vmcnt(0)" ::: "memory");
        } else {
            XB_SPIN(xb_ld(&bar[XB_XGEN(b.x)]) == gen, bar);
            __builtin_amdgcn_fence(__ATOMIC_ACQUIRE, "agent");
            asm volatile("s_waitcnt vmcnt(0)" ::: "memory");
        }
    }
    __syncthreads();
}

constexpr int RING_BYTES = 131072;
constexpr int LDS_BYTES = 147456;
constexpr int LDSCTL_OFF = LDS_BYTES - 512;
constexpr int MISC_OFF = LDSCTL_OFF;
constexpr int LDS_BYTES_UNUSED_ = 0;


__device__ __forceinline__ void launder(Params& q) {
#define LND(f) do { asm volatile("" : "+s"(q.f)); q.f = (decltype(q.f))(const GAS void*)q.f; } while (0)
    LND(x); LND(mem); LND(w_in); LND(w_out); LND(rel_bias); LND(conv_w); LND(conv_b); LND(dt_bias); LND(a_log); LND(d_skip); LND(ssd_norm_w); LND(w_mem_kv); LND(mem_bias);
    LND(ln1_g); LND(ln1_b); LND(ln2_g); LND(ln2_b); LND(w_router); LND(b_router); LND(w_gate); LND(w_up); LND(w_down); LND(out); LND(ws);
#undef LND
}
constexpr int PROBE_STOP = -1;
__global__ void __launch_bounds__(NTHREADS, 2) mega_fwd(Params p, int stop) {
    extern __shared__ __attribute__((aligned(16))) unsigned char lds_raw[];
    LAS unsigned char* lds = (LAS unsigned char*)lds_raw;
    const int tid = threadIdx.x, blk = blockIdx.x, nblk = gridDim.x; const int wv_ = __builtin_amdgcn_readfirstlane(tid >> 6);
    for (int u = tid; u < (LDS_BYTES - LDSCTL_OFF) / 4; u += NTHREADS) ((LAS unsigned*)(lds + LDSCTL_OFF))[u] = 0u;
    __syncthreads();
    volatile LAS unsigned* MISC = (volatile LAS unsigned*)(lds + MISC_OFF);
    (void)xcd_barrier_post((unsigned*)(p.ws + WS_CTL) + CW_BAR, MISC + 8);
#define GRID_BAR() do { XcdBarrier b_; b_.bar = (unsigned*)(p.ws + WS_CTL) + CW_BAR; b_.x = xb_xcc_id(); b_.st = (volatile LAS unsigned*)(lds + MISC_OFF) + 8; b_.leader = (otid() == 0); xcd_barrier(b_); } while (0)
    stage_prologue(p, lds, blk, nblk, wv_);
    if (stop == 0) return;
    GRID_BAR();
#pragma unroll 1
    for (int l = 0; l < DEPTH; ++l) {
        Params q = p; launder(q);
        stage_proj(q, lds, l, blk, nblk, wv_);
        if (stop == l * 10 + 1) return;
        GRID_BAR();
        stage_ssd1(q, lds, l, blk, nblk, wv_); if (stop == 100 + l * 10 + 1) return; stage_attn3(q, lds, blk, nblk, wv_); if (stop == 100 + l * 10 + 2) return; stage_memattn2(q, lds, l, blk * NWAVES + wv_, nblk * NWAVES, wv_);
        if (stop == l * 10 + 2) return;
        GRID_BAR();
        stage_ssd_scan2(q, blk, nblk, wv_); stage_merge2(q, blk, nblk, wv_);
        if (stop == l * 10 + 3) return;
        GRID_BAR();
        stage_ssd3(q, lds, l, blk, nblk, wv_);
        if (stop == l * 10 + 4) return;
        GRID_BAR();
        stage_out(q, lds, l, blk, nblk, wv_);
        if (stop == l * 10 + 5) return;
        GRID_BAR();
        stage_ln1_router2(q, lds, l, blk, nblk, wv_);
        if (stop == l * 10 + 6) return;
        GRID_BAR();
        stage_moe1(q, lds, l, blk, nblk, wv_);
        if (stop == l * 10 + 7) return;
        GRID_BAR();
        stage_moe2(q, lds, l, blk, nblk, wv_);
        if (stop == l * 10 + 8) return;
        GRID_BAR();
        stage_ln2b(q, lds, l, blk, nblk, wv_);
        if (l + 1 < DEPTH) GRID_BAR();
    }
}

extern "C" void kernel_launch(void* const* d_in, const int* in_sizes, int n_in, void* d_out, int out_size, void* d_ws, size_t ws_size, hipStream_t stream) {
    if (n_in != 22 || out_size != T * DM || ws_size < WS_END) { fprintf(stderr, "kernel_launch: unexpected shapes (n_in %d out %d ws %zu)\n", n_in, out_size, ws_size); return; }
    static int grid = 0;
    if (grid == 0) {
        int dev = 0, cus = 0, per_cu = 0;
        if (hipGetDevice(&dev) != hipSuccess || hipDeviceGetAttribute(&cus, hipDeviceAttributeMultiprocessorCount, dev) != hipSuccess) { grid = -1; return; }
        if (hipFuncSetAttribute((const void*)mega_fwd, hipFuncAttributeMaxDynamicSharedMemorySize, LDS_BYTES) != hipSuccess) { fprintf(stderr, "kernel_launch: hipFuncSetAttribute failed\n"); grid = -1; return; }
        if (hipOccupancyMaxActiveBlocksPerMultiprocessor(&per_cu, (const void*)mega_fwd, NTHREADS, LDS_BYTES) != hipSuccess || per_cu < 1) fprintf(stderr, "kernel_launch: occupancy query reports %d\n", per_cu);
        (void)hipGetLastError();
        grid = cus;
    }
    if (grid < 0) return;
    Params p{};
    const float** pp = (const float**)&p;
    for (int i = 0; i < 22; ++i) pp[i] = (const float*)d_in[i];
    p.out = (float*)d_out; p.ws = (unsigned char*)d_ws;
    (void)hipMemsetAsync((char*)d_ws + WS_CTL, 0, CTL_ZERO_BYTES, stream);
    if (PROBE_STOP >= 0) { hipLaunchKernelGGL(mega_fwd, dim3(grid), dim3(NTHREADS), LDS_BYTES, stream, p, PROBE_STOP); (void)hipMemsetAsync((char*)d_ws + WS_CTL, 0, CTL_ZERO_BYTES, stream); }
    hipLaunchKernelGGL(mega_fwd, dim3(grid), dim3(NTHREADS), LDS_BYTES, stream, p, 1000);
}
```

```cpp
#include <hip/hip_runtime.h>
#include <cstdio>
#include <cstdint>

#define GAS __attribute__((address_space(1)))
#define LAS __attribute__((address_space(3)))
typedef unsigned short bf16;
typedef short bf16x8 __attribute__((ext_vector_type(8)));
typedef float f32x4 __attribute__((ext_vector_type(4)));
typedef float f32x2 __attribute__((ext_vector_type(2)));
typedef float f32x16 __attribute__((ext_vector_type(16)));
typedef unsigned u32x4 __attribute__((ext_vector_type(4)));
typedef unsigned u32x2 __attribute__((ext_vector_type(2)));

constexpr int NB = 4, SEQ = 4096, T = NB * SEQ, DM = 1024, DEPTH = 2;
constexpr int NCOLS_IN = 2820, NPROJ = 2816;
constexpr int C_Q = 0, C_K = 512, C_V = 1024, C_Z = 1536, C_XBC = 1792, C_QM = 2560;
constexpr int NE = 16, NMEM = 256;
constexpr int HROWS = 36864;
constexpr float ALPHA = 1.41421356237309515f;
constexpr float LN_EPS = 1e-5f, RMS_EPS = 1e-5f;
constexpr int NTHREADS = 512, NWAVES = 8;

constexpr size_t MiB = 1u << 20;
constexpr size_t WS_CTL = 0, CTL_ZERO_BYTES = 1 * MiB;
constexpr size_t WS_BIAST = 1 * MiB;
constexpr size_t WS_KV = 2 * MiB;
constexpr size_t WS_MEMB = 4 * MiB;
constexpr size_t WS_WT_KV = 6 * MiB;
constexpr size_t WS_WT_OUT = 8 * MiB;
constexpr size_t WS_WT_IN = 12 * MiB;
constexpr size_t WS_WT_GU = 24 * MiB;
constexpr size_t WS_WT_DN = 152 * MiB;
constexpr size_t WS_XB = 216 * MiB;
constexpr size_t WS_MIX = 248 * MiB;
constexpr size_t WS_DT = 280 * MiB;
constexpr size_t WS_TOKE = 281 * MiB;
constexpr size_t WS_TOKP = WS_TOKE + 128 * 1024;
constexpr size_t WS_TOKW = WS_TOKP + 128 * 1024;
constexpr size_t WS_LIST = 282 * MiB;
constexpr size_t WS_SST = 284 * MiB;
constexpr size_t WS_P = 300 * MiB;
constexpr size_t WS_ATTO = 388 * MiB;
constexpr size_t WS_LSE = 436 * MiB;
constexpr size_t WS_H = 300 * MiB;
constexpr size_t WS_Y = 372 * MiB;
constexpr size_t WS_XBCC = 444 * MiB;
constexpr size_t WS_YS = 492 * MiB;
constexpr size_t WS_END = 508 * MiB;
constexpr int CW_CNT = 64;

struct Params {
    const float *x, *mem, *w_in, *w_out, *rel_bias, *conv_w, *conv_b, *dt_bias, *a_log, *d_skip, *ssd_norm_w, *w_mem_kv, *mem_bias,
        *ln1_g, *ln1_b, *ln2_g, *ln2_b, *w_router, *b_router, *w_gate, *w_up, *w_down;
    float* out; unsigned char* ws;
};

__device__ __forceinline__ int otid_w(int wv) { int t; asm volatile("v_mbcnt_lo_u32_b32 %0, -1, 0\n\tv_mbcnt_hi_u32_b32 %0, -1, %0\n\tv_lshl_add_u32 %0, %1, 6, %0" : "=&v"(t) : "s"(wv)); return t; }
#define otid() otid_w(wv_)
__device__ __forceinline__ unsigned f2bf(float f) { unsigned u = __builtin_bit_cast(unsigned, f); return (u + 0x7fffu + ((u >> 16) & 1u)) >> 16; }
__device__ __forceinline__ unsigned pk2(float lo, float hi) { unsigned r; asm("v_cvt_pk_bf16_f32 %0, %1, %2" : "=v"(r) : "v"(lo), "v"(hi)); return r; }
__device__ __forceinline__ float bf2f(unsigned b) { return __builtin_bit_cast(float, b << 16); }
__device__ __forceinline__ float bflo(unsigned w) { return __builtin_bit_cast(float, w << 16); }
__device__ __forceinline__ float bfhi(unsigned w) { return __builtin_bit_cast(float, w & 0xffff0000u); }
__device__ __forceinline__ float dpp_f(float x, int ctrl_sel) {
    const int xi = __builtin_bit_cast(int, x);
    int r;
    if (ctrl_sel == 0) r = __builtin_amdgcn_update_dpp(0, xi, 0xB1, 0xf, 0xf, true);
    else if (ctrl_sel == 1) r = __builtin_amdgcn_update_dpp(0, xi, 0x4E, 0xf, 0xf, true);
    else if (ctrl_sel == 2) r = __builtin_amdgcn_update_dpp(0, xi, 0x141, 0xf, 0xf, true);
    else r = __builtin_amdgcn_update_dpp(0, xi, 0x140, 0xf, 0xf, true);
    return __builtin_bit_cast(float, r);
}
__device__ __forceinline__ float wave_sum(float v) {
    v += dpp_f(v, 0); v += dpp_f(v, 1); v += dpp_f(v, 2); v += dpp_f(v, 3);
    const int vi = __builtin_bit_cast(int, v);
    const float a = __builtin_bit_cast(float, __builtin_amdgcn_readlane(vi, 0)), b = __builtin_bit_cast(float, __builtin_amdgcn_readlane(vi, 16));
    const float c = __builtin_bit_cast(float, __builtin_amdgcn_readlane(vi, 32)), d = __builtin_bit_cast(float, __builtin_amdgcn_readlane(vi, 48));
    return (a + b) + (c + d);
}
__device__ __forceinline__ float wave_max(float v) {
#pragma unroll
    for (int o = 1; o < 64; o <<= 1) v = fmaxf(v, __shfl_xor(v, o));
    return v;
}
__device__ __forceinline__ float silu_f(float v) { return v / (1.f + __expf(-v)); }
__device__ __forceinline__ float softplus_f(float v) { return v > 20.f ? v : log1pf(__expf(v)); }
__device__ __forceinline__ int crow(int r, int hi) { return (r & 3) + 8 * (r >> 2) + 4 * hi; }

template <class TT> __device__ __forceinline__ TT gld(const void* ptr) { return *(const GAS TT*)ptr; }
template <class TT> __device__ __forceinline__ void gst(void* ptr, TT v) { *(GAS TT*)ptr = v; }
__device__ __forceinline__ void transpose_item(const float* W, int ldw, int src_col0, bf16* WT, int K, int dst_row0, float scale, LAS float* scr, int k0, int lane) {
    f32x4 v[16];
#pragma unroll
    for (int i = 0; i < 16; ++i) v[i] = __builtin_nontemporal_load((const GAS f32x4*)(W + (size_t)(k0 + 4 * i + (lane >> 4)) * ldw + src_col0 + 4 * (lane & 15)));
#pragma unroll
    for (int i = 0; i < 16; ++i) { LAS float* d = scr + (4 * i + (lane >> 4)) * 65 + 4 * (lane & 15); d[0] = v[i].x; d[1] = v[i].y; d[2] = v[i].z; d[3] = v[i].w; }
    asm volatile("s_waitcnt lgkmcnt(0)" ::: "memory");
    const int c = lane >> 3, nn = lane & 7;
#pragma unroll
    for (int jj = 0; jj < 8; ++jj) { const int n = nn + 8 * jj; const LAS float* sp = scr + (8 * c) * 65 + n;
        u32x4 o; o.x = pk2(sp[0 * 65] * scale, sp[1 * 65] * scale); o.y = pk2(sp[2 * 65] * scale, sp[3 * 65] * scale); o.z = pk2(sp[4 * 65] * scale, sp[5 * 65] * scale); o.w = pk2(sp[6 * 65] * scale, sp[7 * 65] * scale);
        *(u32x4*)(WT + (size_t)(dst_row0 + n) * K + k0 + 8 * c) = o; }
    asm volatile("s_waitcnt lgkmcnt(0)" ::: "memory");
}
constexpr int I_IN = 2 * 16 * 44, I_OUT = 2 * 16 * 16, I_KV = 2 * 16 * 8, I_GU = 32 * 16 * 32, I_DN = 32 * 16 * 16;
constexpr int I_TOTAL = I_IN + I_OUT + I_KV + I_GU + I_DN;

__device__ __forceinline__ void stage_prologue(const Params& p, LAS unsigned char* lds, int blk, int nblk, int wv_) {
    const int tid = otid(), lane = tid & 63, wave = tid >> 6;
    const int gw = blk * NWAVES + wave, ngw = nblk * NWAVES;
    LAS float* scr = (LAS float*)(lds + wave * 16640);
    unsigned char* ws = p.ws;
    for (int it = gw; it < I_TOTAL; it += ngw) {
        int r = it;
        if (r < I_IN) { const int l = r / (16 * 44), q = r % (16 * 44), kb = q % 16, nb = q / 16, n0 = nb * 64;
            transpose_item(p.w_in + (size_t)l * DM * NCOLS_IN, NCOLS_IN, n0 < 2560 ? n0 : n0 + 4, (bf16*)(ws + WS_WT_IN) + (size_t)l * NPROJ * DM, DM, n0, (n0 < 512 || n0 >= 2560) ? 0.125f : 1.f, scr, kb * 64, lane); continue; }
        r -= I_IN;
        if (r < I_OUT) { const int l = r / (16 * 16), q = r % (16 * 16), kb = q % 16, nb = q / 16;
            transpose_item(p.w_out + (size_t)l * DM * DM, DM, nb * 64, (bf16*)(ws + WS_WT_OUT) + (size_t)l * DM * DM, DM, nb * 64, 1.f, scr, kb * 64, lane); continue; }
        r -= I_OUT;
        if (r < I_KV) { const int l = r / (16 * 8), q = r % (16 * 8), kb = q % 16, nb = q / 16;
            transpose_item(p.w_mem_kv + (size_t)l * DM * 512, 512, nb * 64, (bf16*)(ws + WS_WT_KV) + (size_t)l * 512 * DM, DM, nb * 64, 1.f, scr, kb * 64, lane); continue; }
        r -= I_KV;
        if (r < I_GU) { const int le = r / (16 * 32), q = r % (16 * 32), kb = q % 16, nb = q / 16, n0 = nb * 64, pn = n0 >> 8, bj = (n0 >> 7) & 1, j0 = n0 & 127;
            transpose_item((bj ? p.w_up : p.w_gate) + (size_t)le * DM * DM, DM, 128 * pn + j0, (bf16*)(ws + WS_WT_GU) + (size_t)le * 2048 * DM, DM, n0, 1.f, scr, kb * 64, lane); continue; }
        r -= I_GU;
        { const int le = r / (16 * 16), q = r % (16 * 16), kb = q % 16, nb = q / 16;
            transpose_item(p.w_down + (size_t)le * DM * DM, DM, nb * 64, (bf16*)(ws + WS_WT_DN) + (size_t)le * DM * DM, DM, nb * 64, 1.f, scr, kb * 64, lane); }
    }
    {
        bf16* XB = (bf16*)(ws + WS_XB); float* DT = (float*)(ws + WS_DT);
        for (int m = 2 * gw; m < T; m += 2 * ngw) {
            const f32x4* xr = (const f32x4*)(p.x + (size_t)m * DM) + lane;
            f32x4 va[4], vb[4];
#pragma unroll
            for (int j = 0; j < 4; ++j) { va[j] = xr[64 * j]; vb[j] = xr[DM / 4 + 64 * j]; }
            float d0 = 0.f, d1 = 0.f, d2 = 0.f, d3 = 0.f, f0 = 0.f, f1 = 0.f, f2 = 0.f, f3 = 0.f;
#pragma unroll
            for (int j = 0; j < 4; ++j) {
                u32x2 o; o.x = pk2(va[j].x, va[j].y); o.y = pk2(va[j].z, va[j].w); *((u32x2*)(XB + (size_t)m * DM) + lane + 64 * j) = o;
                o.x = pk2(vb[j].x, vb[j].y); o.y = pk2(vb[j].z, vb[j].w); *((u32x2*)(XB + (size_t)(m + 1) * DM) + lane + 64 * j) = o;
#pragma unroll
                for (int c = 0; c < 4; ++c) { const int k = 4 * lane + 256 * j + c; const f32x4 w = *(const f32x4*)(p.w_in + (size_t)k * NCOLS_IN + 2560); const float xa = va[j][c], xc = vb[j][c];
                    d0 += xa * w.x; d1 += xa * w.y; d2 += xa * w.z; d3 += xa * w.w; f0 += xc * w.x; f1 += xc * w.y; f2 += xc * w.z; f3 += xc * w.w; } }
            d0 = wave_sum(d0); d1 = wave_sum(d1); d2 = wave_sum(d2); d3 = wave_sum(d3); f0 = wave_sum(f0); f1 = wave_sum(f1); f2 = wave_sum(f2); f3 = wave_sum(f3);
            if (lane == 0) { *(f32x4*)(DT + (size_t)m * 4) = (f32x4){d0, d1, d2, d3}; *(f32x4*)(DT + (size_t)(m + 1) * 4) = (f32x4){f0, f1, f2, f3}; }
        }
    }
    {
        bf16* MB = (bf16*)(ws + WS_MEMB);
        for (int m = gw; m < NB * NMEM; m += ngw) {
            const f32x4* xr = (const f32x4*)(p.mem + (size_t)m * DM) + lane;
#pragma unroll
            for (int j = 0; j < 4; ++j) { const f32x4 v = xr[64 * j]; u32x2 o; o.x = pk2(v.x, v.y); o.y = pk2(v.z, v.w); *((u32x2*)(MB + (size_t)m * DM) + lane + 64 * j) = o; }
        }
    }
    if (blk == 0) {
        float* BT = (float*)(ws + WS_BIAST);
        for (int i = tid; i < 3 * 129; i += NTHREADS) { const int br = i / 129, st = i % 129, dil = br == 0 ? 1 : (br == 1 ? 4 : 16), n = st * dil; int bucket;
            if (n < 16) bucket = n; else { const float nf = (float)n; int lg = 16 + (int)(logf(nf / 16.f) / logf(128.f) * 16.f); bucket = lg < 31 ? lg : 31; }
#pragma unroll
            for (int h = 0; h < 8; ++h) BT[(br * 8 + h) * 132 + st] = p.rel_bias[bucket * 8 + h]; }
    }
}

template <class RowPtr, class Epi>
__device__ __forceinline__ void wave_gemm_tile(RowPtr arow  , const bf16* brow  , int K, int lane, Epi epi) {
    const int hi = lane >> 5;
    const bf16* ap = arow + 8 * hi; const bf16* bp = brow + 8 * hi;
    f32x16 acc = {};
    for (int k0 = 0; k0 < K; k0 += 16) { const bf16x8 a = *(const bf16x8*)(ap + k0); const bf16x8 b = *(const bf16x8*)(bp + k0); acc = __builtin_amdgcn_mfma_f32_32x32x16_bf16(b, a, acc, 0, 0, 0); }
#pragma unroll
    for (int g = 0; g < 4; ++g) epi(8 * g + 4 * hi, acc[4 * g], acc[4 * g + 1], acc[4 * g + 2], acc[4 * g + 3]);
}

__device__ __forceinline__ void stage_proj_ref(const Params& p, int l, int blk, int nblk, int wv_) {
    const int tid = otid(), lane = tid & 63, wave = tid >> 6, gw = blk * NWAVES + wave, ngw = nblk * NWAVES;
    unsigned char* ws = p.ws;
    const bf16* XB = (const bf16*)(ws + WS_XB); const bf16* WT = (const bf16*)(ws + WS_WT_IN) + (size_t)l * NPROJ * DM; bf16* P = (bf16*)(ws + WS_P);
    constexpr int NT = NPROJ / 32, MT = T / 32;
    for (int tile = gw; tile < MT * NT; tile += ngw) { const int tm = tile / NT, tn = tile % NT; const int m = tm * 32 + (lane & 31);
        wave_gemm_tile(XB + (size_t)m * DM, WT + (size_t)(tn * 32 + (lane & 31)) * DM, DM, lane, [&](int nn, float a, float b, float c, float d) {
            u32x2 o; o.x = pk2(a, b); o.y = pk2(c, d); *(u32x2*)(P + (size_t)m * NPROJ + tn * 32 + nn) = o; }); }
    if (l == 0) {
        const bf16* MB = (const bf16*)(ws + WS_MEMB);
        constexpr int NT2 = 512 / 32, MT2 = NB * NMEM / 32;
        for (int tile = gw; tile < 2 * MT2 * NT2; tile += ngw) { const int ll = tile / (MT2 * NT2), q = tile % (MT2 * NT2), tm = q / NT2, tn = q % NT2; const int m = tm * 32 + (lane & 31);
            const bf16* WK = (const bf16*)(ws + WS_WT_KV) + (size_t)ll * 512 * DM; bf16* KV = (bf16*)(ws + WS_KV) + (size_t)ll * 1024 * 512;
            wave_gemm_tile(MB + (size_t)m * DM, WK + (size_t)(tn * 32 + (lane & 31)) * DM, DM, lane, [&](int nn, float a, float b, float c, float d) {
                u32x2 o; o.x = pk2(a, b); o.y = pk2(c, d); *(u32x2*)(KV + (size_t)m * 512 + tn * 32 + nn) = o; }); }
    }
}

__device__ __forceinline__ float dot64(const bf16* row, const unsigned (&qw)[32]) {
    float s = 0.f;
#pragma unroll
    for (int c = 0; c < 8; ++c) { const u32x4 kv = *(const u32x4*)(row + 8 * c);
        s += bflo(kv.x) * bflo(qw[4 * c]) + bfhi(kv.x) * bfhi(qw[4 * c]); s += bflo(kv.y) * bflo(qw[4 * c + 1]) + bfhi(kv.y) * bfhi(qw[4 * c + 1]);
        s += bflo(kv.z) * bflo(qw[4 * c + 2]) + bfhi(kv.z) * bfhi(qw[4 * c + 2]); s += bflo(kv.w) * bflo(qw[4 * c + 3]) + bfhi(kv.w) * bfhi(qw[4 * c + 3]); }
    return s;
}
__device__ __forceinline__ void stage_attn_ref(const Params& p, int l, int blk, int nblk, int wv_) {
    const int tid = otid(), lane = tid & 63, wave = tid >> 6, gw = blk * NWAVES + wave, ngw = nblk * NWAVES;
    unsigned char* ws = p.ws; const bf16* P = (const bf16*)(ws + WS_P); const float* BT = (const float*)(ws + WS_BIAST);
    bf16* AO = (bf16*)(ws + WS_ATTO); float* LSE = (float*)(ws + WS_LSE);
    for (int task = gw; task < 3 * T * 8; task += ngw) {
        const int br = task / (T * 8), q = task % (T * 8), t = q >> 3, h = q & 7, s = t % SEQ, dil = br == 0 ? 1 : (br == 1 ? 4 : 16);
        unsigned qw[32];
        { const u32x4* qp = (const u32x4*)(P + (size_t)t * NPROJ + C_Q + h * 64);
#pragma unroll
            for (int c = 0; c < 8; ++c) { const u32x4 v = qp[c]; qw[4 * c] = v.x; qw[4 * c + 1] = v.y; qw[4 * c + 2] = v.z; qw[4 * c + 3] = v.w; } }
        float sc[3];
#pragma unroll
        for (int kk = 0; kk < 3; ++kk) { const int st = lane + 64 * kk; const bool valid = st <= 128 && s - st * dil >= 0; sc[kk] = -INFINITY;
            if (valid) sc[kk] = dot64(P + (size_t)(t - st * dil) * NPROJ + C_K + h * 64, qw) + BT[(br * 8 + h) * 132 + st]; }
        const float mx = wave_max(fmaxf(fmaxf(sc[0], sc[1]), sc[2]));
        float pr[3], ls = 0.f;
#pragma unroll
        for (int kk = 0; kk < 3; ++kk) { pr[kk] = __expf(sc[kk] - mx); ls += pr[kk]; }
        ls = wave_sum(ls);
        float o = 0.f;
        const int nst = min(128, s / dil);
        for (int st = 0; st <= nst; ++st) { const float pj = __shfl(st < 64 ? pr[0] : (st < 128 ? pr[1] : pr[2]), st & 63);
            o += pj * bf2f(P[(size_t)(t - st * dil) * NPROJ + C_V + h * 64 + lane]); }
        AO[((size_t)br * T + t) * 512 + h * 64 + lane] = (bf16)f2bf(o / ls);
        if (lane == 0) LSE[((size_t)br * T + t) * 8 + h] = mx + __logf(ls);
    }
}
__device__ __forceinline__ void stage_merge(const Params& p, int blk, int nblk, int wv_) {
    const int tid = otid(), lane = tid & 63, wave = tid >> 6, gw = blk * NWAVES + wave, ngw = nblk * NWAVES;
    unsigned char* ws = p.ws; const bf16* AO = (const bf16*)(ws + WS_ATTO); const float* LSE = (const float*)(ws + WS_LSE); bf16* MIX = (bf16*)(ws + WS_MIX);
    for (int t = gw; t < T; t += ngw) {
        const int h = lane >> 3;
        const float l0 = LSE[((size_t)0 * T + t) * 8 + h], l1 = LSE[((size_t)1 * T + t) * 8 + h], l2 = LSE[((size_t)2 * T + t) * 8 + h];
        const float mx = fmaxf(fmaxf(l0, l1), l2); float w0 = __expf(l0 - mx), w1 = __expf(l1 - mx), w2 = __expf(l2 - mx); const float inv = 1.f / (w0 + w1 + w2); w0 *= inv; w1 *= inv; w2 *= inv;
        const u32x4 a = *(const u32x4*)(AO + ((size_t)0 * T + t) * 512 + lane * 8), b = *(const u32x4*)(AO + ((size_t)1 * T + t) * 512 + lane * 8), c = *(const u32x4*)(AO + ((size_t)2 * T + t) * 512 + lane * 8);
        u32x4 o;
#pragma unroll
        for (int i = 0; i < 4; ++i) o[i] = pk2(w0 * bflo(a[i]) + w1 * bflo(b[i]) + w2 * bflo(c[i]), w0 * bfhi(a[i]) + w1 * bfhi(b[i]) + w2 * bfhi(c[i]));
        *(u32x4*)(MIX + (size_t)t * DM + lane * 8) = o;
    }
}
__device__ __forceinline__ void stage_memattn_ref(const Params& p, int l, int blk, int nblk, int wv_) {
    const int tid = otid(), lane = tid & 63, wave = tid >> 6, gw = blk * NWAVES + wave, ngw = nblk * NWAVES;
    unsigned char* ws = p.ws; const bf16* P = (const bf16*)(ws + WS_P); const bf16* KV = (const bf16*)(ws + WS_KV) + (size_t)l * 1024 * 512; bf16* MIX = (bf16*)(ws + WS_MIX);
    for (int task = gw; task < T * 4; task += ngw) {
        const int t = task >> 2, h = task & 3, b = t / SEQ;
        unsigned qw[32];
        { const u32x4* qp = (const u32x4*)(P + (size_t)t * NPROJ + C_QM + h * 64);
#pragma unroll
            for (int c = 0; c < 8; ++c) { const u32x4 v = qp[c]; qw[4 * c] = v.x; qw[4 * c + 1] = v.y; qw[4 * c + 2] = v.z; qw[4 * c + 3] = v.w; } }
        float sc[4];
#pragma unroll
        for (int kk = 0; kk < 4; ++kk) { const int j = lane + 64 * kk; sc[kk] = dot64(KV + (size_t)(b * NMEM + j) * 512 + h * 64, qw) + p.mem_bias[(l * 4 + h) * NMEM + j]; }
        const float mx = wave_max(fmaxf(fmaxf(sc[0], sc[1]), fmaxf(sc[2], sc[3])));
        float pr[4], ls = 0.f;
#pragma unroll
        for (int kk = 0; kk < 4; ++kk) { pr[kk] = __expf(sc[kk] - mx); ls += pr[kk]; }
        ls = wave_sum(ls);
        float o = 0.f;
        for (int j = 0; j < NMEM; ++j) { const int kk = j >> 6; const float pj = __shfl(kk == 0 ? pr[0] : (kk == 1 ? pr[1] : (kk == 2 ? pr[2] : pr[3])), j & 63);
            o += pj * bf2f(KV[(size_t)(b * NMEM + j) * 512 + 256 + h * 64 + lane]); }
        MIX[(size_t)t * DM + 768 + h * 64 + lane] = (bf16)f2bf(o / ls);
    }
}
__device__ __forceinline__ void stage_conv_ref(const Params& p, int l, int blk, int nblk, int wv_) {
    unsigned char* ws = p.ws; const bf16* P = (const bf16*)(ws + WS_P); float* XC = (float*)(ws + WS_XBCC);
    const float* cw = p.conv_w + (size_t)l * 4 * 768; const float* cb = p.conv_b + (size_t)l * 768;
    for (size_t i = (size_t)blk * NTHREADS + otid(); i < (size_t)T * 768; i += (size_t)nblk * NTHREADS) {
        const int t = (int)(i / 768), c = (int)(i % 768), s = t % SEQ; float a = cb[c];
#pragma unroll
        for (int k = 0; k < 4; ++k) { const int sp = s + k - 3; if (sp >= 0) a += cw[k * 768 + c] * bf2f(P[(size_t)(t + k - 3) * NPROJ + C_XBC + c]); }
        XC[i] = silu_f(a);
    }
}
__device__ __forceinline__ void stage_ssd_ref(const Params& p, int l, int blk, int nblk, int wv_) {
    unsigned char* ws = p.ws; const float* XC = (const float*)(ws + WS_XBCC); const float* DT = (const float*)(ws + WS_DT); float* YS = (float*)(ws + WS_YS);
    const int tid = otid();
    for (int u = blk; u < NB * 4; u += nblk) {
        const int b = u >> 2, h = u & 3, g = h >> 1, pp = tid >> 3, ns = (tid & 7) * 16;
        const float a = -__expf(p.a_log[l * 4 + h]), dtb = p.dt_bias[l * 4 + h], Dh = p.d_skip[l * 4 + h];
        float hst[16];
#pragma unroll
        for (int i = 0; i < 16; ++i) hst[i] = 0.f;
        for (int s = 0; s < SEQ; ++s) { const size_t t = (size_t)b * SEQ + s;
            const float dt = softplus_f(DT[t * 4 + h] + dtb), da = __expf(a * dt);
            const float xv = XC[t * 768 + h * 64 + pp], xd = xv * dt;
            const f32x4* Bp = (const f32x4*)(XC + t * 768 + 256 + g * 128 + ns); const f32x4* Cp = (const f32x4*)(XC + t * 768 + 512 + g * 128 + ns);
            float acc = 0.f;
#pragma unroll
            for (int i4 = 0; i4 < 4; ++i4) { const f32x4 bv = Bp[i4], cv = Cp[i4];
#pragma unroll
                for (int c = 0; c < 4; ++c) { float& hh = hst[4 * i4 + c]; hh = hh * da + xd * bv[c]; acc += cv[c] * hh; } }
            acc += __shfl_xor(acc, 1); acc += __shfl_xor(acc, 2); acc += __shfl_xor(acc, 4);
            if ((tid & 7) == 0) YS[t * 256 + h * 64 + pp] = acc + Dh * xv;
        }
    }
}
__device__ __forceinline__ void stage_gate_ref(const Params& p, int l, int blk, int nblk, int wv_) {
    const int tid = otid(), lane = tid & 63, wave = tid >> 6, gw = blk * NWAVES + wave, ngw = nblk * NWAVES;
    unsigned char* ws = p.ws; const bf16* P = (const bf16*)(ws + WS_P); const float* YS = (const float*)(ws + WS_YS); bf16* MIX = (bf16*)(ws + WS_MIX);
    const f32x4 nw = *(const f32x4*)(p.ssd_norm_w + l * 256 + 4 * lane);
    for (int t = gw; t < T; t += ngw) {
        f32x4 y = *(const f32x4*)(YS + (size_t)t * 256 + 4 * lane); const u32x2 zw = *(const u32x2*)(P + (size_t)t * NPROJ + C_Z + 4 * lane);
        y.x *= silu_f(bflo(zw.x)); y.y *= silu_f(bfhi(zw.x)); y.z *= silu_f(bflo(zw.y)); y.w *= silu_f(bfhi(zw.y));
        const float ms = wave_sum(y.x * y.x + y.y * y.y + y.z * y.z + y.w * y.w) * (1.f / 256.f); const float r = 1.f / sqrtf(ms + RMS_EPS);
        u32x2 o; o.x = pk2(y.x * r * nw.x, y.y * r * nw.y); o.y = pk2(y.z * r * nw.z, y.w * r * nw.w);
        *(u32x2*)(MIX + (size_t)t * DM + 512 + 4 * lane) = o;
    }
}
__device__ __forceinline__ void stage_out_ref(const Params& p, int l, int blk, int nblk, int wv_) {
    const int tid = otid(), lane = tid & 63, wave = tid >> 6, gw = blk * NWAVES + wave, ngw = nblk * NWAVES;
    unsigned char* ws = p.ws; const bf16* MIX = (const bf16*)(ws + WS_MIX); const bf16* WT = (const bf16*)(ws + WS_WT_OUT) + (size_t)l * DM * DM;
    const float* xin = l == 0 ? p.x : p.out; float* out = p.out;
    constexpr int NT = DM / 32, MT = T / 32;
    for (int tile = gw; tile < MT * NT; tile += ngw) { const int tm = tile / NT, tn = tile % NT; const int m = tm * 32 + (lane & 31);
        wave_gemm_tile(MIX + (size_t)m * DM, WT + (size_t)(tn * 32 + (lane & 31)) * DM, DM, lane, [&](int nn, float a, float b, float c, float d) {
            const size_t off = (size_t)m * DM + tn * 32 + nn; const f32x4 xv = *(const f32x4*)(xin + off);
            *(f32x4*)(out + off) = (f32x4){ALPHA * xv.x + a, ALPHA * xv.y + b, ALPHA * xv.z + c, ALPHA * xv.w + d}; }); }
}

__device__ __forceinline__ void ln_row(f32x4 (&v)[4], const float* g, const float* bta, int lane) {
    float s = 0.f;
#pragma unroll
    for (int j = 0; j < 4; ++j) s += (v[j].x + v[j].y) + (v[j].z + v[j].w);
    const float mean = wave_sum(s) * (1.f / DM); float s2 = 0.f;
#pragma unroll
    for (int j = 0; j < 4; ++j) { v[j] = v[j] - mean; s2 += (v[j].x * v[j].x + v[j].y * v[j].y) + (v[j].z * v[j].z + v[j].w * v[j].w); }
    const float rstd = 1.f / sqrtf(wave_sum(s2) * (1.f / DM) + LN_EPS);
#pragma unroll
    for (int j = 0; j < 4; ++j) { const f32x4 gg = *((const f32x4*)g + lane + 64 * j), bb = *((const f32x4*)bta + lane + 64 * j); v[j] = v[j] * rstd * gg + bb; }
}
__device__ __forceinline__ void stage_ln1_router(const Params& p, int l, int blk, int nblk, int wv_) {
    const int tid = otid(), lane = tid & 63, wave = tid >> 6, gw = blk * NWAVES + wave, ngw = nblk * NWAVES;
    unsigned char* ws = p.ws; bf16* XB = (bf16*)(ws + WS_XB); unsigned* cnt = (unsigned*)(ws + WS_CTL) + CW_CNT + l * 16;
    int* TOKE = (int*)(ws + WS_TOKE); int* TOKP = (int*)(ws + WS_TOKP); float* TOKW = (float*)(ws + WS_TOKW); int* LIST = (int*)(ws + WS_LIST);
    for (int t = gw; t < T; t += ngw) {
        asm volatile("" ::: "memory");
        f32x4 v[4]; f32x4* xr = (f32x4*)(p.out + (size_t)t * DM) + lane;
#pragma unroll
        for (int j = 0; j < 4; ++j) v[j] = xr[64 * j];
        ln_row(v, p.ln1_g + l * DM, p.ln1_b + l * DM, lane);
        float lg[16];
#pragma unroll
        for (int e = 0; e < 16; ++e) lg[e] = 0.f;
#pragma unroll
        for (int j = 0; j < 4; ++j) { xr[64 * j] = v[j]; u32x2 o; o.x = pk2(v[j].x, v[j].y); o.y = pk2(v[j].z, v[j].w); *((u32x2*)(XB + (size_t)t * DM) + lane + 64 * j) = o;
#pragma unroll
            for (int c = 0; c < 4; ++c) { const int k = 4 * lane + 256 * j + c; const float xv = v[j][c]; const f32x4* wr = (const f32x4*)(p.w_router + (size_t)k * 16);
#pragma unroll
                for (int q = 0; q < 4; ++q) { const f32x4 w = wr[q]; lg[4 * q] += xv * w.x; lg[4 * q + 1] += xv * w.y; lg[4 * q + 2] += xv * w.z; lg[4 * q + 3] += xv * w.w; } } }
        float mx = -INFINITY;
#pragma unroll
        for (int e = 0; e < 16; ++e) { lg[e] = wave_sum(lg[e]) + p.b_router[e]; mx = fmaxf(mx, lg[e]); }
        float sum = 0.f;
#pragma unroll
        for (int e = 0; e < 16; ++e) { lg[e] = __expf(lg[e] - mx); sum += lg[e]; }
        const float inv = 1.f / sum;
#pragma unroll
        for (int e = 0; e < 16; ++e) lg[e] *= inv;
        int best = 0; float bs = -1.f;
#pragma unroll
        for (int g = 0; g < 4; ++g) { const float a = lg[4 * g], b = lg[4 * g + 1], c = lg[4 * g + 2], d = lg[4 * g + 3];
            const float h1 = fmaxf(a, b), l1 = fminf(a, b), h2 = fmaxf(c, d), l2 = fminf(c, d); const float gs = fmaxf(h1, h2) + fmaxf(fminf(h1, h2), fmaxf(l1, l2));
            if (gs > bs) { bs = gs; best = g; } }
        const float c0 = best == 0 ? lg[0] : (best == 1 ? lg[4] : (best == 2 ? lg[8] : lg[12]));
        const float c1 = best == 0 ? lg[1] : (best == 1 ? lg[5] : (best == 2 ? lg[9] : lg[13]));
        const float c2 = best == 0 ? lg[2] : (best == 1 ? lg[6] : (best == 2 ? lg[10] : lg[14]));
        const float c3 = best == 0 ? lg[3] : (best == 1 ? lg[7] : (best == 2 ? lg[11] : lg[15]));
        int i1 = 0; float s1 = c0; if (c1 > s1) { s1 = c1; i1 = 1; } if (c2 > s1) { s1 = c2; i1 = 2; } if (c3 > s1) { s1 = c3; i1 = 3; }
        int i2 = -1; float s2 = -1.f;
        if (i1 != 0 && c0 > s2) { s2 = c0; i2 = 0; } if (i1 != 1 && c1 > s2) { s2 = c1; i2 = 1; } if (i1 != 2 && c2 > s2) { s2 = c2; i2 = 2; } if (i1 != 3 && c3 > s2) { s2 = c3; i2 = 3; }
        if (lane == 0) { const int e1 = best * 4 + i1, e2 = best * 4 + i2; const float ws_ = 1.f / (s1 + s2);
            const int p1 = (int)atomicAdd(cnt + e1, 1u), p2 = (int)atomicAdd(cnt + e2, 1u);
            LIST[e1 * T + p1] = t; LIST[e2 * T + p2] = t;
            TOKE[2 * t] = e1; TOKE[2 * t + 1] = e2; TOKP[2 * t] = p1; TOKP[2 * t + 1] = p2; TOKW[2 * t] = s1 * ws_; TOKW[2 * t + 1] = s2 * ws_; }
    }
}
__device__ __forceinline__ void stage_moe1_ref(const Params& p, int l, int blk, int nblk, int wv_) {
    const int tid = otid(), lane = tid & 63, wave = tid >> 6, gw = blk * NWAVES + wave, ngw = nblk * NWAVES;
    unsigned char* ws = p.ws; const bf16* XB = (const bf16*)(ws + WS_XB); const unsigned* cnt = (const unsigned*)(ws + WS_CTL) + CW_CNT + l * 16; const int* LIST = (const int*)(ws + WS_LIST);
    bf16* H = (bf16*)(ws + WS_H);
    int total = 0;
    for (int e = 0; e < NE; ++e) total += (int)((cnt[e] + 255u) >> 8) * 256;
    const int ntask = (total / 32) * 32;
    for (int task = gw; task < ntask; task += ngw) { const int rt = task >> 5, ct = task & 31; const int row0 = rt * 32;
        int e = 0, base = 0;
        for (int q = 0; q < NE; ++q) { const int sz = (int)((cnt[q] + 255u) >> 8) * 256; if (row0 >= base + sz) { base += sz; e = q + 1; } else break; }
        const int i = row0 + (lane & 31) - base; const int tok = i < (int)cnt[e] ? LIST[e * T + i] : 0;
        const bf16* WG = (const bf16*)(ws + WS_WT_GU) + (size_t)(l * 16 + e) * 2048 * DM; const int c0 = ct * 32, pn = c0 >> 7, j0 = c0 & 127;
        const int hi = lane >> 5;
        const bf16* ap = XB + (size_t)tok * DM + 8 * hi; const bf16* gp = WG + (size_t)(256 * pn + j0 + (lane & 31)) * DM + 8 * hi; const bf16* up = gp + (size_t)128 * DM;
        f32x16 ag = {}, au = {};
        for (int k0 = 0; k0 < DM; k0 += 16) { const bf16x8 a = *(const bf16x8*)(ap + k0); ag = __builtin_amdgcn_mfma_f32_32x32x16_bf16(*(const bf16x8*)(gp + k0), a, ag, 0, 0, 0); au = __builtin_amdgcn_mfma_f32_32x32x16_bf16(*(const bf16x8*)(up + k0), a, au, 0, 0, 0); }
        const int row = row0 + (lane & 31);
#pragma unroll
        for (int g = 0; g < 4; ++g) { u32x2 o; o.x = pk2(silu_f(ag[4 * g]) * au[4 * g], silu_f(ag[4 * g + 1]) * au[4 * g + 1]); o.y = pk2(silu_f(ag[4 * g + 2]) * au[4 * g + 2], silu_f(ag[4 * g + 3]) * au[4 * g + 3]);
            *(u32x2*)(H + (size_t)row * DM + c0 + 8 * g + 4 * hi) = o; }
    }
}
__device__ __forceinline__ void stage_moe2_ref(const Params& p, int l, int blk, int nblk, int wv_) {
    const int tid = otid(), lane = tid & 63, wave = tid >> 6, gw = blk * NWAVES + wave, ngw = nblk * NWAVES;
    unsigned char* ws = p.ws; const unsigned* cnt = (const unsigned*)(ws + WS_CTL) + CW_CNT + l * 16; const bf16* H = (const bf16*)(ws + WS_H); bf16* Y = (bf16*)(ws + WS_Y);
    int total = 0;
    for (int e = 0; e < NE; ++e) total += (int)((cnt[e] + 255u) >> 8) * 256;
    const int ntask = (total / 32) * 32;
    for (int task = gw; task < ntask; task += ngw) { const int rt = task >> 5, ct = task & 31; const int row0 = rt * 32;
        int e = 0, base = 0;
        for (int q = 0; q < NE; ++q) { const int sz = (int)((cnt[q] + 255u) >> 8) * 256; if (row0 >= base + sz) { base += sz; e = q + 1; } else break; }
        const bf16* WD = (const bf16*)(ws + WS_WT_DN) + (size_t)(l * 16 + e) * DM * DM; const int row = row0 + (lane & 31);
        wave_gemm_tile(H + (size_t)row * DM, WD + (size_t)(ct * 32 + (lane & 31)) * DM, DM, lane, [&](int nn, float a, float b, float c, float d) {
            u32x2 o; o.x = pk2(a, b); o.y = pk2(c, d); *(u32x2*)(Y + (size_t)row * DM + ct * 32 + nn) = o; });
    }
}
__device__ __forceinline__ void stage_ln2(const Params& p, int l, int blk, int nblk, int wv_) {
    const int tid = otid(), lane = tid & 63, wave = tid >> 6, gw = blk * NWAVES + wave, ngw = nblk * NWAVES;
    unsigned char* ws = p.ws; bf16* XB = (bf16*)(ws + WS_XB); const unsigned* cnt = (const unsigned*)(ws + WS_CTL) + CW_CNT + l * 16; const bf16* Y = (const bf16*)(ws + WS_Y);
    const int* TOKE = (const int*)(ws + WS_TOKE); const int* TOKP = (const int*)(ws + WS_TOKP); const float* TOKW = (const float*)(ws + WS_TOKW); float* DT = (float*)(ws + WS_DT);
    for (int t = gw; t < T; t += ngw) {
        asm volatile("" ::: "memory");
        const int e1 = TOKE[2 * t], e2 = TOKE[2 * t + 1]; int r1 = TOKP[2 * t], r2 = TOKP[2 * t + 1]; const float w1 = TOKW[2 * t], w2 = TOKW[2 * t + 1];
        for (int e = 0; e < NE; ++e) { const int sz = (int)((cnt[e] + 255u) >> 8) * 256; if (e < e1) r1 += sz; if (e < e2) r2 += sz; }
        f32x4 v[4]; f32x4* xr = (f32x4*)(p.out + (size_t)t * DM) + lane;
#pragma unroll
        for (int j = 0; j < 4; ++j) { const f32x4 xv = xr[64 * j]; const u32x2 a = *((const u32x2*)(Y + (size_t)r1 * DM) + lane + 64 * j), b = *((const u32x2*)(Y + (size_t)r2 * DM) + lane + 64 * j);
            v[j].x = ALPHA * xv.x + (w1 * bflo(a.x) + w2 * bflo(b.x)); v[j].y = ALPHA * xv.y + (w1 * bfhi(a.x) + w2 * bfhi(b.x));
            v[j].z = ALPHA * xv.z + (w1 * bflo(a.y) + w2 * bflo(b.y)); v[j].w = ALPHA * xv.w + (w1 * bfhi(a.y) + w2 * bfhi(b.y)); }
        ln_row(v, p.ln2_g + l * DM, p.ln2_b + l * DM, lane);
        float d0 = 0.f, d1 = 0.f, d2 = 0.f, d3 = 0.f;
#pragma unroll
        for (int j = 0; j < 4; ++j) { xr[64 * j] = v[j];
            if (l + 1 < DEPTH) { u32x2 o; o.x = pk2(v[j].x, v[j].y); o.y = pk2(v[j].z, v[j].w); *((u32x2*)(XB + (size_t)t * DM) + lane + 64 * j) = o;
#pragma unroll
                for (int c = 0; c < 4; ++c) { const int k = 4 * lane + 256 * j + c; const f32x4 w = *(const f32x4*)(p.w_in + ((size_t)(l + 1) * DM + k) * NCOLS_IN + 2560); const float xv = v[j][c];
                    d0 += xv * w.x; d1 += xv * w.y; d2 += xv * w.z; d3 += xv * w.w; } } }
        if (l + 1 < DEPTH) { d0 = wave_sum(d0); d1 = wave_sum(d1); d2 = wave_sum(d2); d3 = wave_sum(d3); if (lane == 0) *(f32x4*)(DT + (size_t)t * 4) = (f32x4){d0, d1, d2, d3}; }
    }
}


namespace pg8 {
constexpr int BM = 256, BK = 64, HALF = 128, HTB = HALF * BK * 2  , STAGE_BYTES = 8 * HTB;
__host__ __device__ __forceinline__ int lds_byte(int r, int c) { const int st = (r >> 4) * 2 + (c >> 5), rr = r & 15, cc = c & 31, ob = rr * 64 + cc * 2; return st * 1024 + (ob ^ (((ob >> 9) & 1) << 5)); }
__host__ __device__ __forceinline__ void stage_rc(int b, int& R, int& C) { const int st = b / 1024, sb = b % 1024, swz = sb ^ (((sb >> 9) & 1) << 5); R = (st >> 1) * 16 + swz / 64; C = (st & 1) * 32 + (swz % 64) / 2; }
__host__ __device__ __forceinline__ int perm32(int rho) { const int n = rho >> 4, i = rho & 15; return 8 * (i >> 2) + 4 * n + (i & 3); }
struct Unit { int pm, pn, cn; };
struct Gemm { const bf16* A; const bf16* Bt; int K; };

__device__ __forceinline__ unsigned cvt_pk_bf16(float lo, float hi) { unsigned r; asm volatile("v_cvt_pk_bf16_f32 %0, %1, %2" : "=v"(r) : "v"(lo), "v"(hi)); return r; }

struct EpiBf16 {
    static constexpr bool PERM = true;
    bf16* O; int ldc; int split_cols; size_t split_stride;
    __device__ __forceinline__ void operator()(const f32x4 (&acc)[2][2][4][2], const Unit& u, int wr, int wc, int fr, int fq) const {
        const int row0 = u.pm * BM + wr * 64 + fr; int colt = u.cn * BM; bf16* base = O;
        if (split_cols) { const int t = colt / split_cols; base += (size_t)t * split_stride; colt -= t * split_cols; }
        const int col0 = colt + wc * 32 + 8 * fq;
#pragma unroll
        for (int ai = 0; ai < 2; ++ai)
#pragma unroll
            for (int m = 0; m < 4; ++m) { bf16* rowp = base + (size_t)(row0 + ai * HALF + m * 16) * ldc + col0;
#pragma unroll
                for (int bj = 0; bj < 2; ++bj) { const f32x4 v0 = acc[ai][bj][m][0], v1 = acc[ai][bj][m][1];
                    u32x4 w; w.x = cvt_pk_bf16(v0[0], v0[1]); w.y = cvt_pk_bf16(v0[2], v0[3]); w.z = cvt_pk_bf16(v1[0], v1[1]); w.w = cvt_pk_bf16(v1[2], v1[3]);
                    *(u32x4*)(rowp + bj * HALF) = w; } }
    }
};
struct EpiSwiGLU {
    static constexpr bool PERM = true;
    bf16* O; int ldc;
    __device__ __forceinline__ void operator()(const f32x4 (&acc)[2][2][4][2], const Unit& u, int wr, int wc, int fr, int fq) const {
        const int row0 = u.pm * BM + wr * 64 + fr; const int col0 = u.cn * HALF + wc * 32 + 8 * fq;
#pragma unroll
        for (int ai = 0; ai < 2; ++ai)
#pragma unroll
            for (int m = 0; m < 4; ++m) { float h[8];
#pragma unroll
                for (int n = 0; n < 2; ++n)
#pragma unroll
                    for (int c = 0; c < 4; ++c) { const float g = acc[ai][0][m][n][c], uu = acc[ai][1][m][n][c]; h[4 * n + c] = g * __builtin_amdgcn_rcpf(1.f + __expf(-g)) * uu; }
                u32x4 w; w.x = cvt_pk_bf16(h[0], h[1]); w.y = cvt_pk_bf16(h[2], h[3]); w.z = cvt_pk_bf16(h[4], h[5]); w.w = cvt_pk_bf16(h[6], h[7]);
                *(u32x4*)(O + (size_t)(row0 + ai * HALF + m * 16) * ldc + col0) = w; }
    }
};
struct EpiResF32 {
    static constexpr bool PERM = false;
    const float* base; float* out; int ldc; float alpha;
    __device__ __forceinline__ void operator()(const f32x4 (&acc)[2][2][4][2], const Unit& u, int wr, int wc, int fr, int fq) const {
        const int row0 = u.pm * BM + wr * 64 + fr; const int col0 = u.cn * BM + wc * 32 + 4 * fq;
#pragma unroll
        for (int ai = 0; ai < 2; ++ai)
#pragma unroll
            for (int m = 0; m < 4; ++m) { const size_t off = (size_t)(row0 + ai * HALF + m * 16) * ldc + col0;
#pragma unroll
                for (int bj = 0; bj < 2; ++bj)
#pragma unroll
                    for (int n = 0; n < 2; ++n) { const f32x4 bs = *(const f32x4*)(base + off + bj * HALF + n * 16); *(f32x4*)(out + off + bj * HALF + n * 16) = bs * alpha + acc[ai][bj][m][n]; } }
    }
};

template <class Epi, class Sched, bool GATHER>
__device__ __forceinline__ void gemm_phase(LAS unsigned char* lds, const Gemm g, const Sched& S, const Epi& E, const LAS int* gtab, int wv_) {
    const int tid = otid(), wid = __builtin_amdgcn_readfirstlane(tid >> 6), lane = tid & 63, wr = wid >> 2, wc = wid & 3, fr = lane & 15, fq = lane >> 4;
    const int K = g.K, nt = K / BK;
    unsigned voffA[2], voffB[2]; int RA[2], CA[2];
#pragma unroll
    for (int i = 0; i < 2; ++i) { int R, C; stage_rc(tid * 16 + i * 8192, R, C); const int Rb = Epi::PERM ? ((R & ~31) + perm32(R & 31)) : R; RA[i] = R; CA[i] = C;
        voffA[i] = (unsigned)(R * K + C) * 2u; voffB[i] = (unsigned)(Rb * K + C) * 2u; }
    const size_t kstep = (size_t)(BK * 2);
    const size_t hstep = (size_t)HALF * K * 2;
    const size_t tstep = 2 * hstep;
    const unsigned ldsw = (unsigned)wid * 1024u;
    const int aoff = lds_byte(wr * 64 + fr, fq * 8), boff = lds_byte(wc * 32 + fr, fq * 8);
#define PG8_SA(b, h) (((b) * 2 + (h)) * HTB)
#define PG8_SB(b, h) ((4 + (b) * 2 + (h)) * HTB)
#define PG8_STAGE(bufoff, gbase, voff) do { _Pragma("unroll") for (int _i = 0; _i < 2; ++_i) \
        __builtin_amdgcn_global_load_lds((const unsigned*)((const char*)(gbase) + (voff)[_i]), (LAS unsigned*)(lds + (bufoff) + ldsw + _i * 8192), 16, 0, 0); } while (0)
#define PG8_STAGE_A(bufoff, pbase, gbase, h, vo) do { if constexpr (GATHER) { PG8_STAGE(bufoff, gbase, (vo)[h]); } else { PG8_STAGE(bufoff, (pbase) + (h) * hstep, voffA); } } while (0)
#define PG8_LDA(dst, b, h) do { _Pragma("unroll") for (int m = 0; m < 4; ++m) _Pragma("unroll") for (int k = 0; k < 2; ++k) dst[m][k] = *(const LAS bf16x8*)(lds + PG8_SA(b, h) + aoff + m * 2048 + k * 1024); } while (0)
#define PG8_LDB(dst, b, h) do { _Pragma("unroll") for (int n = 0; n < 2; ++n) _Pragma("unroll") for (int k = 0; k < 2; ++k) dst[n][k] = *(const LAS bf16x8*)(lds + PG8_SB(b, h) + boff + n * 2048 + k * 1024); } while (0)
#define PG8_MMA(ai, bj, At, Bt) do { __builtin_amdgcn_s_setprio(1); _Pragma("unroll") for (int m = 0; m < 4; ++m) _Pragma("unroll") for (int n = 0; n < 2; ++n) _Pragma("unroll") for (int k = 0; k < 2; ++k) \
        acc[ai][bj][m][n] = __builtin_amdgcn_mfma_f32_16x16x32_bf16(Bt[n][k], At[m][k], acc[ai][bj][m][n], 0, 0, 0); __builtin_amdgcn_s_setprio(0); } while (0)
#define PG8_WAIT_V(n) asm volatile("s_waitcnt vmcnt(" #n ")" ::: "memory")
#define PG8_WAIT_L(n) asm volatile("s_waitcnt lgkmcnt(" #n ")" ::: "memory")
#define PG8_BAR __builtin_amdgcn_s_barrier()
#define PG8_SCHED __builtin_amdgcn_sched_barrier(0)
#define PG8_GVO(dst, ui_) do { _Pragma("unroll") for (int _h = 0; _h < 2; ++_h) _Pragma("unroll") for (int _i = 0; _i < 2; ++_i) \
        dst[_h][_i] = (unsigned)gtab[(ui_) * 256 + _h * HALF + RA[_i]] * (unsigned)(K * 2) + (unsigned)(CA[_i] * 2); } while (0)
    Unit cur, nxt; int ui = 0;
    if (!S.next(0, cur)) return;
    f32x4 acc[2][2][4][2];
#pragma unroll
    for (int a = 0; a < 2; ++a)
#pragma unroll
        for (int b = 0; b < 2; ++b)
#pragma unroll
            for (int m = 0; m < 4; ++m)
#pragma unroll
                for (int n = 0; n < 2; ++n) acc[a][b][m][n] = (f32x4){0.f, 0.f, 0.f, 0.f};
    bf16x8 At[4][2], B0[2][2], B1[2][2];
    unsigned voC[2][2], voN[2][2];
    if constexpr (GATHER) { PG8_GVO(voC, 0); PG8_WAIT_L(0); }
    const char* gA = (const char*)g.A;
    const char* cA = GATHER ? gA : gA + (size_t)cur.pm * tstep; const char* cB = (const char*)g.Bt + (size_t)cur.pn * tstep;
    PG8_STAGE(PG8_SB(0, 0), cB, voffB); PG8_STAGE(PG8_SB(0, 1), cB + hstep, voffB); PG8_STAGE_A(PG8_SA(0, 0), cA, cA, 0, voC); PG8_STAGE_A(PG8_SA(0, 1), cA, cA, 1, voC);
    if (wr == 1) PG8_BAR;
    PG8_WAIT_V(2); PG8_BAR;
    PG8_STAGE(PG8_SB(1, 0), cB + kstep, voffB); PG8_STAGE_A(PG8_SA(1, 0), cA + kstep, cA + kstep, 0, voC); PG8_STAGE(PG8_SB(1, 1), cB + hstep + kstep, voffB);
    PG8_WAIT_V(6); PG8_BAR;
    for (;;) {
        const bool has_next = S.next(ui + 1, nxt);
        const char* nA = (has_next && !GATHER) ? gA + (size_t)nxt.pm * tstep : cA; const char* nB = has_next ? (const char*)g.Bt + (size_t)nxt.pn * tstep : cB;
        if constexpr (GATHER) { if (has_next) { PG8_GVO(voN, ui + 1); } else {
#pragma unroll
            for (int _h = 0; _h < 2; ++_h)
#pragma unroll
                for (int _i = 0; _i < 2; ++_i) voN[_h][_i] = voC[_h][_i]; } }
        for (int t = 0; t < nt; t += 2) {
            const bool last = (t == nt - 2);
            const char* a1 = cA + (size_t)(t + 1) * kstep;
            const char* a2 = last ? nA : cA + (size_t)(t + 2) * kstep; const char* b2 = last ? nB : cB + (size_t)(t + 2) * kstep;
            const char* a3 = a2 + kstep; const char* b3 = b2 + kstep;
            unsigned vs[2][2];
            if constexpr (GATHER) {
#pragma unroll
                for (int _h = 0; _h < 2; ++_h)
#pragma unroll
                    for (int _i = 0; _i < 2; ++_i) vs[_h][_i] = last ? voN[_h][_i] : voC[_h][_i]; }
            PG8_LDB(B0, 0, 0); PG8_LDB(B1, 0, 1); PG8_SCHED; PG8_LDA(At, 0, 0); PG8_STAGE_A(PG8_SA(1, 1), a1, a1, 1, voC);
            PG8_WAIT_V(8); PG8_WAIT_L(0); PG8_BAR; PG8_MMA(0, 0, At, B0); PG8_MMA(0, 1, At, B1); PG8_BAR; PG8_SCHED;
            PG8_LDA(At, 0, 1); PG8_STAGE(PG8_SB(0, 0), b2, voffB); PG8_STAGE(PG8_SB(0, 1), b2 + hstep, voffB); PG8_STAGE_A(PG8_SA(0, 0), a2, a2, 0, vs);
            PG8_WAIT_V(8); PG8_WAIT_L(0); PG8_BAR; PG8_MMA(1, 0, At, B0); PG8_MMA(1, 1, At, B1); PG8_BAR; PG8_SCHED;
            PG8_LDB(B0, 1, 0); PG8_LDB(B1, 1, 1); PG8_SCHED; PG8_LDA(At, 1, 0); PG8_STAGE_A(PG8_SA(0, 1), a2, a2, 1, vs);
            PG8_WAIT_V(8); PG8_WAIT_L(0); PG8_BAR; PG8_MMA(0, 0, At, B0); PG8_MMA(0, 1, At, B1); PG8_BAR; PG8_SCHED;
            PG8_LDA(At, 1, 1); PG8_STAGE(PG8_SB(1, 0), b3, voffB); PG8_STAGE(PG8_SB(1, 1), b3 + hstep, voffB); PG8_STAGE_A(PG8_SA(1, 0), a3, a3, 0, vs);
            PG8_WAIT_V(8); PG8_WAIT_L(0); PG8_BAR; PG8_MMA(1, 0, At, B0); PG8_MMA(1, 1, At, B1); PG8_BAR; PG8_SCHED;
        }
        if (wr == 0) PG8_BAR;
        E(acc, cur, wr, wc, fr, fq);
        if (!has_next) break;
#pragma unroll
        for (int a = 0; a < 2; ++a)
#pragma unroll
            for (int b = 0; b < 2; ++b)
#pragma unroll
                for (int m = 0; m < 4; ++m)
#pragma unroll
                    for (int n = 0; n < 2; ++n) acc[a][b][m][n] = (f32x4){0.f, 0.f, 0.f, 0.f};
        cur = nxt; cA = nA; cB = nB; ++ui;
        if constexpr (GATHER) {
#pragma unroll
            for (int _h = 0; _h < 2; ++_h)
#pragma unroll
                for (int _i = 0; _i < 2; ++_i) voC[_h][_i] = voN[_h][_i]; }
        if (wr == 1) PG8_BAR;
    }
    PG8_WAIT_V(0);
    PG8_BAR;
#undef PG8_SA
#undef PG8_SB
#undef PG8_STAGE
#undef PG8_STAGE_A
#undef PG8_LDA
#undef PG8_LDB
#undef PG8_MMA
#undef PG8_WAIT_V
#undef PG8_WAIT_L
#undef PG8_BAR
#undef PG8_SCHED
#undef PG8_GVO
}
struct GridOrder {
    int nMx, nN, x, j, W;
    __device__ __forceinline__ void init(int nM, int nN_, int G, int c) { nMx = nM / 8; nN = nN_; x = c & 7; j = c >> 3; W = (G - x + 7) >> 3; }
    __device__ __forceinline__ bool next(int i, Unit& u) const { const int L = i * W + j; if (L >= nMx * nN) return false; u.pm = x * nMx + L % nMx; u.pn = L / nMx; u.cn = u.pn; return true; }
};
struct ListOrder {
    int first, n, nN;
    __device__ __forceinline__ bool next(int i, Unit& u) const { if (i > 0 || first < 0 || first >= n) return false; u.pm = first / nN; u.pn = first % nN; u.cn = u.pn; return true; }
};
struct MoeOrder {
    int pe[16]; int nC, t0, t1, j, W;
    __device__ __forceinline__ void init(const unsigned* cnt, int nC_, int G, int c) { int a = 0;
#pragma unroll
        for (int e = 0; e < 16; ++e) { a += (int)((__builtin_amdgcn_readfirstlane(cnt[e]) + 255u) >> 8); pe[e] = a; }
        const int x = c & 7; nC = nC_; j = c >> 3; W = (G - x + 7) >> 3; t0 = (x * a) >> 3; t1 = ((x + 1) * a) >> 3; }
    __device__ __forceinline__ void expert_of(int rt, int& e, int& start) const { e = 0; start = 0;
#pragma unroll
        for (int q = 0; q < 16; ++q) if (rt >= pe[q]) { e = q + 1; start = pe[q]; } }
    __device__ __forceinline__ bool next(int i, Unit& u) const { const int L = i * W + j; const int rt = t0 + L / nC, cl = L % nC; if (rt >= t1) return false;
        int e, st; expert_of(rt, e, st); u.pm = rt; u.pn = e * nC + cl; u.cn = cl; return true; }
};
}

constexpr int GTAB_OFF = 131072 + 1024;
__device__ __forceinline__ void stage_proj(const Params& p, LAS unsigned char* lds, int l, int blk, int nblk, int wv_) {
    unsigned char* ws = p.ws;
    { pg8::Gemm g{(const bf16*)(ws + WS_XB), (const bf16*)(ws + WS_WT_IN) + (size_t)l * NPROJ * DM, DM}; pg8::GridOrder S; S.init(T / 256, NPROJ / 256, nblk, blk);
      pg8::EpiBf16 E{(bf16*)(ws + WS_P), NPROJ, 0, 0};
      pg8::gemm_phase<pg8::EpiBf16, pg8::GridOrder, false>(lds, g, S, E, nullptr, wv_); }
    if (l == 0) {
        pg8::Gemm g{(const bf16*)(ws + WS_MEMB), (const bf16*)(ws + WS_WT_KV), DM}; pg8::ListOrder S{nblk >= 208 ? blk - 192 : blk, 16, 4};
        pg8::EpiBf16 E{(bf16*)(ws + WS_KV), 512, 512, (size_t)1024 * 512};
        pg8::gemm_phase<pg8::EpiBf16, pg8::ListOrder, false>(lds, g, S, E, nullptr, wv_); }
}
__device__ __forceinline__ void stage_out(const Params& p, LAS unsigned char* lds, int l, int blk, int nblk, int wv_) {
    unsigned char* ws = p.ws;
    pg8::Gemm g{(const bf16*)(ws + WS_MIX), (const bf16*)(ws + WS_WT_OUT) + (size_t)l * DM * DM, DM}; pg8::GridOrder S; S.init(T / 256, DM / 256, nblk, blk);
    pg8::EpiResF32 E{l == 0 ? p.x : p.out, p.out, DM, ALPHA};
    pg8::gemm_phase<pg8::EpiResF32, pg8::GridOrder, false>(lds, g, S, E, nullptr, wv_);
}
__device__ __forceinline__ void stage_moe1(const Params& p, LAS unsigned char* lds, int l, int blk, int nblk, int wv_) {
    unsigned char* ws = p.ws; const unsigned* cnt = (const unsigned*)(ws + WS_CTL) + CW_CNT + l * 16; const int* LIST = (const int*)(ws + WS_LIST);
    pg8::MoeOrder S; S.init(cnt, 8, nblk, blk);
    LAS int* gtab = (LAS int*)(lds + GTAB_OFF);
    { pg8::Unit u; const int tid = otid();
      for (int i = 0; i < 12 && S.next(i, u); ++i) if (tid < 256) { int e, st; S.expert_of(u.pm, e, st); const int pos = (u.pm - st) * 256 + tid; gtab[i * 256 + tid] = pos < (int)cnt[e] ? LIST[e * T + pos] : 0; }
      __syncthreads(); }
    pg8::Gemm g{(const bf16*)(ws + WS_XB), (const bf16*)(ws + WS_WT_GU) + (size_t)l * 16 * 2048 * DM, DM};
    pg8::EpiSwiGLU E{(bf16*)(ws + WS_H), DM};
    pg8::gemm_phase<pg8::EpiSwiGLU, pg8::MoeOrder, true>(lds, g, S, E, gtab, wv_);
}
__device__ __forceinline__ void stage_moe2(const Params& p, LAS unsigned char* lds, int l, int blk, int nblk, int wv_) {
    unsigned char* ws = p.ws; const unsigned* cnt = (const unsigned*)(ws + WS_CTL) + CW_CNT + l * 16;
    pg8::MoeOrder S; S.init(cnt, 4, nblk, blk);
    pg8::Gemm g{(const bf16*)(ws + WS_H), (const bf16*)(ws + WS_WT_DN) + (size_t)l * 16 * DM * DM, DM};
    pg8::EpiBf16 E{(bf16*)(ws + WS_Y), DM, 0, 0};
    pg8::gemm_phase<pg8::EpiBf16, pg8::MoeOrder, false>(lds, g, S, E, nullptr, wv_);
}

constexpr int SSD_PITCH = 272, SSD_TILE = 128 * SSD_PITCH;
constexpr int SSD_TX = 0, SSD_TB = SSD_TILE, SSD_TC = 2 * SSD_TILE, SSD_TW = 3 * SSD_TILE, SSD_TAB = 4 * SSD_TILE;
constexpr size_t WS_ATOT = WS_DT + 512 * 1024;
typedef short s16x4 __attribute__((ext_vector_type(4)));
template <int PITCH = SSD_PITCH> __device__ __forceinline__ s16x4 tr_read4(const LAS unsigned char* tile, int row0, int col0, int lane) {
    const int i = lane & 15, cb = ((lane >> 4) & 1) * 16;
    const LAS unsigned char* a = tile + (row0 + (i >> 2)) * PITCH + (col0 + cb + 4 * (i & 3)) * 2;
    return __builtin_bit_cast(s16x4, __builtin_amdgcn_ds_read_tr16_b64_v4i16((LAS s16x4*)a));
}
__device__ __forceinline__ bf16x8 cat8(s16x4 a, s16x4 b) { return (bf16x8){a[0], a[1], a[2], a[3], b[0], b[1], b[2], b[3]}; }
__device__ __forceinline__ bf16x8 tr_frag_nat(const LAS unsigned char* tile, int r0, int col0, int lane) { const int hi = lane >> 5; return cat8(tr_read4(tile, r0 + 8 * hi, col0, lane), tr_read4(tile, r0 + 8 * hi + 4, col0, lane)); }
template <int PITCH = SSD_PITCH> __device__ __forceinline__ bf16x8 tr_frag_acc(const LAS unsigned char* tile, int r0, int col0, int lane) { const int hi = lane >> 5; return cat8(tr_read4<PITCH>(tile, r0 + 4 * hi, col0, lane), tr_read4<PITCH>(tile, r0 + 4 * hi + 8, col0, lane)); }
__device__ __forceinline__ bf16x8 row_frag(const LAS unsigned char* tile, int r0, int k0, int lane) { return *(const LAS bf16x8*)(tile + (r0 + (lane & 31)) * SSD_PITCH + (k0 + 8 * (lane >> 5)) * 2); }

__device__ __forceinline__ void ssd_stage_conv(const bf16* P, int t0, int s0, int pcol0, const float* cw, const float* cb, int cc0, LAS unsigned char* tile, int tid) {
    const int ch = tid & 15, rg = tid >> 4;
    float w[4][8], bias[8];
#pragma unroll
    for (int k = 0; k < 4; ++k) { const f32x4 a = *(const f32x4*)(cw + k * 768 + cc0 + ch * 8), b = *(const f32x4*)(cw + k * 768 + cc0 + ch * 8 + 4);
        w[k][0] = a.x; w[k][1] = a.y; w[k][2] = a.z; w[k][3] = a.w; w[k][4] = b.x; w[k][5] = b.y; w[k][6] = b.z; w[k][7] = b.w; }
    { const f32x4 a = *(const f32x4*)(cb + cc0 + ch * 8), b = *(const f32x4*)(cb + cc0 + ch * 8 + 4); bias[0] = a.x; bias[1] = a.y; bias[2] = a.z; bias[3] = a.w; bias[4] = b.x; bias[5] = b.y; bias[6] = b.z; bias[7] = b.w; }
    u32x4 in[7];
#pragma unroll
    for (int r = 0; r < 7; ++r) { const int row = 4 * rg - 3 + r; in[r] = (u32x4){0u, 0u, 0u, 0u}; if (s0 + row >= 0) in[r] = *(const u32x4*)(P + (size_t)(t0 + row) * NPROJ + pcol0 + ch * 8); }
#pragma unroll
    for (int j = 0; j < 4; ++j) { float o[8];
#pragma unroll
        for (int i = 0; i < 8; ++i) o[i] = bias[i];
#pragma unroll
        for (int k = 0; k < 4; ++k)
#pragma unroll
            for (int i2 = 0; i2 < 4; ++i2) { const unsigned wd = in[j + k][i2]; o[2 * i2] += w[k][2 * i2] * bflo(wd); o[2 * i2 + 1] += w[k][2 * i2 + 1] * bfhi(wd); }
        u32x4 ov;
#pragma unroll
        for (int i2 = 0; i2 < 4; ++i2) ov[i2] = pk2(silu_f(o[2 * i2]), silu_f(o[2 * i2 + 1]));
        *(LAS u32x4*)(tile + (4 * rg + j) * SSD_PITCH + ch * 16) = ov; }
}
__device__ __forceinline__ void ssd_tables(const Params& p, int l, int t0, int h0, int nh, LAS float* dtv, LAS float* acs, int tid) {
    const int hh = tid >> 7, row = tid & 127;
    if (hh < nh) { const int h = h0 + hh; const float a = -__expf(p.a_log[l * 4 + h]); const float dt = softplus_f(((const float*)(p.ws + WS_DT))[(size_t)(t0 + row) * 4 + h] + p.dt_bias[l * 4 + h]);
        dtv[hh * 128 + row] = dt; acs[hh * 128 + row] = a * dt; }
    __syncthreads();
    float cs = 0.f;
    if (hh < nh) for (int k = 0; k <= row; ++k) cs += acs[hh * 128 + k];
    __syncthreads();
    if (hh < nh) acs[hh * 128 + row] = cs;
    __syncthreads();
}
__device__ __forceinline__ void stage_ssd1(const Params& p, LAS unsigned char* lds, int l, int blk, int nblk, int wv_) {
    const int tid = otid(), lane = tid & 63, wave = __builtin_amdgcn_readfirstlane(tid >> 6);
    unsigned char* ws = p.ws; const bf16* P = (const bf16*)(ws + WS_P); float* SST = (float*)(ws + WS_SST); float* ATOT = (float*)(ws + WS_ATOT);
    const float* cw = p.conv_w + (size_t)l * 4 * 768; const float* cb = p.conv_b + (size_t)l * 768;
    LAS float* dtv = (LAS float*)(lds + SSD_TAB); LAS float* acs = dtv + 512;
    for (int u = blk; u < NB * 32 * 2; u += nblk) {
        const int g = u & 1, c = (u >> 1) & 31, b = u >> 6, t0 = b * SEQ + c * 128, s0 = c * 128;
        ssd_tables(p, l, t0, 2 * g, 2, dtv, acs, tid);
        if (tid < 2) ATOT[(b * 32 + c) * 4 + 2 * g + tid] = acs[tid * 128 + 127];
        ssd_stage_conv(P, t0, s0, C_XBC + g * 128, cw, cb, g * 128, lds + SSD_TX, tid);
        ssd_stage_conv(P, t0, s0, C_XBC + 256 + g * 128, cw, cb, 256 + g * 128, lds + SSD_TB, tid);
        __syncthreads();
        { const int row = tid >> 2, cq = tid & 3, hh = cq >> 1; const float sc = dtv[hh * 128 + row] * __expf(acs[hh * 128 + 127] - acs[hh * 128 + row]);
#pragma unroll
            for (int i = 0; i < 4; ++i) { const u32x4 v = *(const LAS u32x4*)(lds + SSD_TX + row * SSD_PITCH + cq * 64 + i * 16); u32x4 o;
#pragma unroll
                for (int q = 0; q < 4; ++q) o[q] = pk2(bflo(v[q]) * sc, bfhi(v[q]) * sc);
                *(LAS u32x4*)(lds + SSD_TW + row * SSD_PITCH + cq * 64 + i * 16) = o; } }
        __syncthreads();
        { const int hh = wave >> 2, nt = wave & 3, hi = lane >> 5; f32x16 acc0 = {}, acc1 = {};
#pragma unroll
            for (int ks = 0; ks < 8; ++ks) { const bf16x8 bfr = tr_frag_nat(lds + SSD_TB, 16 * ks, nt * 32, lane);
                const bf16x8 a0 = tr_frag_nat(lds + SSD_TW, 16 * ks, hh * 64, lane), a1 = tr_frag_nat(lds + SSD_TW, 16 * ks, hh * 64 + 32, lane);
                acc0 = __builtin_amdgcn_mfma_f32_32x32x16_bf16(a0, bfr, acc0, 0, 0, 0); acc1 = __builtin_amdgcn_mfma_f32_32x32x16_bf16(a1, bfr, acc1, 0, 0, 0); }
            float* So = SST + ((size_t)((b * 32 + c) * 4 + 2 * g + hh)) * 8192 + nt * 32 + (lane & 31);
#pragma unroll
            for (int r = 0; r < 16; ++r) { So[(size_t)crow(r, hi) * 128] = acc0[r]; So[(size_t)(32 + crow(r, hi)) * 128] = acc1[r]; } }
        __syncthreads();
    }
}
__device__ __forceinline__ void stage_ssd_scan(const Params& p, int blk, int nblk, int wv_) {
    unsigned char* ws = p.ws; float* SST = (float*)(ws + WS_SST); const float* ATOT = (const float*)(ws + WS_ATOT);
    for (int e = blk * NTHREADS + otid(); e < NB * 4 * 8192; e += nblk * NTHREADS) { const int el = e & 8191, h = (e >> 13) & 3, b = e >> 15;
        float run = 0.f;
        for (int c = 0; c < 32; ++c) { float* q = SST + ((size_t)((b * 32 + c) * 4 + h)) * 8192 + el; const float sv = *q; *q = run; run = run * __expf(ATOT[(b * 32 + c) * 4 + h]) + sv; } }
}
__device__ __forceinline__ void stage_ssd3(const Params& p, LAS unsigned char* lds, int l, int blk, int nblk, int wv_) {
    const int tid = otid(), lane = tid & 63, wave = __builtin_amdgcn_readfirstlane(tid >> 6), hi = lane >> 5, l31 = lane & 31;
    unsigned char* ws = p.ws; const bf16* P = (const bf16*)(ws + WS_P); const float* SST = (const float*)(ws + WS_SST); bf16* MIX = (bf16*)(ws + WS_MIX); float* YS = (float*)(ws + WS_YS);
    const float* cw = p.conv_w + (size_t)l * 4 * 768; const float* cb = p.conv_b + (size_t)l * 768;
    LAS float* dtv = (LAS float*)(lds + SSD_TAB); LAS float* acs = dtv + 512; LAS float* ssq = dtv + 1024;
    for (int u = blk; u < NB * 32; u += nblk) {
        const int c = u & 31, b = u >> 5, t0 = b * SEQ + c * 128, s0 = c * 128;
        ssd_tables(p, l, t0, 0, 4, dtv, acs, tid);
        const int hh = wave >> 2, j = wave & 3, lrow = 32 * j + l31;
        float ssq0 = 0.f, ssq1 = 0.f;
#pragma unroll 1
        for (int g = 0; g < 2; ++g) {
            ssd_stage_conv(P, t0, s0, C_XBC + g * 128, cw, cb, g * 128, lds + SSD_TX, tid);
            ssd_stage_conv(P, t0, s0, C_XBC + 256 + g * 128, cw, cb, 256 + g * 128, lds + SSD_TB, tid);
            ssd_stage_conv(P, t0, s0, C_XBC + 512 + g * 128, cw, cb, 512 + g * 128, lds + SSD_TC, tid);
            { const int row = tid >> 2, cq = tid & 3; const float* src = SST + ((size_t)((b * 32 + c) * 4 + 2 * g + (row >> 6))) * 8192 + (row & 63) * 128 + cq * 32;
#pragma unroll
                for (int i = 0; i < 4; ++i) { const f32x4 a = *(const f32x4*)(src + 8 * i), bq = *(const f32x4*)(src + 8 * i + 4); u32x4 o; o.x = pk2(a.x, a.y); o.y = pk2(a.z, a.w); o.z = pk2(bq.x, bq.y); o.w = pk2(bq.z, bq.w);
                    *(LAS u32x4*)(lds + SSD_TW + row * SSD_PITCH + cq * 64 + i * 16) = o; } }
            __syncthreads();
            const int h = 2 * g + hh; const LAS float* acsh = acs + h * 128; const LAS float* dth = dtv + h * 128; const float acs_l = acsh[lrow];
            f32x16 yd0 = {}, yd1 = {};
            for (int a = 0; a <= j; ++a) {
                f32x16 G = {};
#pragma unroll
                for (int ks = 0; ks < 8; ++ks) G = __builtin_amdgcn_mfma_f32_32x32x16_bf16(row_frag(lds + SSD_TB, 32 * a, 16 * ks, lane), row_frag(lds + SSD_TC, 32 * j, 16 * ks, lane), G, 0, 0, 0);
                unsigned mw[8];
#pragma unroll
                for (int r2 = 0; r2 < 8; ++r2) { float v2[2];
#pragma unroll
                    for (int q = 0; q < 2; ++q) { const int r = 2 * r2 + q, srow = 32 * a + crow(r, hi); float v = G[r] * __expf(acs_l - acsh[srow]) * dth[srow]; if (srow > lrow) v = 0.f; v2[q] = v; }
                    mw[r2] = pk2(v2[0], v2[1]); }
#pragma unroll
                for (int ks = 0; ks < 2; ++ks) { const bf16x8 mb = __builtin_bit_cast(bf16x8, (u32x4){mw[4 * ks], mw[4 * ks + 1], mw[4 * ks + 2], mw[4 * ks + 3]});
                    yd0 = __builtin_amdgcn_mfma_f32_32x32x16_bf16(tr_frag_acc(lds + SSD_TX, 32 * a + 16 * ks, hh * 64, lane), mb, yd0, 0, 0, 0);
                    yd1 = __builtin_amdgcn_mfma_f32_32x32x16_bf16(tr_frag_acc(lds + SSD_TX, 32 * a + 16 * ks, hh * 64 + 32, lane), mb, yd1, 0, 0, 0); }
            }
            f32x16 yo0 = {}, yo1 = {};
#pragma unroll
            for (int ks = 0; ks < 8; ++ks) { const bf16x8 cf = row_frag(lds + SSD_TC, 32 * j, 16 * ks, lane);
                yo0 = __builtin_amdgcn_mfma_f32_32x32x16_bf16(row_frag(lds + SSD_TW, hh * 64, 16 * ks, lane), cf, yo0, 0, 0, 0);
                yo1 = __builtin_amdgcn_mfma_f32_32x32x16_bf16(row_frag(lds + SSD_TW, hh * 64 + 32, 16 * ks, lane), cf, yo1, 0, 0, 0); }
            const float eo = __expf(acs_l), Dh = p.d_skip[l * 4 + h];
#pragma unroll
            for (int pt = 0; pt < 2; ++pt)
#pragma unroll
                for (int rg = 0; rg < 4; ++rg) { const int pc = pt * 32 + 8 * rg + 4 * hi;
                    const u32x2 xw = *(const LAS u32x2*)(lds + SSD_TX + lrow * SSD_PITCH + (hh * 64 + pc) * 2);
                    const u32x2 zw = *(const u32x2*)(P + (size_t)(t0 + lrow) * NPROJ + C_Z + h * 64 + pc);
                    const float xs[4] = {bflo(xw.x), bfhi(xw.x), bflo(xw.y), bfhi(xw.y)}, zs[4] = {bflo(zw.x), bfhi(zw.x), bflo(zw.y), bfhi(zw.y)};
                    f32x4 yo4;
#pragma unroll
                    for (int q = 0; q < 4; ++q) { const int r = 4 * rg + q; const float yy = ((pt ? yd1[r] : yd0[r]) + (pt ? yo1[r] : yo0[r]) * eo + Dh * xs[q]) * silu_f(zs[q]); yo4[q] = yy; if (g == 0) ssq0 += yy * yy; else ssq1 += yy * yy; }
                    *(f32x4*)(YS + (size_t)(t0 + lrow) * 256 + h * 64 + pc) = yo4; }
            __syncthreads();
        }
        {
            ssq0 += __shfl_xor(ssq0, 32); ssq1 += __shfl_xor(ssq1, 32);
            if (hi == 0) { ssq[hh * 128 + lrow] = ssq0; ssq[(2 + hh) * 128 + lrow] = ssq1; }
            __syncthreads();
            const float tot = ssq[lrow] + ssq[128 + lrow] + ssq[256 + lrow] + ssq[384 + lrow];
            const float rn = 1.f / sqrtf(tot * (1.f / 256.f) + RMS_EPS);
#pragma unroll 1
            for (int g = 0; g < 2; ++g)
#pragma unroll
                for (int pt = 0; pt < 2; ++pt)
#pragma unroll
                    for (int rg = 0; rg < 4; ++rg) { const int ch = (2 * g + hh) * 64 + pt * 32 + 8 * rg + 4 * hi; const f32x4 nw = *(const f32x4*)(p.ssd_norm_w + l * 256 + ch);
                        const f32x4 yq = *(const f32x4*)(YS + (size_t)(t0 + lrow) * 256 + ch);
                        u32x2 o; o.x = pk2(yq.x * rn * nw.x, yq.y * rn * nw.y); o.y = pk2(yq.z * rn * nw.z, yq.w * rn * nw.w);
                        *(u32x2*)(MIX + (size_t)(t0 + lrow) * DM + 512 + ch) = o; }
            __syncthreads();
        }
    }
}

constexpr int AT_VP = 144, AT_WAVE_LDS = 32 * AT_VP + 1056;
struct AttnState { float m, l; f32x16 o0, o1; };
__device__ __forceinline__ void attn_tile_update(AttnState& st, f32x16& S, unsigned validmask, const LAS unsigned char* vt, int lane) {
    float tmax = -1e30f;
#pragma unroll
    for (int r = 0; r < 16; ++r) tmax = fmaxf(tmax, S[r]);
    tmax = fmaxf(tmax, __shfl_xor(tmax, 32));
    const float mn = fmaxf(st.m, tmax), sc = __expf(st.m - mn); st.m = mn;
    float ps = 0.f; unsigned pw[8]; (void)validmask;
#pragma unroll
    for (int r2 = 0; r2 < 8; ++r2) { float p0 = __expf(S[2 * r2] - mn), p1 = __expf(S[2 * r2 + 1] - mn); p0 = S[2 * r2] > -1e29f ? p0 : 0.f; p1 = S[2 * r2 + 1] > -1e29f ? p1 : 0.f;
        ps += p0 + p1; pw[r2] = pk2(p0, p1); }
    st.l = st.l * sc + ps;
    if (__any(sc != 1.0f)) {
#pragma unroll
        for (int r = 0; r < 16; ++r) { st.o0[r] *= sc; st.o1[r] *= sc; } }
    asm volatile("s_waitcnt lgkmcnt(0)" ::: "memory");
#pragma unroll
    for (int ks = 0; ks < 2; ++ks) { const bf16x8 pb = __builtin_bit_cast(bf16x8, (u32x4){pw[4 * ks], pw[4 * ks + 1], pw[4 * ks + 2], pw[4 * ks + 3]});
        st.o0 = __builtin_amdgcn_mfma_f32_32x32x16_bf16(tr_frag_acc<AT_VP>(vt, 16 * ks, 0, lane), pb, st.o0, 0, 0, 0);
        st.o1 = __builtin_amdgcn_mfma_f32_32x32x16_bf16(tr_frag_acc<AT_VP>(vt, 16 * ks, 32, lane), pb, st.o1, 0, 0, 0); }
    asm volatile("s_waitcnt lgkmcnt(0)" ::: "memory");
}
__device__ __forceinline__ void stage_attn(const Params& p, LAS unsigned char* lds, int item0, int item_stride, int wv_) {
    const int tid = otid(), lane = tid & 63, wave = __builtin_amdgcn_readfirstlane(tid >> 6), hi = lane >> 5, l31 = lane & 31;
    unsigned char* ws = p.ws; const bf16* P = (const bf16*)(ws + WS_P); const float* BT = (const float*)(ws + WS_BIAST);
    bf16* AO = (bf16*)(ws + WS_ATTO); float* LSE = (float*)(ws + WS_LSE);
    LAS unsigned char* vt = lds + wave * AT_WAVE_LDS; LAS float* bt = (LAS float*)(vt + 32 * AT_VP);
    const int h = wave;
    for (int item = item0; item < 384; item += item_stride) {
        const int br = item >> 7, q7 = item & 127, b = q7 >> 5, q5 = q7 & 31;
        const int dil = br == 0 ? 1 : (br == 1 ? 4 : 16), r = br == 0 ? 0 : (br == 1 ? (q5 >> 3) : (q5 >> 1)), n = br == 0 ? q5 : (br == 1 ? (q5 & 7) : (q5 & 1));
        const int tokbase = b * SEQ + r, m0 = n * 128;
        asm volatile("s_waitcnt lgkmcnt(0)" ::: "memory");
        bt[lane] = BT[(br * 8 + h) * 132 + lane]; bt[64 + lane] = BT[(br * 8 + h) * 132 + 64 + lane]; if (lane == 0) bt[128] = BT[(br * 8 + h) * 132 + 128];
        for (int a = 0; a < 4; ++a) {
            const int tokq = tokbase + (m0 + 32 * a + l31) * dil;
            bf16x8 qf[4];
#pragma unroll
            for (int ks = 0; ks < 4; ++ks) qf[ks] = *(const bf16x8*)(P + (size_t)tokq * NPROJ + C_Q + h * 64 + 16 * ks + 8 * hi);
            AttnState st; st.m = -1e30f; st.l = 0.f; st.o0 = (f32x16){}; st.o1 = (f32x16){};
            const int jt0 = (n == 0 && a < 4) ? 4 : a;
            for (int jt = (jt0 > a ? jt0 : a); jt <= a + 4; ++jt) {
                const int mk0 = m0 - 128 + 32 * jt;
                {
#pragma unroll
                    for (int it = 0; it < 4; ++it) { const int row = it * 8 + (lane >> 3), chn = lane & 7;
                        const u32x4 v = *(const u32x4*)(P + (size_t)(tokbase + (mk0 + row) * dil) * NPROJ + C_V + h * 64 + chn * 8);
                        *(LAS u32x4*)(vt + row * AT_VP + chn * 16) = v; } }
                const int tokk = tokbase + (mk0 + l31) * dil;
                f32x16 S = {};
#pragma unroll
                for (int ks = 0; ks < 4; ++ks) { const bf16x8 kf = *(const bf16x8*)(P + (size_t)tokk * NPROJ + C_K + h * 64 + 16 * ks + 8 * hi); S = __builtin_amdgcn_mfma_f32_32x32x16_bf16(kf, qf[ks], S, 0, 0, 0); }
                const int bs = 32 * (a - jt) + 128 + l31; unsigned vm = 0u;
#pragma unroll
                for (int rr = 0; rr < 16; ++rr) { const int stp = bs - crow(rr, hi); const bool ok = stp >= 0 && stp <= 128; const int sti = stp < 0 ? 0 : (stp > 128 ? 128 : stp);
                    const float bv = bt[sti]; S[rr] = ok ? S[rr] + bv : -1e30f; }
                attn_tile_update(st, S, vm, vt, lane);
            }
            const float lt = st.l + __shfl_xor(st.l, 32), inv = 1.f / lt;
#pragma unroll
            for (int dt = 0; dt < 2; ++dt)
#pragma unroll
                for (int rg = 0; rg < 4; ++rg) { const f32x16& o = dt ? st.o1 : st.o0; u32x2 w; w.x = pk2(o[4 * rg] * inv, o[4 * rg + 1] * inv); w.y = pk2(o[4 * rg + 2] * inv, o[4 * rg + 3] * inv);
                    *(u32x2*)(AO + ((size_t)br * T + tokq) * 512 + h * 64 + dt * 32 + 8 * rg + 4 * hi) = w; }
            if (hi == 0) LSE[((size_t)br * T + tokq) * 8 + h] = st.m + __logf(lt);
        }
    }
}
__device__ __forceinline__ void stage_memattn(const Params& p, LAS unsigned char* lds, int l, int item0, int item_stride, int wv_) {
    const int tid = otid(), lane = tid & 63, wave = __builtin_amdgcn_readfirstlane(tid >> 6), hi = lane >> 5, l31 = lane & 31;
    unsigned char* ws = p.ws; const bf16* P = (const bf16*)(ws + WS_P); const bf16* KV = (const bf16*)(ws + WS_KV) + (size_t)l * 1024 * 512; bf16* MIX = (bf16*)(ws + WS_MIX);
    LAS unsigned char* vt = lds + wave * AT_WAVE_LDS; LAS float* bt = (LAS float*)(vt + 32 * AT_VP);
    for (int item = item0; item < (T / 32) * 4; item += item_stride) {
        const int h = item & 3, tt = item >> 2, t0 = tt * 32, b = t0 / SEQ; const int tokq = t0 + l31;
        asm volatile("s_waitcnt lgkmcnt(0)" ::: "memory");
#pragma unroll
        for (int i = 0; i < 4; ++i) bt[64 * i + lane] = p.mem_bias[(l * 4 + h) * NMEM + 64 * i + lane];
        bf16x8 qf[4];
#pragma unroll
        for (int ks = 0; ks < 4; ++ks) qf[ks] = *(const bf16x8*)(P + (size_t)tokq * NPROJ + C_QM + h * 64 + 16 * ks + 8 * hi);
        AttnState st; st.m = -1e30f; st.l = 0.f; st.o0 = (f32x16){}; st.o1 = (f32x16){};
        for (int jt = 0; jt < 8; ++jt) {
            const bf16* kvb = KV + (size_t)(b * NMEM + 32 * jt) * 512;
#pragma unroll
            for (int it = 0; it < 4; ++it) { const int row = it * 8 + (lane >> 3), chn = lane & 7; const u32x4 v = *(const u32x4*)(kvb + (size_t)row * 512 + 256 + h * 64 + chn * 8); *(LAS u32x4*)(vt + row * AT_VP + chn * 16) = v; }
            f32x16 S = {};
#pragma unroll
            for (int ks = 0; ks < 4; ++ks) { const bf16x8 kf = *(const bf16x8*)(kvb + (size_t)l31 * 512 + h * 64 + 16 * ks + 8 * hi); S = __builtin_amdgcn_mfma_f32_32x32x16_bf16(kf, qf[ks], S, 0, 0, 0); }
#pragma unroll
            for (int rr = 0; rr < 16; ++rr) S[rr] += bt[32 * jt + crow(rr, hi)];
            attn_tile_update(st, S, 0xffffu, vt, lane);
        }
        const float lt = st.l + __shfl_xor(st.l, 32), inv = 1.f / lt;
#pragma unroll
        for (int dt = 0; dt < 2; ++dt)
#pragma unroll
            for (int rg = 0; rg < 4; ++rg) { const f32x16& o = dt ? st.o1 : st.o0; u32x2 w; w.x = pk2(o[4 * rg] * inv, o[4 * rg + 1] * inv); w.y = pk2(o[4 * rg + 2] * inv, o[4 * rg + 3] * inv);
                *(u32x2*)(MIX + (size_t)tokq * DM + 768 + h * 64 + dt * 32 + 8 * rg + 4 * hi) = w; }
    }
}

struct Route { int e1, e2; float w1, w2; };
__device__ __forceinline__ Route route_row(float (&lg)[16], const float* b_router) {
    float mx = -INFINITY;
#pragma unroll
    for (int e = 0; e < 16; ++e) { lg[e] += b_router[e]; mx = fmaxf(mx, lg[e]); }
    float sum = 0.f;
#pragma unroll
    for (int e = 0; e < 16; ++e) { lg[e] = __expf(lg[e] - mx); sum += lg[e]; }
    const float inv = 1.f / sum;
#pragma unroll
    for (int e = 0; e < 16; ++e) lg[e] *= inv;
    int best = 0; float bs = -1.f, c0 = 0.f, c1 = 0.f, c2 = 0.f, c3 = 0.f;
#pragma unroll
    for (int g = 0; g < 4; ++g) { const float a = lg[4 * g], b = lg[4 * g + 1], c = lg[4 * g + 2], d = lg[4 * g + 3];
        const float h1 = fmaxf(a, b), l1 = fminf(a, b), h2 = fmaxf(c, d), l2 = fminf(c, d); const float gs = fmaxf(h1, h2) + fmaxf(fminf(h1, h2), fmaxf(l1, l2));
        const bool better = gs > bs; bs = better ? gs : bs; best = better ? g : best; c0 = better ? a : c0; c1 = better ? b : c1; c2 = better ? c : c2; c3 = better ? d : c3; }
    int i1 = 0; float s1 = c0; if (c1 > s1) { s1 = c1; i1 = 1; } if (c2 > s1) { s1 = c2; i1 = 2; } if (c3 > s1) { s1 = c3; i1 = 3; }
    int i2 = -1; float s2 = -1.f;
    if (i1 != 0 && c0 > s2) { s2 = c0; i2 = 0; } if (i1 != 1 && c1 > s2) { s2 = c1; i2 = 1; } if (i1 != 2 && c2 > s2) { s2 = c2; i2 = 2; } if (i1 != 3 && c3 > s2) { s2 = c3; i2 = 3; }
    Route r; r.e1 = best * 4 + i1; r.e2 = best * 4 + i2; const float wsn = 1.f / (s1 + s2); r.w1 = s1 * wsn; r.w2 = s2 * wsn; return r;
}
constexpr int RT_W = 0, RT_LCNT = 65536, RT_GB = 65536 + 64, RT_INFO = 65536 + 128;
__device__ __forceinline__ void stage_ln1_router2(const Params& p, LAS unsigned char* lds, int l, int blk, int nblk, int wv_) {
    const int tid = otid(), lane = tid & 63, wave = __builtin_amdgcn_readfirstlane(tid >> 6);
    unsigned char* ws = p.ws; bf16* XB = (bf16*)(ws + WS_XB); unsigned* cnt = (unsigned*)(ws + WS_CTL) + CW_CNT + l * 16;
    int* TOKE = (int*)(ws + WS_TOKE); int* TOKP = (int*)(ws + WS_TOKP); float* TOKW = (float*)(ws + WS_TOKW); int* LIST = (int*)(ws + WS_LIST);
    LAS f32x4* WL = (LAS f32x4*)(lds + RT_W); LAS unsigned* lcnt = (LAS unsigned*)(lds + RT_LCNT); LAS unsigned* gb = (LAS unsigned*)(lds + RT_GB); LAS int* info = (LAS int*)(lds + RT_INFO);
#pragma unroll
    for (int i = 0; i < 8; ++i) { const int chunk = tid + NTHREADS * i, k = chunk >> 2, q = chunk & 3, ln = (k & 255) >> 2, c = k & 3, j = k >> 8;
        WL[((j * 4 + c) * 4 + q) * 64 + ln] = *((const f32x4*)p.w_router + chunk); }
    for (int rb = blk; rb < T / 64; rb += nblk) {
        if (tid < 16) lcnt[tid] = 0u;
        __syncthreads();
#pragma unroll 1
        for (int pr = 0; pr < 4; ++pr) {
            const int r0 = wave * 8 + 2 * pr, t = rb * 64 + r0;
            f32x4 v0[4], v1[4]; f32x4* xr0 = (f32x4*)(p.out + (size_t)t * DM) + lane; f32x4* xr1 = xr0 + DM / 4;
#pragma unroll
            for (int j = 0; j < 4; ++j) { v0[j] = xr0[64 * j]; v1[j] = xr1[64 * j]; }
            ln_row(v0, p.ln1_g + l * DM, p.ln1_b + l * DM, lane); ln_row(v1, p.ln1_g + l * DM, p.ln1_b + l * DM, lane);
            f32x2 lgp[16];
#pragma unroll
            for (int e = 0; e < 16; ++e) lgp[e] = (f32x2){0.f, 0.f};
#pragma unroll
            for (int j = 0; j < 4; ++j) { xr0[64 * j] = v0[j]; xr1[64 * j] = v1[j];
                u32x2 o; o.x = pk2(v0[j].x, v0[j].y); o.y = pk2(v0[j].z, v0[j].w); *((u32x2*)(XB + (size_t)t * DM) + lane + 64 * j) = o;
                o.x = pk2(v1[j].x, v1[j].y); o.y = pk2(v1[j].z, v1[j].w); *((u32x2*)(XB + (size_t)(t + 1) * DM) + lane + 64 * j) = o;
#pragma unroll
                for (int c = 0; c < 4; ++c) { const f32x2 xp = (f32x2){v0[j][c], v1[j][c]};
#pragma unroll
                    for (int q = 0; q < 4; ++q) { const f32x4 w = WL[((j * 4 + c) * 4 + q) * 64 + lane];
                        lgp[4 * q] = __builtin_elementwise_fma(xp, (f32x2){w.x, w.x}, lgp[4 * q]); lgp[4 * q + 1] = __builtin_elementwise_fma(xp, (f32x2){w.y, w.y}, lgp[4 * q + 1]);
                        lgp[4 * q + 2] = __builtin_elementwise_fma(xp, (f32x2){w.z, w.z}, lgp[4 * q + 2]); lgp[4 * q + 3] = __builtin_elementwise_fma(xp, (f32x2){w.w, w.w}, lgp[4 * q + 3]); } } }
            float lg0[16], lg1[16];
            {
                const bool b5 = lane & 32, b4 = lane & 16, b3 = lane & 8, b2 = lane & 4;
                f32x2 r8[8], r4[4], r2[2], r1;
#pragma unroll
                for (int e = 0; e < 8; ++e) { const f32x2 send = b5 ? lgp[e] : lgp[e + 8], keep = b5 ? lgp[e + 8] : lgp[e]; r8[e] = keep + (f32x2){__shfl_xor(send.x, 32), __shfl_xor(send.y, 32)}; }
#pragma unroll
                for (int e = 0; e < 4; ++e) { const f32x2 send = b4 ? r8[e] : r8[e + 4], keep = b4 ? r8[e + 4] : r8[e]; r4[e] = keep + (f32x2){__shfl_xor(send.x, 16), __shfl_xor(send.y, 16)}; }
#pragma unroll
                for (int e = 0; e < 2; ++e) { const f32x2 send = b3 ? r4[e] : r4[e + 2], keep = b3 ? r4[e + 2] : r4[e]; r2[e] = keep + (f32x2){__shfl_xor(send.x, 8), __shfl_xor(send.y, 8)}; }
                { const f32x2 send = b2 ? r2[0] : r2[1], keep = b2 ? r2[1] : r2[0]; r1 = keep + (f32x2){__shfl_xor(send.x, 4), __shfl_xor(send.y, 4)}; }
                r1 = r1 + (f32x2){__shfl_xor(r1.x, 1), __shfl_xor(r1.y, 1)}; r1 = r1 + (f32x2){__shfl_xor(r1.x, 2), __shfl_xor(r1.y, 2)};
#pragma unroll
                for (int e = 0; e < 16; ++e) { const int src = ((e >> 3) & 1) * 32 + ((e >> 2) & 1) * 16 + ((e >> 1) & 1) * 8 + (e & 1) * 4; lg0[e] = __shfl(r1.x, src); lg1[e] = __shfl(r1.y, src); }
            }
            const Route ra = route_row(lg0, p.b_router), rc = route_row(lg1, p.b_router);
            if (lane == 0) {
                const int pa1 = (int)__hip_atomic_fetch_add(lcnt + ra.e1, 1u, __ATOMIC_RELAXED, __HIP_MEMORY_SCOPE_WORKGROUP), pa2 = (int)__hip_atomic_fetch_add(lcnt + ra.e2, 1u, __ATOMIC_RELAXED, __HIP_MEMORY_SCOPE_WORKGROUP);
                const int pc1 = (int)__hip_atomic_fetch_add(lcnt + rc.e1, 1u, __ATOMIC_RELAXED, __HIP_MEMORY_SCOPE_WORKGROUP), pc2 = (int)__hip_atomic_fetch_add(lcnt + rc.e2, 1u, __ATOMIC_RELAXED, __HIP_MEMORY_SCOPE_WORKGROUP);
                LAS int* ia = info + r0 * 6; ia[0] = ra.e1; ia[1] = ra.e2; ia[2] = pa1; ia[3] = pa2; ia[4] = __builtin_bit_cast(int, ra.w1); ia[5] = __builtin_bit_cast(int, ra.w2);
                ia[6] = rc.e1; ia[7] = rc.e2; ia[8] = pc1; ia[9] = pc2; ia[10] = __builtin_bit_cast(int, rc.w1); ia[11] = __builtin_bit_cast(int, rc.w2); }
        }
        __syncthreads();
        if (tid < 16) gb[tid] = atomicAdd(cnt + tid, lcnt[tid]);
        __syncthreads();
        if (tid < 64) { const int t = rb * 64 + tid; const LAS int* ia = info + tid * 6; const int e1 = ia[0], e2 = ia[1], p1 = (int)gb[e1] + ia[2], p2 = (int)gb[e2] + ia[3];
            LIST[e1 * T + p1] = t; LIST[e2 * T + p2] = t; TOKE[2 * t] = e1; TOKE[2 * t + 1] = e2; TOKP[2 * t] = p1; TOKP[2 * t + 1] = p2;
            TOKW[2 * t] = __builtin_bit_cast(float, ia[4]); TOKW[2 * t + 1] = __builtin_bit_cast(float, ia[5]); }
        __syncthreads();
    }
}
__device__ __forceinline__ void stage_ln2b(const Params& p, LAS unsigned char* lds, int l, int blk, int nblk, int wv_) {
    const int tid = otid(), lane = tid & 63, wave = __builtin_amdgcn_readfirstlane(tid >> 6), gw = blk * NWAVES + wave, ngw = nblk * NWAVES;
    unsigned char* ws = p.ws; bf16* XB = (bf16*)(ws + WS_XB); const unsigned* cnt = (const unsigned*)(ws + WS_CTL) + CW_CNT + l * 16; const bf16* Y = (const bf16*)(ws + WS_Y);
    const int* TOKE = (const int*)(ws + WS_TOKE); const int* TOKP = (const int*)(ws + WS_TOKP); const float* TOKW = (const float*)(ws + WS_TOKW); float* DT = (float*)(ws + WS_DT);
    LAS int* eb = (LAS int*)lds;
    if (tid == 0) { int a = 0; for (int e = 0; e < NE; ++e) { eb[e] = a; a += (int)((cnt[e] + 255u) >> 8) * 256; } }
    __syncthreads();
    const bool nextl = l + 1 < DEPTH;
    for (int t = 2 * gw; t < T; t += 2 * ngw) {
        asm volatile("" ::: "memory");
        int ie = 0, ip = 0; float iw = 0.f;
        if (lane < 4) { ie = gld<int>(TOKE + 2 * t + lane); ip = gld<int>(TOKP + 2 * t + lane); iw = gld<float>(TOKW + 2 * t + lane); }
        const int ea1 = __shfl(ie, 0), ea2 = __shfl(ie, 1), ec1 = __shfl(ie, 2), ec2 = __shfl(ie, 3);
        const int ra1 = __shfl(ip, 0) + eb[ea1], ra2 = __shfl(ip, 1) + eb[ea2], rc1 = __shfl(ip, 2) + eb[ec1], rc2 = __shfl(ip, 3) + eb[ec2];
        const float wa1 = __shfl(iw, 0), wa2 = __shfl(iw, 1), wc1 = __shfl(iw, 2), wc2 = __shfl(iw, 3);
        f32x4 v0[4], v1[4]; f32x4* xr0 = (f32x4*)(p.out + (size_t)t * DM) + lane; f32x4* xr1 = xr0 + DM / 4;
#pragma unroll
        for (int j = 0; j < 4; ++j) { const f32x4 xa = xr0[64 * j], xc = xr1[64 * j];
            const u32x2 a = *((const u32x2*)(Y + (size_t)ra1 * DM) + lane + 64 * j), b = *((const u32x2*)(Y + (size_t)ra2 * DM) + lane + 64 * j);
            const u32x2 c = *((const u32x2*)(Y + (size_t)rc1 * DM) + lane + 64 * j), d = *((const u32x2*)(Y + (size_t)rc2 * DM) + lane + 64 * j);
            v0[j].x = ALPHA * xa.x + (wa1 * bflo(a.x) + wa2 * bflo(b.x)); v0[j].y = ALPHA * xa.y + (wa1 * bfhi(a.x) + wa2 * bfhi(b.x));
            v0[j].z = ALPHA * xa.z + (wa1 * bflo(a.y) + wa2 * bflo(b.y)); v0[j].w = ALPHA * xa.w + (wa1 * bfhi(a.y) + wa2 * bfhi(b.y));
            v1[j].x = ALPHA * xc.x + (wc1 * bflo(c.x) + wc2 * bflo(d.x)); v1[j].y = ALPHA * xc.y + (wc1 * bfhi(c.x) + wc2 * bfhi(d.x));
            v1[j].z = ALPHA * xc.z + (wc1 * bflo(c.y) + wc2 * bflo(d.y)); v1[j].w = ALPHA * xc.w + (wc1 * bfhi(c.y) + wc2 * bfhi(d.y)); }
        ln_row(v0, p.ln2_g + l * DM, p.ln2_b + l * DM, lane); ln_row(v1, p.ln2_g + l * DM, p.ln2_b + l * DM, lane);
        float d0 = 0.f, d1 = 0.f, d2 = 0.f, d3 = 0.f, f0 = 0.f, f1 = 0.f, f2 = 0.f, f3 = 0.f;
#pragma unroll
        for (int j = 0; j < 4; ++j) { xr0[64 * j] = v0[j]; xr1[64 * j] = v1[j];
            if (nextl) { u32x2 o; o.x = pk2(v0[j].x, v0[j].y); o.y = pk2(v0[j].z, v0[j].w); *((u32x2*)(XB + (size_t)t * DM) + lane + 64 * j) = o;
                o.x = pk2(v1[j].x, v1[j].y); o.y = pk2(v1[j].z, v1[j].w); *((u32x2*)(XB + (size_t)(t + 1) * DM) + lane + 64 * j) = o;
#pragma unroll
                for (int c = 0; c < 4; ++c) { const int k = 4 * lane + 256 * j + c; const f32x4 w = *(const f32x4*)(p.w_in + ((size_t)(l + 1) * DM + k) * NCOLS_IN + 2560); const float xa = v0[j][c], xc = v1[j][c];
                    d0 += xa * w.x; d1 += xa * w.y; d2 += xa * w.z; d3 += xa * w.w; f0 += xc * w.x; f1 += xc * w.y; f2 += xc * w.z; f3 += xc * w.w; } } }
        if (nextl) { d0 = wave_sum(d0); d1 = wave_sum(d1); d2 = wave_sum(d2); d3 = wave_sum(d3); f0 = wave_sum(f0); f1 = wave_sum(f1); f2 = wave_sum(f2); f3 = wave_sum(f3);
            if (lane == 0) { *(f32x4*)(DT + (size_t)t * 4) = (f32x4){d0, d1, d2, d3}; *(f32x4*)(DT + (size_t)(t + 1) * 4) = (f32x4){f0, f1, f2, f3}; } }
    }
    __syncthreads();
}
__device__ __forceinline__ void stage_merge2(const Params& p, int blk, int nblk, int wv_) {
    const int tid = otid(), lane = tid & 63, wave = tid >> 6, gw = blk * NWAVES + wave, ngw = nblk * NWAVES, h = lane >> 3;
    unsigned char* ws = p.ws; const bf16* AO = (const bf16*)(ws + WS_ATTO); const float* LSE = (const float*)(ws + WS_LSE); bf16* MIX = (bf16*)(ws + WS_MIX);
    for (int t0 = 4 * gw; t0 < T; t0 += 4 * ngw) {
        u32x4 a[4][3]; float ls[4][3];
#pragma unroll
        for (int i = 0; i < 4; ++i)
#pragma unroll
            for (int br = 0; br < 3; ++br) { a[i][br] = *(const u32x4*)(AO + ((size_t)br * T + t0 + i) * 512 + lane * 8); ls[i][br] = LSE[((size_t)br * T + t0 + i) * 8 + h]; }
#pragma unroll
        for (int i = 0; i < 4; ++i) { const float mx = fmaxf(fmaxf(ls[i][0], ls[i][1]), ls[i][2]); float w0 = __expf(ls[i][0] - mx), w1 = __expf(ls[i][1] - mx), w2 = __expf(ls[i][2] - mx); const float inv = 1.f / (w0 + w1 + w2); w0 *= inv; w1 *= inv; w2 *= inv;
            u32x4 o;
#pragma unroll
            for (int q = 0; q < 4; ++q) o[q] = pk2(w0 * bflo(a[i][0][q]) + w1 * bflo(a[i][1][q]) + w2 * bflo(a[i][2][q]), w0 * bfhi(a[i][0][q]) + w1 * bfhi(a[i][1][q]) + w2 * bfhi(a[i][2][q]));
            *(u32x4*)(MIX + (size_t)(t0 + i) * DM + lane * 8) = o; }
    }
}
__device__ __forceinline__ void stage_ssd_scan2(const Params& p, int blk, int nblk, int wv_) {
    unsigned char* ws = p.ws; float* SST = (float*)(ws + WS_SST); const float* ATOT = (const float*)(ws + WS_ATOT);
    for (int e = blk * NTHREADS + otid(); e < NB * 4 * 8192; e += nblk * NTHREADS) { const int el = e & 8191, h = (e >> 13) & 3, b = e >> 15;
        float sv[32], dc[32];
#pragma unroll
        for (int c = 0; c < 32; ++c) { sv[c] = SST[((size_t)((b * 32 + c) * 4 + h)) * 8192 + el]; dc[c] = ATOT[(b * 32 + c) * 4 + h]; }
        float run = 0.f;
#pragma unroll
        for (int c = 0; c < 32; ++c) { const float in = sv[c]; sv[c] = run; run = run * __expf(dc[c]) + in; }
#pragma unroll
        for (int c = 0; c < 32; ++c) SST[((size_t)((b * 32 + c) * 4 + h)) * 8192 + el] = sv[c]; }
}

__device__ __forceinline__ void stage_attn2(const Params& p, LAS unsigned char* lds, int item0, int item_stride, int wv_) {
    const int tid = otid(), lane = tid & 63, wave = __builtin_amdgcn_readfirstlane(tid >> 6), hi = lane >> 5, l31 = lane & 31;
    unsigned char* ws = p.ws; const bf16* P = (const bf16*)(ws + WS_P); const float* BT = (const float*)(ws + WS_BIAST);
    bf16* AO = (bf16*)(ws + WS_ATTO); float* LSE = (float*)(ws + WS_LSE);
    LAS unsigned char* vt = lds + wave * AT_WAVE_LDS; LAS float* bt = (LAS float*)(vt + 32 * AT_VP);
    const int h = wave;
    for (int hitem = item0; hitem < 768; hitem += item_stride) {
        const int item = hitem >> 1, half = hitem & 1;
        const int br = item >> 7, q7 = item & 127, b = q7 >> 5, q5 = q7 & 31;
        const int dil = br == 0 ? 1 : (br == 1 ? 4 : 16), r = br == 0 ? 0 : (br == 1 ? (q5 >> 3) : (q5 >> 1)), n = br == 0 ? q5 : (br == 1 ? (q5 & 7) : (q5 & 1));
        const int tokbase = b * SEQ + r, m0 = n * 128;
        asm volatile("s_waitcnt lgkmcnt(0)" ::: "memory");
#pragma unroll
        for (int i = 0; i < 3; ++i) { const int idx = lane + 64 * i, jj = idx - 32; bt[idx] = (jj >= 0 && jj <= 128) ? gld<float>(BT + (br * 8 + h) * 132 + 128 - jj) : -1e30f; }
        const int sb = n == 0 ? (half ? 3 : 0) : 10 * half, ns = n == 0 ? (half ? 10 : 3) : 10 * half + 10;
#define AT_DECODE(s_, a_, jt_) do { if (n != 0) { a_ = (s_) / 5; jt_ = a_ + (s_) % 5; } else { a_ = (s_) < 1 ? 0 : ((s_) < 3 ? 1 : ((s_) < 6 ? 2 : 3)); jt_ = 4 + (s_) - (a_ == 0 ? 0 : (a_ == 1 ? 1 : (a_ == 2 ? 3 : 6))); } } while (0)
#define AT_LOADKV(a_, jt_) do { const int mk0_ = m0 - 128 + 32 * (jt_); const bf16* kp_ = P + (size_t)(tokbase + (mk0_ + l31) * dil) * NPROJ + C_K + h * 64 + 8 * hi; \
            _Pragma("unroll") for (int ks = 0; ks < 4; ++ks) kn[ks] = gld<bf16x8>(kp_ + 16 * ks); \
            _Pragma("unroll") for (int it = 0; it < 4; ++it) vn[it] = gld<u32x4>(P + (size_t)(tokbase + (mk0_ + it * 8 + (lane >> 3)) * dil) * NPROJ + C_V + h * 64 + (lane & 7) * 8); } while (0)
#define AT_LOADQ(a_) do { const bf16* qp_ = P + (size_t)(tokbase + (m0 + 32 * (a_) + l31) * dil) * NPROJ + C_Q + h * 64 + 8 * hi; _Pragma("unroll") for (int ks = 0; ks < 4; ++ks) qn[ks] = gld<bf16x8>(qp_ + 16 * ks); } while (0)
        bf16x8 kn[4], qn[4], qf[4]; u32x4 vn[4];
        int a, jt; AT_DECODE(sb, a, jt); AT_LOADQ(a); AT_LOADKV(a, jt);
        AttnState st; st.m = -1e30f; st.l = 0.f; st.o0 = (f32x16){}; st.o1 = (f32x16){};
        int cur_a = -1;
        for (int s_ = sb; s_ < ns; ++s_) {
            AT_DECODE(s_, a, jt);
            bf16x8 kc[4]; u32x4 vc[4];
#pragma unroll
            for (int i = 0; i < 4; ++i) { kc[i] = kn[i]; vc[i] = vn[i]; }
            if (a != cur_a) { cur_a = a;
#pragma unroll
                for (int i = 0; i < 4; ++i) qf[i] = qn[i];
                st.m = -1e30f; st.l = 0.f; st.o0 = (f32x16){}; st.o1 = (f32x16){}; }
            int a2 = -1, jt2 = 0;
            if (s_ + 1 < ns) { AT_DECODE(s_ + 1, a2, jt2); AT_LOADKV(a2, jt2); if (a2 != a) AT_LOADQ(a2); }
#pragma unroll
            for (int it = 0; it < 4; ++it) *(LAS u32x4*)(vt + (it * 8 + (lane >> 3)) * AT_VP + (lane & 7) * 16) = vc[it];
            f32x16 S = {};
#pragma unroll
            for (int ks = 0; ks < 4; ++ks) S = __builtin_amdgcn_mfma_f32_32x32x16_bf16(kc[ks], qf[ks], S, 0, 0, 0);
            const LAS float* rb = bt + 32 + 32 * (jt - a) - l31 + 4 * hi;
#pragma unroll
            for (int rr = 0; rr < 16; ++rr) S[rr] += rb[(rr & 3) + 8 * (rr >> 2)];
            attn_tile_update(st, S, 0u, vt, lane);
            if (a2 != a) {
                const int tokq = tokbase + (m0 + 32 * a + l31) * dil;
                const float lt = st.l + __shfl_xor(st.l, 32), inv = 1.f / lt;
#pragma unroll
                for (int dt = 0; dt < 2; ++dt)
#pragma unroll
                    for (int rg = 0; rg < 4; ++rg) { const f32x16& o = dt ? st.o1 : st.o0; u32x2 w; w.x = pk2(o[4 * rg] * inv, o[4 * rg + 1] * inv); w.y = pk2(o[4 * rg + 2] * inv, o[4 * rg + 3] * inv);
                        gst<u32x2>(AO + ((size_t)br * T + tokq) * 512 + h * 64 + dt * 32 + 8 * rg + 4 * hi, w); }
                if (hi == 0) gst<float>(LSE + ((size_t)br * T + tokq) * 8 + h, st.m + __logf(lt));
            }
        }
#undef AT_DECODE
#undef AT_LOADKV
#undef AT_LOADQ
    }
}
__device__ __forceinline__ void stage_memattn2(const Params& p, LAS unsigned char* lds, int l, int item0, int item_stride, int wv_) {
    const int tid = otid(), lane = tid & 63, wave = __builtin_amdgcn_readfirstlane(tid >> 6), hi = lane >> 5, l31 = lane & 31;
    unsigned char* ws = p.ws; const bf16* P = (const bf16*)(ws + WS_P); const bf16* KV = (const bf16*)(ws + WS_KV) + (size_t)l * 1024 * 512; bf16* MIX = (bf16*)(ws + WS_MIX);
    LAS unsigned char* vt = lds + wave * AT_WAVE_LDS; LAS float* bt = (LAS float*)(vt + 32 * AT_VP);
    for (int item = item0; item < (T / 32) * 4; item += item_stride) {
        const int h = item & 3, tt = item >> 2, t0 = tt * 32, b = t0 / SEQ; const int tokq = t0 + l31;
        asm volatile("s_waitcnt lgkmcnt(0)" ::: "memory");
#pragma unroll
        for (int i = 0; i < 4; ++i) bt[64 * i + lane] = gld<float>(p.mem_bias + (l * 4 + h) * NMEM + 64 * i + lane);
        bf16x8 qf[4], kn[4]; u32x4 vn[4];
#pragma unroll
        for (int ks = 0; ks < 4; ++ks) qf[ks] = gld<bf16x8>(P + (size_t)tokq * NPROJ + C_QM + h * 64 + 16 * ks + 8 * hi);
#define MA_LOADKV(jt_) do { const bf16* kvb_ = KV + (size_t)(b * NMEM + 32 * (jt_)) * 512; \
            _Pragma("unroll") for (int ks = 0; ks < 4; ++ks) kn[ks] = gld<bf16x8>(kvb_ + (size_t)l31 * 512 + h * 64 + 16 * ks + 8 * hi); \
            _Pragma("unroll") for (int it = 0; it < 4; ++it) vn[it] = gld<u32x4>(kvb_ + (size_t)(it * 8 + (lane >> 3)) * 512 + 256 + h * 64 + (lane & 7) * 8); } while (0)
        MA_LOADKV(0);
        AttnState st; st.m = -1e30f; st.l = 0.f; st.o0 = (f32x16){}; st.o1 = (f32x16){};
        for (int jt = 0; jt < 8; ++jt) {
            bf16x8 kc[4]; u32x4 vc[4];
#pragma unroll
            for (int i = 0; i < 4; ++i) { kc[i] = kn[i]; vc[i] = vn[i]; }
            if (jt + 1 < 8) MA_LOADKV(jt + 1);
#pragma unroll
            for (int it = 0; it < 4; ++it) *(LAS u32x4*)(vt + (it * 8 + (lane >> 3)) * AT_VP + (lane & 7) * 16) = vc[it];
            f32x16 S = {};
#pragma unroll
            for (int ks = 0; ks < 4; ++ks) S = __builtin_amdgcn_mfma_f32_32x32x16_bf16(kc[ks], qf[ks], S, 0, 0, 0);
#pragma unroll
            for (int rr = 0; rr < 16; ++rr) S[rr] += bt[32 * jt + crow(rr, hi)];
            attn_tile_update(st, S, 0xffffu, vt, lane);
        }
#undef MA_LOADKV
        const float lt = st.l + __shfl_xor(st.l, 32), inv = 1.f / lt;
#pragma unroll
        for (int dt = 0; dt < 2; ++dt)
#pragma unroll
            for (int rg = 0; rg < 4; ++rg) { const f32x16& o = dt ? st.o1 : st.o0; u32x2 w; w.x = pk2(o[4 * rg] * inv, o[4 * rg + 1] * inv); w.y = pk2(o[4 * rg + 2] * inv, o[4 * rg + 3] * inv);
                gst<u32x2>(MIX + (size_t)tokq * DM + 768 + h * 64 + dt * 32 + 8 * rg + 4 * hi, w); }
    }
}

__device__ __forceinline__ void stage_attn3(const Params& p, LAS unsigned char* lds, int blk, int nblk, int wv_) {
    const int tid = otid(), lane = tid & 63, wave = __builtin_amdgcn_readfirstlane(tid >> 6), hi = lane >> 5, l31 = lane & 31;
    unsigned char* ws = p.ws; const bf16* P = (const bf16*)(ws + WS_P); const float* BT = (const float*)(ws + WS_BIAST);
    bf16* AO = (bf16*)(ws + WS_ATTO); float* LSE = (float*)(ws + WS_LSE);
    LAS unsigned char* vt = lds + wave * AT_WAVE_LDS; LAS float* bt = (LAS float*)(vt + 32 * AT_VP);
    const int h = wave;
    for (int rnd = 0; rnd * nblk < 768; ++rnd) {
        int br, b, r, n, hf2;
        if (nblk == 256) { const int x = blk & 7, jx = blk >> 3, li = jx >> 1; hf2 = jx & 1; br = rnd;
            if (br == 0) { b = li >> 2; n = 4 * x + (li & 3); r = 0; }
            else if (br == 1) { const int combo = 2 * x + (li >> 3); b = combo >> 2; r = combo & 3; n = li & 7; }
            else { const int combo = 8 * x + (li >> 1); b = combo >> 4; r = combo & 15; n = li & 1; } }
        else { const int hitem = blk + rnd * nblk; if (hitem >= 768) break; const int it2 = hitem >> 1; hf2 = hitem & 1; br = it2 >> 7; const int q7 = it2 & 127, q5 = q7 & 31; b = q7 >> 5;
            r = br == 0 ? 0 : (br == 1 ? (q5 >> 3) : (q5 >> 1)); n = br == 0 ? q5 : (br == 1 ? (q5 & 7) : (q5 & 1)); }
        const int dil = br == 0 ? 1 : (br == 1 ? 4 : 16);
        const int tokbase = b * SEQ + r, m0 = n * 128, a0 = 2 * hf2;
        asm volatile("s_waitcnt lgkmcnt(0)" ::: "memory");
#pragma unroll
        for (int i = 0; i < 3; ++i) { const int idx = lane + 64 * i, jj = idx - 32; bt[idx] = (jj >= 0 && jj <= 128) ? gld<float>(BT + (br * 8 + h) * 132 + 128 - jj) : -1e30f; }
        const int jlo = n == 0 ? 4 : a0, jhi = a0 + 5;
#define AT_LOADKV(jt_) do { const int mk0_ = m0 - 128 + 32 * (jt_); const bf16* kp_ = P + (size_t)(tokbase + (mk0_ + l31) * dil) * NPROJ + C_K + h * 64 + 8 * hi; \
            _Pragma("unroll") for (int ks = 0; ks < 4; ++ks) kn[ks] = gld<bf16x8>(kp_ + 16 * ks); \
            _Pragma("unroll") for (int it = 0; it < 4; ++it) vn[it] = gld<u32x4>(P + (size_t)(tokbase + (mk0_ + it * 8 + (lane >> 3)) * dil) * NPROJ + C_V + h * 64 + (lane & 7) * 8); } while (0)
        bf16x8 kn[4], q0[4], q1[4]; u32x4 vn[4];
        const int tokq0 = tokbase + (m0 + 32 * a0 + l31) * dil, tokq1 = tokq0 + 32 * dil;
#pragma unroll
        for (int ks = 0; ks < 4; ++ks) { q0[ks] = gld<bf16x8>(P + (size_t)tokq0 * NPROJ + C_Q + h * 64 + 8 * hi + 16 * ks); q1[ks] = gld<bf16x8>(P + (size_t)tokq1 * NPROJ + C_Q + h * 64 + 8 * hi + 16 * ks); }
        AT_LOADKV(jlo);
        AttnState s0, s1; s0.m = -1e30f; s0.l = 0.f; s0.o0 = (f32x16){}; s0.o1 = (f32x16){}; s1.m = -1e30f; s1.l = 0.f; s1.o0 = (f32x16){}; s1.o1 = (f32x16){};
        for (int jt = jlo; jt <= jhi; ++jt) {
            bf16x8 kc[4]; u32x4 vc[4];
#pragma unroll
            for (int i = 0; i < 4; ++i) { kc[i] = kn[i]; vc[i] = vn[i]; }
            if (jt < jhi) AT_LOADKV(jt + 1);
#pragma unroll
            for (int it = 0; it < 4; ++it) *(LAS u32x4*)(vt + (it * 8 + (lane >> 3)) * AT_VP + (lane & 7) * 16) = vc[it];
            if (jt <= a0 + 4) {
                f32x16 S = {};
#pragma unroll
                for (int ks = 0; ks < 4; ++ks) S = __builtin_amdgcn_mfma_f32_32x32x16_bf16(kc[ks], q0[ks], S, 0, 0, 0);
                const LAS float* rb = bt + 32 + 32 * (jt - a0) - l31 + 4 * hi;
#pragma unroll
                for (int rr = 0; rr < 16; ++rr) S[rr] += rb[(rr & 3) + 8 * (rr >> 2)];
                attn_tile_update(s0, S, 0u, vt, lane);
            }
            if (jt >= a0 + 1) {
                f32x16 S = {};
#pragma unroll
                for (int ks = 0; ks < 4; ++ks) S = __builtin_amdgcn_mfma_f32_32x32x16_bf16(kc[ks], q1[ks], S, 0, 0, 0);
                const LAS float* rb = bt + 32 + 32 * (jt - a0 - 1) - l31 + 4 * hi;
#pragma unroll
                for (int rr = 0; rr < 16; ++rr) S[rr] += rb[(rr & 3) + 8 * (rr >> 2)];
                attn_tile_update(s1, S, 0u, vt, lane);
            }
        }
#undef AT_LOADKV
#pragma unroll
        for (int qt = 0; qt < 2; ++qt) { const AttnState& st = qt ? s1 : s0; const int tokq = qt ? tokq1 : tokq0;
            const float lt = st.l + __shfl_xor(st.l, 32), inv = 1.f / lt;
#pragma unroll
            for (int dt = 0; dt < 2; ++dt)
#pragma unroll
                for (int rg = 0; rg < 4; ++rg) { const f32x16& o = dt ? st.o1 : st.o0; u32x2 w; w.x = pk2(o[4 * rg] * inv, o[4 * rg + 1] * inv); w.y = pk2(o[4 * rg + 2] * inv, o[4 * rg + 3] * inv);
                    gst<u32x2>(AO + ((size_t)br * T + tokq) * 512 + h * 64 + dt * 32 + 8 * rg + 4 * hi, w); }
            if (hi == 0) gst<float>(LSE + ((size_t)br * T + tokq) * 8 + h, st.m + __logf(lt)); }
    }
}

__device__ __forceinline__ void ssd_tables2(const Params& p, int l, int t0, int h0, int nh, LAS float* dtv, LAS float* acs, LAS float* wtot, int wv_) {
    const int tid = otid();
    const int hh = tid >> 7, row = tid & 127, lane = tid & 63, wave = tid >> 6;
    float v = 0.f;
    if (hh < nh) { const int h = h0 + hh; const float a = -__expf(gld<float>(p.a_log + l * 4 + h)); const float dt = softplus_f(gld<float>((const float*)(p.ws + WS_DT) + (size_t)(t0 + row) * 4 + h) + gld<float>(p.dt_bias + l * 4 + h));
        dtv[hh * 128 + row] = dt; v = a * dt; }
#pragma unroll
    for (int o = 1; o < 64; o <<= 1) { const float t = __shfl_up(v, o); if (lane >= o) v += t; }
    if (lane == 63) wtot[wave] = v;
    __syncthreads();
    if (wave & 1) v += wtot[wave - 1];
    if (hh < nh) acs[hh * 128 + row] = v;
    __syncthreads();
}
template <int NT, int RPT>
__device__ __forceinline__ void ssd_conv_multi(const bf16* P, int t0, int s0, int g, const float* cw, const float* cb, LAS unsigned char* tile0, int tid) {
    constexpr int RG = 128 / RPT;
    const int k = tid / (16 * RG), rem = tid % (16 * RG), ch = rem & 15, rg = rem >> 4;
    if (k < NT) {
        const int cc0 = k * 256 + g * 128 + ch * 8;
        const bf16* src = P + (size_t)t0 * NPROJ + C_XBC + cc0;
        u32x4 in[RPT + 3];
#pragma unroll
        for (int r = 0; r < RPT + 3; ++r) { const int row = RPT * rg - 3 + r; in[r] = (u32x4){0u, 0u, 0u, 0u}; if (s0 + row >= 0) in[r] = gld<u32x4>(src + (ptrdiff_t)row * NPROJ); }
        float w[4][8], bias[8];
#pragma unroll
        for (int kk = 0; kk < 4; ++kk) { const f32x4 a = gld<f32x4>(cw + kk * 768 + cc0), b = gld<f32x4>(cw + kk * 768 + cc0 + 4);
            w[kk][0] = a.x; w[kk][1] = a.y; w[kk][2] = a.z; w[kk][3] = a.w; w[kk][4] = b.x; w[kk][5] = b.y; w[kk][6] = b.z; w[kk][7] = b.w; }
        { const f32x4 a = gld<f32x4>(cb + cc0), b = gld<f32x4>(cb + cc0 + 4); bias[0] = a.x; bias[1] = a.y; bias[2] = a.z; bias[3] = a.w; bias[4] = b.x; bias[5] = b.y; bias[6] = b.z; bias[7] = b.w; }
        LAS unsigned char* tile = tile0 + k * SSD_TILE;
#pragma unroll
        for (int j = 0; j < RPT; ++j) { float o[8];
#pragma unroll
            for (int i = 0; i < 8; ++i) o[i] = bias[i];
#pragma unroll
            for (int kk = 0; kk < 4; ++kk)
#pragma unroll
                for (int i2 = 0; i2 < 4; ++i2) { const unsigned wd = in[j + kk][i2]; o[2 * i2] += w[kk][2 * i2] * bflo(wd); o[2 * i2 + 1] += w[kk][2 * i2 + 1] * bfhi(wd); }
            u32x4 ov;
#pragma unroll
            for (int i2 = 0; i2 < 4; ++i2) ov[i2] = pk2(silu_f(o[2 * i2]), silu_f(o[2 * i2 + 1]));
            *(LAS u32x4*)(tile + (RPT * rg + j) * SSD_PITCH + ch * 16) = ov; }
    }
}
__device__ __forceinline__ void stage_ssd1b(const Params& p, LAS unsigned char* lds, int l, int blk, int nblk, int wv_) {
    const int tid = otid(), lane = tid & 63, wave = __builtin_amdgcn_readfirstlane(tid >> 6);
    unsigned char* ws = p.ws; const bf16* P = (const bf16*)(ws + WS_P); float* SST = (float*)(ws + WS_SST); float* ATOT = (float*)(ws + WS_ATOT);
    const float* cw = p.conv_w + (size_t)l * 4 * 768; const float* cb = p.conv_b + (size_t)l * 768;
    LAS float* dtv = (LAS float*)(lds + SSD_TAB); LAS float* acs = dtv + 512; LAS float* wtot = dtv + 1024;
    for (int u = blk; u < NB * 32 * 2; u += nblk) {
        const int g = u & 1, c = (u >> 1) & 31, b = u >> 6, t0 = b * SEQ + c * 128, s0 = c * 128;
        ssd_conv_multi<2, 8>(P, t0, s0, g, cw, cb, lds + SSD_TX, tid);
        ssd_tables2(p, l, t0, 2 * g, 2, dtv, acs, wtot, wv_);
        if (tid < 2) gst<float>(ATOT + (b * 32 + c) * 4 + 2 * g + tid, acs[tid * 128 + 127]);
        { const int row = tid >> 2, cq = tid & 3, hh = cq >> 1; const float sc = dtv[hh * 128 + row] * __expf(acs[hh * 128 + 127] - acs[hh * 128 + row]);
#pragma unroll
            for (int i = 0; i < 4; ++i) { const u32x4 v = *(const LAS u32x4*)(lds + SSD_TX + row * SSD_PITCH + cq * 64 + i * 16); u32x4 o;
#pragma unroll
                for (int q = 0; q < 4; ++q) o[q] = pk2(bflo(v[q]) * sc, bfhi(v[q]) * sc);
                *(LAS u32x4*)(lds + SSD_TW + row * SSD_PITCH + cq * 64 + i * 16) = o; } }
        __syncthreads();
        { const int hh = wave >> 2, nt = wave & 3, hi = lane >> 5; f32x16 acc0 = {}, acc1 = {};
#pragma unroll
            for (int ks = 0; ks < 8; ++ks) { const bf16x8 bfr = tr_frag_nat(lds + SSD_TB, 16 * ks, nt * 32, lane);
                const bf16x8 a0 = tr_frag_nat(lds + SSD_TW, 16 * ks, hh * 64, lane), a1 = tr_frag_nat(lds + SSD_TW, 16 * ks, hh * 64 + 32, lane);
                acc0 = __builtin_amdgcn_mfma_f32_32x32x16_bf16(a0, bfr, acc0, 0, 0, 0); acc1 = __builtin_amdgcn_mfma_f32_32x32x16_bf16(a1, bfr, acc1, 0, 0, 0); }
            float* So = SST + ((size_t)((b * 32 + c) * 4 + 2 * g + hh)) * 8192 + nt * 32 + (lane & 31);
#pragma unroll
            for (int r = 0; r < 16; ++r) { gst<float>(So + (size_t)crow(r, hi) * 128, acc0[r]); gst<float>(So + (size_t)(32 + crow(r, hi)) * 128, acc1[r]); } }
        __syncthreads();
    }
}
__device__ __forceinline__ void stage_ssd3b(const Params& p, LAS unsigned char* lds, int l, int blk, int nblk, int wv_) {
    const int tid = otid(), lane = tid & 63, wave = __builtin_amdgcn_readfirstlane(tid >> 6), hi = lane >> 5, l31 = lane & 31;
    unsigned char* ws = p.ws; const bf16* P = (const bf16*)(ws + WS_P); const float* SST = (const float*)(ws + WS_SST); bf16* MIX = (bf16*)(ws + WS_MIX); float* YS = (float*)(ws + WS_YS);
    const float* cw = p.conv_w + (size_t)l * 4 * 768; const float* cb = p.conv_b + (size_t)l * 768;
    LAS float* dtv = (LAS float*)(lds + SSD_TAB); LAS float* acs = dtv + 512; LAS float* ssq = dtv + 1024; LAS float* wtot = dtv + 1024 + 512;
    for (int u = blk; u < NB * 32 * 2; u += nblk) {
        const int tp = u & 1, c = (u >> 1) & 31, b = u >> 6, t0 = b * SEQ + c * 128, s0 = c * 128;
        const int hh = wave >> 2, jj = (wave >> 1) & 1, pt = wave & 1, j = tp == 0 ? (jj ? 3 : 0) : (jj ? 2 : 1), lrow = 32 * j + l31;
        ssd_tables2(p, l, t0, 0, 4, dtv, acs, wtot, wv_);
        float ssq_l = 0.f;
#pragma unroll 1
        for (int g = 0; g < 2; ++g) {
            ssd_conv_multi<3, 16>(P, t0, s0, g, cw, cb, lds + SSD_TX, tid);
            { const int row = tid >> 2, cq = tid & 3; const float* src = SST + ((size_t)((b * 32 + c) * 4 + 2 * g + (row >> 6))) * 8192 + (row & 63) * 128 + cq * 32;
#pragma unroll
                for (int i = 0; i < 4; ++i) { const f32x4 a = gld<f32x4>(src + 8 * i), bq = gld<f32x4>(src + 8 * i + 4); u32x4 o; o.x = pk2(a.x, a.y); o.y = pk2(a.z, a.w); o.z = pk2(bq.x, bq.y); o.w = pk2(bq.z, bq.w);
                    *(LAS u32x4*)(lds + SSD_TW + row * SSD_PITCH + cq * 64 + i * 16) = o; } }
            const int h = 2 * g + hh, pc0 = pt * 32 + 4 * hi;
            u32x2 zw[4];
#pragma unroll
            for (int rg = 0; rg < 4; ++rg) zw[rg] = gld<u32x2>(P + (size_t)(t0 + lrow) * NPROJ + C_Z + h * 64 + pc0 + 8 * rg);
            __syncthreads();
            const LAS float* acsh = acs + h * 128; const LAS float* dth = dtv + h * 128; const float acs_l = acsh[lrow];
            f32x16 yd = {};
            for (int a = 0; a <= j; ++a) {
                f32x16 G = {};
#pragma unroll
                for (int ks = 0; ks < 8; ++ks) G = __builtin_amdgcn_mfma_f32_32x32x16_bf16(row_frag(lds + SSD_TB, 32 * a, 16 * ks, lane), row_frag(lds + SSD_TC, 32 * j, 16 * ks, lane), G, 0, 0, 0);
                unsigned mw[8];
#pragma unroll
                for (int r2 = 0; r2 < 8; ++r2) { float v2[2];
#pragma unroll
                    for (int q = 0; q < 2; ++q) { const int r = 2 * r2 + q, srow = 32 * a + crow(r, hi); float v = G[r] * __expf(acs_l - acsh[srow]) * dth[srow]; v = srow > lrow ? 0.f : v; v2[q] = v; }
                    mw[r2] = pk2(v2[0], v2[1]); }
#pragma unroll
                for (int ks = 0; ks < 2; ++ks) { const bf16x8 mb = __builtin_bit_cast(bf16x8, (u32x4){mw[4 * ks], mw[4 * ks + 1], mw[4 * ks + 2], mw[4 * ks + 3]});
                    yd = __builtin_amdgcn_mfma_f32_32x32x16_bf16(tr_frag_acc(lds + SSD_TX, 32 * a + 16 * ks, hh * 64 + pt * 32, lane), mb, yd, 0, 0, 0); }
            }
            f32x16 yo = {};
#pragma unroll
            for (int ks = 0; ks < 8; ++ks) yo = __builtin_amdgcn_mfma_f32_32x32x16_bf16(row_frag(lds + SSD_TW, hh * 64 + pt * 32, 16 * ks, lane), row_frag(lds + SSD_TC, 32 * j, 16 * ks, lane), yo, 0, 0, 0);
            const float eo = __expf(acs_l), Dh = gld<float>(p.d_skip + l * 4 + h);
#pragma unroll
            for (int rg = 0; rg < 4; ++rg) { const int pc = pc0 + 8 * rg;
                const u32x2 xw = *(const LAS u32x2*)(lds + SSD_TX + lrow * SSD_PITCH + (hh * 64 + pc) * 2);
                const float xs[4] = {bflo(xw.x), bfhi(xw.x), bflo(xw.y), bfhi(xw.y)}, zs[4] = {bflo(zw[rg].x), bfhi(zw[rg].x), bflo(zw[rg].y), bfhi(zw[rg].y)};
                f32x4 yo4;
#pragma unroll
                for (int q = 0; q < 4; ++q) { const int r = 4 * rg + q; const float yy = (yd[r] + yo[r] * eo + Dh * xs[q]) * silu_f(zs[q]); yo4[q] = yy; ssq_l += yy * yy; }
                gst<f32x4>(YS + (size_t)(t0 + lrow) * 256 + h * 64 + pc, yo4); }
            __syncthreads();
        }
        ssq_l += __shfl_xor(ssq_l, 32);
        if (hi == 0) ssq[(hh * 2 + pt) * 64 + jj * 32 + l31] = ssq_l;
        __syncthreads();
        { float tot = 0.f;
#pragma unroll
          for (int k = 0; k < 4; ++k) tot += ssq[k * 64 + jj * 32 + l31];
          const float rn = 1.f / sqrtf(tot * (1.f / 256.f) + RMS_EPS);
#pragma unroll
          for (int g = 0; g < 2; ++g)
#pragma unroll
            for (int rg = 0; rg < 4; ++rg) { const int ch = (2 * g + hh) * 64 + pt * 32 + 4 * hi + 8 * rg; const f32x4 nw = gld<f32x4>(p.ssd_norm_w + l * 256 + ch);
                const f32x4 yq = gld<f32x4>(YS + (size_t)(t0 + lrow) * 256 + ch);
                u32x2 o; o.x = pk2(yq.x * rn * nw.x, yq.y * rn * nw.y); o.y = pk2(yq.z * rn * nw.z, yq.w * rn * nw.w);
                gst<u32x2>(MIX + (size_t)(t0 + lrow) * DM + 512 + ch, o); } }
        __syncthreads();
    }
}

constexpr int CW_BAR = 4096;
#define XB_TMO      128
#define XB_XCNT(j)  (256  + 64 * (j))
#define XB_XSUB(j)  (1280 + 64 * (j))
#define XB_XGEN(j)  (2304 + 64 * (j))
#define XB_TOP      3328
#define XB_TOPGEN   3392
#define XCD_BAR_WORDS 3456
#define XB_SPIN_CAP (1u << 18)

__device__ __forceinline__ unsigned xb_ld(unsigned* p)              { return __hip_atomic_load(p, __ATOMIC_RELAXED, __HIP_MEMORY_SCOPE_AGENT); }
__device__ __forceinline__ unsigned xb_add(unsigned* p, unsigned v) { return __hip_atomic_fetch_add(p, v, __ATOMIC_RELAXED, __HIP_MEMORY_SCOPE_AGENT); }
__device__ __forceinline__ unsigned xb_xcc_id() { return (unsigned)__builtin_amdgcn_s_getreg((3 << 11) | 20) & 0xFu; }
#define XB_SPIN(cond, bar) do { unsigned _sp = 0; while (cond) { __builtin_amdgcn_s_sleep(1); \
    if ((++_sp & 255u) == 0u) { if (xb_ld(&(bar)[XB_TMO])) break; if (_sp > XB_SPIN_CAP) { atomicAdd(&(bar)[XB_TMO], 1u); break; } } } } while (0)

struct XcdBarrier {
    unsigned* bar; unsigned x;
    volatile LAS unsigned* st;
    bool leader;
};

__device__ __forceinline__ XcdBarrier xcd_barrier_post(unsigned* bar, volatile LAS unsigned* st) {
    XcdBarrier b; b.bar = bar; b.x = xb_xcc_id(); b.st = st; b.leader = (threadIdx.x == 0);
    if (threadIdx.x == 0) (void)xb_add(&bar[XB_XCNT(b.x)], 1u);
    return b;
}
__device__ __forceinline__ void xcd_barrier_complete(unsigned* bar, unsigned x, unsigned& nloc, unsigned& nx) {
    const unsigned G = gridDim.x * gridDim.y * gridDim.z;
    unsigned sum, cnt, mine, sp = 0u;
    for (;;) {
        sum = 0u; cnt = 0u; mine = 0u;
#pragma unroll
        for (unsigned j = 0; j < 16; ++j) { const unsigned c = xb_ld(&bar[XB_XCNT(j)]); sum += c; cnt += (c > 0u) ? 1u : 0u; mine = (j == x) ? c : mine; }
        if (sum == G) break;
        __builtin_amdgcn_s_sleep(1);
        if ((++sp & 255u) == 0u) { if (xb_ld(&bar[XB_TMO])) break; if (sp > XB_SPIN_CAP) { atomicAdd(&bar[XB_TMO], 1u); break; } }
    }
    nloc = mine > 0u ? mine : 1u; nx = cnt > 0u ? cnt : 1u;
}

__device__ __forceinline__ void xcd_barrier(const XcdBarrier& b) {
    asm volatile("s_waitcnt vmcnt(0)" ::: "memory");
    __syncthreads();
    if (b.leader) {
        unsigned* bar = b.bar;
        __builtin_amdgcn_s_waitcnt(0);
        unsigned nloc = b.st[0], nx = b.st[1];
        if (nloc == 0u) { xcd_barrier_complete(bar, b.x, nloc, nx); b.st[0] = nloc; b.st[1] = nx; }
        const unsigned old = xb_add(&bar[XB_XSUB(b.x)], 1u);
        const unsigned gen = old / nloc;
        if (old + 1u == (gen + 1u) * nloc) {
            __builtin_amdgcn_fence(__ATOMIC_RELEASE, "agent");
            asm volatile("s_waitcnt vmcnt(0)" ::: "memory");
            const unsigned og = xb_add(&bar[XB_TOP], 1u);
            const unsigned tg = og / nx;
            if (og + 1u == (tg + 1u) * nx) xb_add(&bar[XB_TOPGEN], 1u);
            else XB_SPIN(xb_ld(&bar[XB_TOPGEN]) == tg, bar);
            __builtin_amdgcn_fence(__ATOMIC_ACQUIRE, "agent");
            xb_add(&bar[XB_XGEN(b.x)], 1u);
            asm volatile("s_waitcnt vmcnt(0)" ::: "memory");
        } else {
            XB_SPIN(xb_ld(&bar[XB_XGEN(b.x)]) == gen, bar);
            __builtin_amdgcn_fence(__ATOMIC_ACQUIRE, "agent");
            asm volatile("s_waitcnt vmcnt(0)" ::: "memory");
        }
    }
    __syncthreads();
}

constexpr int RING_BYTES = 131072;
constexpr int LDS_BYTES = 147456;
constexpr int LDSCTL_OFF = LDS_BYTES - 512;
constexpr int MISC_OFF = LDSCTL_OFF;
constexpr int LDS_BYTES_UNUSED_ = 0;


__device__ __forceinline__ void launder(Params& q) {
#define LND(f) do { asm volatile("" : "+s"(q.f)); q.f = (decltype(q.f))(const GAS void*)q.f; } while (0)
    LND(x); LND(mem); LND(w_in); LND(w_out); LND(rel_bias); LND(conv_w); LND(conv_b); LND(dt_bias); LND(a_log); LND(d_skip); LND(ssd_norm_w); LND(w_mem_kv); LND(mem_bias);
    LND(ln1_g); LND(ln1_b); LND(ln2_g); LND(ln2_b); LND(w_router); LND(b_router); LND(w_gate); LND(w_up); LND(w_down); LND(out); LND(ws);
#undef LND
}
constexpr int PROBE_STOP = -1;
__global__ void __launch_bounds__(NTHREADS, 2) mega_fwd(Params p, int stop) {
    extern __shared__ __attribute__((aligned(16))) unsigned char lds_raw[];
    LAS unsigned char* lds = (LAS unsigned char*)lds_raw;
    const int tid = threadIdx.x, blk = blockIdx.x, nblk = gridDim.x; const int wv_ = __builtin_amdgcn_readfirstlane(tid >> 6);
    for (int u = tid; u < (LDS_BYTES - LDSCTL_OFF) / 4; u += NTHREADS) ((LAS unsigned*)(lds + LDSCTL_OFF))[u] = 0u;
    __syncthreads();
    volatile LAS unsigned* MISC = (volatile LAS unsigned*)(lds + MISC_OFF);
    (void)xcd_barrier_post((unsigned*)(p.ws + WS_CTL) + CW_BAR, MISC + 8);
#define GRID_BAR() do { XcdBarrier b_; b_.bar = (unsigned*)(p.ws + WS_CTL) + CW_BAR; b_.x = xb_xcc_id(); b_.st = (volatile LAS unsigned*)(lds + MISC_OFF) + 8; b_.leader = (otid() == 0); xcd_barrier(b_); } while (0)
    stage_prologue(p, lds, blk, nblk, wv_);
    if (stop == 0) return;
    GRID_BAR();
#pragma unroll 1
    for (int l = 0; l < DEPTH; ++l) {
        Params q = p; launder(q);
        stage_proj(q, lds, l, blk, nblk, wv_);
        if (stop == l * 10 + 1) return;
        GRID_BAR();
        stage_ssd1b(q, lds, l, blk, nblk, wv_); if (stop == 100 + l * 10 + 1) return; stage_attn3(q, lds, blk, nblk, wv_); if (stop == 100 + l * 10 + 2) return; stage_memattn2(q, lds, l, blk * NWAVES + wv_, nblk * NWAVES, wv_);
        if (stop == l * 10 + 2) return;
        GRID_BAR();
        stage_ssd_scan2(q, blk, nblk, wv_); stage_merge2(q, blk, nblk, wv_);
        if (stop == l * 10 + 3) return;
        GRID_BAR();
        stage_ssd3b(q, lds, l, blk, nblk, wv_);
        if (stop == l * 10 + 4) return;
        GRID_BAR();
        stage_out(q, lds, l, blk, nblk, wv_);
        if (stop == l * 10 + 5) return;
        GRID_BAR();
        stage_ln1_router2(q, lds, l, blk, nblk, wv_);
        if (stop == l * 10 + 6) return;
        GRID_BAR();
        stage_moe1(q, lds, l, blk, nblk, wv_);
        if (stop == l * 10 + 7) return;
        GRID_BAR();
        stage_moe2(q, lds, l, blk, nblk, wv_);
        if (stop == l * 10 + 8) return;
        GRID_BAR();
        stage_ln2b(q, lds, l, blk, nblk, wv_);
        if (l + 1 < DEPTH) GRID_BAR();
    }
}

extern "C" void kernel_launch(void* const* d_in, const int* in_sizes, int n_in, void* d_out, int out_size, void* d_ws, size_t ws_size, hipStream_t stream) {
    if (n_in != 22 || out_size != T * DM || ws_size < WS_END) { fprintf(stderr, "kernel_launch: unexpected shapes (n_in %d out %d ws %zu)\n", n_in, out_size, ws_size); return; }
    static int grid = 0;
    if (grid == 0) {
        int dev = 0, cus = 0, per_cu = 0;
        if (hipGetDevice(&dev) != hipSuccess || hipDeviceGetAttribute(&cus, hipDeviceAttributeMultiprocessorCount, dev) != hipSuccess) { grid = -1; return; }
        if (hipFuncSetAttribute((const void*)mega_fwd, hipFuncAttributeMaxDynamicSharedMemorySize, LDS_BYTES) != hipSuccess) { fprintf(stderr, "kernel_launch: hipFuncSetAttribute failed\n"); grid = -1; return; }
        if (hipOccupancyMaxActiveBlocksPerMultiprocessor(&per_cu, (const void*)mega_fwd, NTHREADS, LDS_BYTES) != hipSuccess || per_cu < 1) fprintf(stderr, "kernel_launch: occupancy query reports %d\n", per_cu);
        (void)hipGetLastError();
        grid = cus;
    }
    if (grid < 0) return;
    Params p{};
    const float** pp = (const float**)&p;
    for (int i = 0; i < 22; ++i) pp[i] = (const float*)d_in[i];
    p.out = (float*)d_out; p.ws = (unsigned char*)d_ws;
    (void)hipMemsetAsync((char*)d_ws + WS_CTL, 0, CTL_ZERO_BYTES, stream);
    if (PROBE_STOP >= 0) { hipLaunchKernelGGL(mega_fwd, dim3(grid), dim3(NTHREADS), LDS_BYTES, stream, p, PROBE_STOP); (void)hipMemsetAsync((char*)d_ws + WS_CTL, 0, CTL_ZERO_BYTES, stream); }
    hipLaunchKernelGGL(mega_fwd, dim3(grid), dim3(NTHREADS), LDS_BYTES, stream, p, 1000);
}
```
